# Optimizing an MI355X kernel written in HIP

```python
import math
import jax, jax.numpy as jnp
from jax import lax
import numpy as np

D_MODEL = 2048
BATCH = 4
SEQ = 2048
DEPTH = 1
DEC_BATCH = 128
DEC_SEQ = 4
PAST_LEN = 16384
PAGE_SIZE = 128

D_MIX = D_MODEL
D_LRU = D_MIX // 2
D_S5 = D_MIX - D_LRU
LRU_HEADS = 16
LRU_HEAD_DIM = D_LRU // LRU_HEADS
CONV_WIDTH = 4
C_GATE = 8.0
S5_GROUP_CH = 16
S5_GROUPS = D_S5 // S5_GROUP_CH
S5_STATE = 64
D_FF = 4 * D_MODEL
EPS = 1e-6

kernel_name = 'hymba_style_rglru_s5_decoder_step'


def _rmsnorm(x, g):
    xf = x.astype(jnp.float32)
    y = xf * lax.rsqrt(jnp.mean(xf * xf, axis=-1, keepdims=True) + EPS)
    return y * g.astype(jnp.float32)


def _linear_scan(a, b, h0):
    b = b.at[:, 0].add(a[:, 0] * h0)
    def combine(l, r):
        return (l[0] * r[0], r[0] * l[1] + r[1])
    _, h = lax.associative_scan(combine, (a, b), axis=1)
    return h


def _layer(x, conv_buf, h_lru, s5_h, p):
    f32 = jnp.float32
    bsz, slen, _ = x.shape
    xn = _rmsnorm(x, p['norm_mix']).astype(x.dtype)
    z = xn @ p['w_in']
    x_lru = z[..., :D_LRU]
    g_lru = z[..., D_LRU:2 * D_LRU]
    u_s5 = z[..., 2 * D_LRU:]

    xp = jnp.concatenate([conv_buf.astype(f32), x_lru.astype(f32)], axis=1)
    conv_w = p['conv_w'].astype(f32)
    xc = p['conv_b'].astype(f32) + sum(xp[:, k:k + slen] * conv_w[k] for k in range(CONV_WIDTH))
    new_conv = xp[:, slen:]
    xh = xc.reshape(bsz, slen, LRU_HEADS, LRU_HEAD_DIM)
    r = jax.nn.sigmoid(jnp.einsum('bshi,hij->bshj', xh, p['w_gate_a'].astype(f32)).reshape(bsz, slen, D_LRU)
                       + p['b_gate_a'].astype(f32))
    i = jax.nn.sigmoid(jnp.einsum('bshi,hij->bshj', xh, p['w_gate_x'].astype(f32)).reshape(bsz, slen, D_LRU)
                       + p['b_gate_x'].astype(f32))
    log_a = -C_GATE * r * jax.nn.softplus(-p['lru_lambda'].astype(f32))
    a = jnp.exp(log_a)
    mult = jnp.sqrt(-jnp.expm1(2.0 * log_a))
    h = _linear_scan(a, mult * (i * xc), h_lru.astype(f32))
    new_lru = h[:, -1]
    lru_out = h * jax.nn.gelu(g_lru.astype(f32))

    lam = lax.complex(p['s5_a_re'].astype(f32), p['s5_a_im'].astype(f32))
    dt = jnp.exp(p['s5_log_step'].astype(f32))[:, None]
    abar = jnp.exp(lam * dt)
    b_c = lax.complex(p['s5_b_re'].astype(f32), p['s5_b_im'].astype(f32))
    bbar = ((abar - 1.0) / lam)[..., None] * b_c
    c_c = lax.complex(p['s5_c_re'].astype(f32), p['s5_c_im'].astype(f32))
    u = u_s5.astype(f32).reshape(bsz, slen, S5_GROUPS, S5_GROUP_CH)
    bu = jnp.einsum('bsgc,gpc->bsgp', u.astype(jnp.complex64), bbar)
    hs = _linear_scan(jnp.broadcast_to(abar, bu.shape), bu, s5_h)
    new_s5 = hs[:, -1]
    y = jnp.real(jnp.einsum('bsgp,gcp->bsgc', hs, c_c)) \
        + u * p['s5_d'].astype(f32).reshape(S5_GROUPS, S5_GROUP_CH)
    g = jax.nn.gelu(y.reshape(bsz, slen, D_S5))
    s5_out = g * jax.nn.sigmoid(g @ p['w_glu'].astype(f32) + p['b_glu'].astype(f32))

    mix = jnp.concatenate([_rmsnorm(lru_out, p['norm_out_a']),
                           _rmsnorm(s5_out, p['norm_out_b'])], axis=-1).astype(x.dtype)
    x = x + mix @ p['w_out']

    hn = _rmsnorm(x, p['norm_mlp']).astype(x.dtype)
    x = x + jnp.square(jax.nn.relu(hn @ p['w_up'])) @ p['w_down']
    return x, new_conv, new_lru, new_s5


def setup_inputs(seed: int = 0) -> dict:
    key = jax.random.key(seed)
    ks = jax.random.split(key, 32)
    f32 = jnp.float32
    def nrm(k, shape, std):
        return std * jax.random.normal(k, shape, f32)
    G, P, C = S5_GROUPS, S5_STATE, S5_GROUP_CH
    a0 = jax.random.uniform(ks[10], (DEPTH, D_LRU), f32, minval=0.9, maxval=0.999)
    s = a0 ** (1.0 / C_GATE)
    lru_lambda = jnp.log(s) - jnp.log1p(-s)
    return {
        'x_prompt': nrm(ks[0], (BATCH, SEQ, D_MODEL), 1.0),
        'x_sample': nrm(ks[1], (DEC_BATCH, DEC_SEQ, D_MODEL), 1.0),
        'state_conv': nrm(ks[2], (DEPTH, DEC_BATCH, CONV_WIDTH - 1, D_LRU), 1.0),
        'state_lru': nrm(ks[3], (DEPTH, DEC_BATCH, D_LRU), 0.5),
        'state_s5_re': nrm(ks[4], (DEPTH, DEC_BATCH, G, P), 0.1),
        'state_s5_im': nrm(ks[5], (DEPTH, DEC_BATCH, G, P), 0.1),
        'norm_mix': 1.0 + nrm(ks[6], (DEPTH, D_MODEL), 0.02),
        'w_in': nrm(ks[7], (DEPTH, D_MODEL, D_LRU * 2 + D_S5), D_MODEL ** -0.5),
        'conv_w': nrm(ks[8], (DEPTH, CONV_WIDTH, D_LRU), CONV_WIDTH ** -0.5),
        'conv_b': nrm(ks[9], (DEPTH, D_LRU), 0.01),
        'w_gate_a': nrm(ks[11], (DEPTH, LRU_HEADS, LRU_HEAD_DIM, LRU_HEAD_DIM), LRU_HEAD_DIM ** -0.5),
        'b_gate_a': nrm(ks[12], (DEPTH, D_LRU), 0.01),
        'w_gate_x': nrm(ks[13], (DEPTH, LRU_HEADS, LRU_HEAD_DIM, LRU_HEAD_DIM), LRU_HEAD_DIM ** -0.5),
        'b_gate_x': nrm(ks[14], (DEPTH, D_LRU), 0.01),
        'lru_lambda': lru_lambda,
        's5_a_re': -0.5 + nrm(ks[15], (DEPTH, G, P), 0.01),
        's5_a_im': math.pi * jnp.arange(P, dtype=f32) + nrm(ks[16], (DEPTH, G, P), 0.01),
        's5_log_step': jax.random.uniform(ks[17], (DEPTH, G), f32,
                                          minval=math.log(1e-3), maxval=math.log(1e-1)),
        's5_b_re': nrm(ks[18], (DEPTH, G, P, C), (2.0 * C) ** -0.5),
        's5_b_im': nrm(ks[19], (DEPTH, G, P, C), (2.0 * C) ** -0.5),
        's5_c_re': nrm(ks[20], (DEPTH, G, C, P), (2.0 * P) ** -0.5),
        's5_c_im': nrm(ks[21], (DEPTH, G, C, P), (2.0 * P) ** -0.5),
        's5_d': nrm(ks[22], (DEPTH, D_S5), 1.0),
        'w_glu': nrm(ks[23], (DEPTH, D_S5, D_S5), D_S5 ** -0.5),
        'b_glu': nrm(ks[24], (DEPTH, D_S5), 0.01),
        'norm_out_a': 1.0 + nrm(ks[25], (DEPTH, D_LRU), 0.02),
        'norm_out_b': 1.0 + nrm(ks[26], (DEPTH, D_S5), 0.02),
        'w_out': nrm(ks[27], (DEPTH, D_MIX, D_MODEL), D_MIX ** -0.5),
        'norm_mlp': 1.0 + nrm(ks[28], (DEPTH, D_MODEL), 0.02),
        'w_up': nrm(ks[29], (DEPTH, D_MODEL, D_FF), D_MODEL ** -0.5),
        'w_down': nrm(ks[30], (DEPTH, D_FF, D_MODEL), D_FF ** -0.5),
        'norm_final': 1.0 + nrm(ks[31], (D_MODEL,), 0.02),
    }


def reference(x_prompt, x_sample, state_conv, state_lru, state_s5_re, state_s5_im,
              norm_mix, w_in, conv_w, conv_b, w_gate_a, b_gate_a, w_gate_x, b_gate_x,
              lru_lambda, s5_a_re, s5_a_im, s5_log_step, s5_b_re, s5_b_im, s5_c_re, s5_c_im,
              s5_d, w_glu, b_glu, norm_out_a, norm_out_b, w_out, norm_mlp, w_up, w_down,
              norm_final):
    f32 = jnp.float32
    bp = x_prompt.shape[0]
    xp_, xs_ = x_prompt, x_sample
    conv_p, lru_p, re_p, im_p = [], [], [], []
    conv_s, lru_s, re_s, im_s = [], [], [], []
    for l in range(DEPTH):
        p = {
            'norm_mix': norm_mix[l], 'w_in': w_in[l], 'conv_w': conv_w[l], 'conv_b': conv_b[l],
            'w_gate_a': w_gate_a[l], 'b_gate_a': b_gate_a[l], 'w_gate_x': w_gate_x[l],
            'b_gate_x': b_gate_x[l], 'lru_lambda': lru_lambda[l], 's5_a_re': s5_a_re[l],
            's5_a_im': s5_a_im[l], 's5_log_step': s5_log_step[l], 's5_b_re': s5_b_re[l],
            's5_b_im': s5_b_im[l], 's5_c_re': s5_c_re[l], 's5_c_im': s5_c_im[l], 's5_d': s5_d[l],
            'w_glu': w_glu[l], 'b_glu': b_glu[l], 'norm_out_a': norm_out_a[l],
            'norm_out_b': norm_out_b[l], 'w_out': w_out[l], 'norm_mlp': norm_mlp[l],
            'w_up': w_up[l], 'w_down': w_down[l],
        }
        xp_, c1, h1, s1 = _layer(
            xp_, jnp.zeros((bp, CONV_WIDTH - 1, D_LRU), f32), jnp.zeros((bp, D_LRU), f32),
            jnp.zeros((bp, S5_GROUPS, S5_STATE), jnp.complex64), p)
        s5_init = lax.complex(state_s5_re[l].astype(f32), state_s5_im[l].astype(f32))
        xs_, c2, h2, s2 = _layer(xs_, state_conv[l], state_lru[l], s5_init, p)
        conv_p.append(c1); lru_p.append(h1); re_p.append(jnp.real(s1)); im_p.append(jnp.imag(s1))
        conv_s.append(c2); lru_s.append(h2); re_s.append(jnp.real(s2)); im_s.append(jnp.imag(s2))
    y_prompt = _rmsnorm(xp_, norm_final).astype(x_prompt.dtype)
    y_sample = _rmsnorm(xs_, norm_final).astype(x_sample.dtype)
    return (y_prompt, y_sample,
            jnp.stack(conv_p), jnp.stack(lru_p), jnp.stack(re_p), jnp.stack(im_p),
            jnp.stack(conv_s), jnp.stack(lru_s), jnp.stack(re_s), jnp.stack(im_s))
```

```cpp
#include <hip/hip_runtime.h>
#include <hip/hip_cooperative_groups.h>
#include <cstdio>
#include <cstdint>
namespace cg = cooperative_groups;

namespace pg8 {
#define PG8_LAS __attribute__((address_space(3)))
typedef unsigned short bf16_t;
typedef short bf16x8 __attribute__((ext_vector_type(8)));
typedef float f32x4 __attribute__((ext_vector_type(4)));
typedef unsigned u32x4 __attribute__((ext_vector_type(4)));
constexpr int BM = 256, BK = 64, HALF = 128, HTB = HALF * BK * 2  , STAGE_BYTES = 8 * HTB, NXCD = 8, WGM = 8;

__host__ __device__ __forceinline__ int lds_byte(int r, int c) { const int st = (r >> 4) * 2 + (c >> 5), rr = r & 15, cc = c & 31, ob = rr * 64 + cc * 2; return st * 1024 + (ob ^ (((ob >> 9) & 1) << 5)); }
__host__ __device__ __forceinline__ void stage_rc(int b, int& R, int& C) { const int st = b / 1024, sb = b % 1024, swz = sb ^ (((sb >> 9) & 1) << 5); R = (st >> 1) * 16 + swz / 64; C = (st & 1) * 32 + (swz % 64) / 2; }
__host__ __device__ __forceinline__ int perm32(int rho) { const int n = rho >> 4, i = rho & 15; return 8 * (i >> 2) + 4 * n + (i & 3); }

struct Unit { int pm, pn, z; };
struct Gemm { const bf16_t* A; const bf16_t* Bt; int lda, ldb, K; size_t sA, sB; };

struct Order {
    int nM, nN, nZ, G, c;
    __device__ void init(int M, int N, int Z, int G_, int c_) { nM = M / BM; nN = N / BM; nZ = Z; G = G_; c = c_; }
    __device__ bool next(int i, Unit& u) const {
        int zz = 0; if (nZ < 0) { zz = i & 1; i >>= 1; }
        const long L = (long)i * G + c; const int nwg = nM * nN; if (L >= (long)nwg * (nZ < 0 ? 1 : nZ)) return false;
        if (nZ > 1) { const int z = (int)(L / nwg), r = (int)(L % nwg); u.z = z; u.pm = r % nM; u.pn = r / nM; return true; }
        int wgid = (int)L; { const int q = nwg / NXCD, r = nwg % NXCD, xcd = wgid % NXCD, off = wgid / NXCD; wgid = (xcd < r ? xcd * (q + 1) : r * (q + 1) + (xcd - r) * q) + off; }
        const int nig = WGM * nN, gid = wgid / nig, fm = gid * WGM, gsz = (nM - fm) < WGM ? (nM - fm) : WGM;
        u.pm = fm + ((wgid % nig) % gsz); u.pn = (wgid % nig) / gsz; u.z = zz; return true;
    }
    __device__ __forceinline__ void a_ready(const Unit&) const {}
    __device__ __forceinline__ void done(const Unit&) const {}
};

__device__ __forceinline__ unsigned cvt_pk_bf16(float lo, float hi) { unsigned r; asm volatile("v_cvt_pk_bf16_f32 %0, %1, %2" : "=v"(r) : "v"(lo), "v"(hi)); return r; }

template <class Epi, class Sched, bool ALIGN_EPI = false, bool SP2 = false>
__device__ __forceinline__ void gemm_phase(PG8_LAS unsigned char* lds, const Gemm g, const Sched& S, const Epi& E) {
    const int tid = threadIdx.x, wid = __builtin_amdgcn_readfirstlane(tid >> 6), lane = tid & 63, wr = wid >> 2, wc = wid & 3, fr = lane & 15, fq = lane >> 4;
    const int K = g.K, nt = K / BK;
    unsigned voffA[2], voffB[2];
#pragma unroll
    for (int i = 0; i < 2; ++i) { int R, C; stage_rc(tid * 16 + i * 8192, R, C); const int Rb = Epi::PERM ? ((R & ~31) + perm32(R & 31)) : R;
        voffA[i] = (unsigned)(R * g.lda + C) * 2u; voffB[i] = (unsigned)(Rb * g.ldb + C) * 2u; }
    const size_t kstep = (size_t)(BK * 2);
    const size_t hstepA = (size_t)HALF * g.lda * 2, hstepB = (size_t)HALF * g.ldb * 2;
    const size_t tstepA = 2 * hstepA, tstepB = 2 * hstepB;
    const unsigned ldsw = (unsigned)wid * 1024u;
    const int aoff = lds_byte(wr * 64 + fr, fq * 8), boff = lds_byte(wc * 32 + fr, fq * 8);
#define PG8_SA(b, h) (((b) * 2 + (h)) * HTB)
#define PG8_SB(b, h) ((4 + (b) * 2 + (h)) * HTB)
#define PG8_STAGE(bufoff, gbase, voff) do { _Pragma("unroll") for (int _i = 0; _i < 2; ++_i) \
        __builtin_amdgcn_global_load_lds((const unsigned*)((const char*)(gbase) + (voff)[_i]), (PG8_LAS unsigned*)(lds + (bufoff) + ldsw + _i * 8192), 16, 0, 0); } while (0)
#define PG8_LDA(dst, b, h) do { _Pragma("unroll") for (int m = 0; m < 4; ++m) _Pragma("unroll") for (int k = 0; k < 2; ++k) dst[m][k] = *(const PG8_LAS bf16x8*)(lds + PG8_SA(b, h) + aoff + m * 2048 + k * 1024); } while (0)
#define PG8_LDB(dst, b, h) do { _Pragma("unroll") for (int n = 0; n < 2; ++n) _Pragma("unroll") for (int k = 0; k < 2; ++k) dst[n][k] = *(const PG8_LAS bf16x8*)(lds + PG8_SB(b, h) + boff + n * 2048 + k * 1024); } while (0)
#define PG8_MMA(ai, bj, At, Bt) do { __builtin_amdgcn_s_setprio(1); _Pragma("unroll") for (int m = 0; m < 4; ++m) _Pragma("unroll") for (int n = 0; n < 2; ++n) _Pragma("unroll") for (int k = 0; k < 2; ++k) \
        acc[ai][bj][m][n] = __builtin_amdgcn_mfma_f32_16x16x32_bf16(Bt[n][k], At[m][k], acc[ai][bj][m][n], 0, 0, 0); __builtin_amdgcn_s_setprio(0); } while (0)
#define PG8_WAIT_V(n) asm volatile("s_waitcnt vmcnt(" #n ")" ::: "memory")
#define PG8_WAIT_L(n) asm volatile("s_waitcnt lgkmcnt(" #n ")" ::: "memory")
#define PG8_BAR __builtin_amdgcn_s_barrier()
#define PG8_SCHED __builtin_amdgcn_sched_barrier(0)
    Unit cur, nxt; int ui = 0;
    if (!S.next(0, cur)) return;
    f32x4 acc[2][2][4][2];
#pragma unroll
    for (int a = 0; a < 2; ++a)
#pragma unroll
        for (int b = 0; b < 2; ++b)
#pragma unroll
            for (int m = 0; m < 4; ++m)
#pragma unroll
                for (int n = 0; n < 2; ++n) acc[a][b][m][n] = (f32x4){0.f, 0.f, 0.f, 0.f};
    bf16x8 At[4][2], B0[2][2], B1[2][2];
    const char* cA = (const char*)g.A + (size_t)cur.z * g.sA * 2 + (size_t)cur.pm * tstepA; const char* cB = (const char*)g.Bt + (size_t)cur.z * g.sB * 2 + (size_t)cur.pn * tstepB;
    S.a_ready(cur);
    if constexpr (SP2) {
        PG8_STAGE(PG8_SB(0, 0), cB, voffB); PG8_STAGE(PG8_SB(0, 1), cB + hstepB, voffB); PG8_STAGE(PG8_SA(0, 0), cA, voffA); PG8_STAGE(PG8_SA(0, 1), cA + hstepA, voffA);
        if (wr == 1) PG8_BAR;
        PG8_WAIT_V(2); PG8_BAR;
        PG8_STAGE(PG8_SB(1, 0), cB + kstep, voffB); PG8_STAGE(PG8_SA(1, 0), cA + kstep, voffA); PG8_STAGE(PG8_SB(1, 1), cB + hstepB + kstep, voffB);
        PG8_WAIT_V(6); PG8_BAR;
    } else {
        PG8_STAGE(PG8_SB(0, 0), cB, voffB); PG8_STAGE(PG8_SA(0, 0), cA, voffA); PG8_STAGE(PG8_SB(0, 1), cB + hstepB, voffB); PG8_STAGE(PG8_SA(0, 1), cA + hstepA, voffA);
        if (wr == 1) PG8_BAR;
        PG8_WAIT_V(4); PG8_BAR;
        PG8_STAGE(PG8_SB(1, 0), cB + kstep, voffB); PG8_STAGE(PG8_SA(1, 0), cA + kstep, voffA); PG8_STAGE(PG8_SB(1, 1), cB + hstepB + kstep, voffB);
        PG8_WAIT_V(6); PG8_BAR;
    }
    for (;;) {
        const bool has_next = S.next(ui + 1, nxt);
        const char* nA = has_next ? (const char*)g.A + (size_t)nxt.z * g.sA * 2 + (size_t)nxt.pm * tstepA : cA; const char* nB = has_next ? (const char*)g.Bt + (size_t)nxt.z * g.sB * 2 + (size_t)nxt.pn * tstepB : cB;
        for (int t = 0; t < nt; t += 2) {
            const bool last = (t == nt - 2);
            const char* a1 = cA + (size_t)(t + 1) * kstep;
            const char* a2 = last ? nA : cA + (size_t)(t + 2) * kstep; const char* b2 = last ? nB : cB + (size_t)(t + 2) * kstep;
            const char* a3 = a2 + kstep; const char* b3 = b2 + kstep;
            if (last && has_next) S.a_ready(nxt);
            if constexpr (SP2) {
            PG8_LDB(B0, 0, 0); PG8_LDB(B1, 0, 1); PG8_SCHED; PG8_LDA(At, 0, 0); PG8_STAGE(PG8_SA(1, 1), a1 + hstepA, voffA);
            PG8_WAIT_V(8); PG8_WAIT_L(0); PG8_BAR; PG8_MMA(0, 0, At, B0); PG8_MMA(0, 1, At, B1); PG8_BAR; PG8_SCHED;
            PG8_LDA(At, 0, 1); PG8_STAGE(PG8_SB(0, 0), b2, voffB); PG8_STAGE(PG8_SB(0, 1), b2 + hstepB, voffB); PG8_STAGE(PG8_SA(0, 0), a2, voffA);
            PG8_WAIT_V(8); PG8_WAIT_L(0); PG8_BAR; PG8_MMA(1, 0, At, B0); PG8_MMA(1, 1, At, B1); PG8_BAR; PG8_SCHED;
            PG8_LDB(B0, 1, 0); PG8_LDB(B1, 1, 1); PG8_SCHED; PG8_LDA(At, 1, 0); PG8_STAGE(PG8_SA(0, 1), a2 + hstepA, voffA);
            PG8_WAIT_V(8); PG8_WAIT_L(0); PG8_BAR; PG8_MMA(0, 0, At, B0); PG8_MMA(0, 1, At, B1); PG8_BAR; PG8_SCHED;
            PG8_LDA(At, 1, 1); PG8_STAGE(PG8_SB(1, 0), b3, voffB); PG8_STAGE(PG8_SB(1, 1), b3 + hstepB, voffB); PG8_STAGE(PG8_SA(1, 0), a3, voffA);
            PG8_WAIT_V(8); PG8_WAIT_L(0); PG8_BAR; PG8_MMA(1, 0, At, B0); PG8_MMA(1, 1, At, B1); PG8_BAR; PG8_SCHED;
            } else {
            PG8_LDB(B0, 0, 0); PG8_SCHED; PG8_LDA(At, 0, 0); PG8_STAGE(PG8_SA(1, 1), a1 + hstepA, voffA);
            PG8_WAIT_L(8); PG8_BAR; PG8_WAIT_L(0); PG8_MMA(0, 0, At, B0); PG8_BAR; PG8_SCHED;
            PG8_LDB(B1, 0, 1); PG8_STAGE(PG8_SB(0, 0), b2, voffB);
            PG8_BAR; PG8_WAIT_L(0); PG8_MMA(0, 1, At, B1); PG8_BAR;
            PG8_LDA(At, 0, 1); PG8_STAGE(PG8_SA(0, 0), a2, voffA);
            PG8_BAR; PG8_WAIT_L(0); PG8_MMA(1, 0, At, B0); PG8_BAR; PG8_SCHED;
            PG8_STAGE(PG8_SB(0, 1), b2 + hstepB, voffB);
            PG8_WAIT_V(6); PG8_BAR; PG8_MMA(1, 1, At, B1); PG8_BAR;
            PG8_LDB(B0, 1, 0); PG8_SCHED; PG8_LDA(At, 1, 0); PG8_STAGE(PG8_SA(0, 1), a2 + hstepA, voffA);
            PG8_WAIT_L(8); PG8_BAR; PG8_WAIT_L(0); PG8_MMA(0, 0, At, B0); PG8_BAR; PG8_SCHED;
            PG8_LDB(B1, 1, 1); PG8_STAGE(PG8_SB(1, 0), b3, voffB);
            PG8_BAR; PG8_WAIT_L(0); PG8_MMA(0, 1, At, B1); PG8_BAR;
            PG8_LDA(At, 1, 1); PG8_STAGE(PG8_SA(1, 0), a3, voffA);
            PG8_BAR; PG8_WAIT_L(0); PG8_MMA(1, 0, At, B0); PG8_BAR; PG8_SCHED;
            PG8_STAGE(PG8_SB(1, 1), b3 + hstepB, voffB);
            PG8_WAIT_V(6); PG8_BAR; PG8_MMA(1, 1, At, B1); PG8_BAR;
            }
        }
        if constexpr (ALIGN_EPI) { if (wr == 0) PG8_BAR; }
        if constexpr (!Epi::AFTER_DRAIN) { E(acc, cur, wr, wc, fr, fq); S.done(cur); }
        if (!has_next) break;
        if (!(Epi::TWO_PART && cur.z == 0)) {
#pragma unroll
        for (int a = 0; a < 2; ++a)
#pragma unroll
            for (int b = 0; b < 2; ++b)
#pragma unroll
                for (int m = 0; m < 4; ++m)
#pragma unroll
                    for (int n = 0; n < 2; ++n) acc[a][b][m][n] = (f32x4){0.f, 0.f, 0.f, 0.f};
        }
        cur = nxt; cA = nA; cB = nB; ++ui;
        if constexpr (ALIGN_EPI) { if (wr == 1) PG8_BAR; }
    }
    PG8_WAIT_V(0);
    if constexpr (!ALIGN_EPI) { if (wr == 0) PG8_BAR; }
    PG8_BAR;
    if constexpr (Epi::AFTER_DRAIN) { E.fused(acc, cur, wr, wc, fr, fq, lds, wid, lane); S.done(cur); }
#undef PG8_SA
#undef PG8_SB
#undef PG8_STAGE
#undef PG8_LDA
#undef PG8_LDB
#undef PG8_MMA
#undef PG8_WAIT_V
#undef PG8_WAIT_L
#undef PG8_BAR
#undef PG8_SCHED
}
}

constexpr int NWAVES = 8, NTHR = 512;
constexpr int DM = 2048, DLRU = 1024, DS5 = 1024, DFF = 8192, NZ = 3072;
constexpr int MP = 8192, MS = 512, MT = MP + MS;
constexpr int SEQ = 2048, NB = 4, NSEQ = 128;
constexpr int NG = 64, NPAIR = 32, LCH = 16, NCH = 128;
constexpr int A2_LD = 768, A2_ROWS = 512;
constexpr float EPS = 1e-6f;

constexpr size_t MiB = 1u << 20;
constexpr size_t WS_CTL = 0, CTL_BYTES = 1 * MiB;
constexpr size_t CTL_SSQA = 0, CTL_SSQB = 64 * 1024, CTL_SSQ1 = 128 * 1024, CTL_SSQ2 = 192 * 1024, CTL_CNT = 256 * 1024, CTL_BAR = 512 * 1024;
constexpr size_t WS_SMALL = 1 * MiB;
constexpr size_t SM_WGA = WS_SMALL, SM_WGX = SM_WGA + 131072;
constexpr size_t SM_AGG = SM_WGX + 131072;
constexpr size_t SM_RS0 = SM_AGG + 524288;
constexpr size_t SM_E1 = SM_RS0 + 65536, SM_E16 = SM_E1 + 32768;
constexpr size_t SM_BBAR = SM_E16 + 32768;
constexpr size_t SM_SP = SM_BBAR + 524288;
static_assert(SM_SP + 4096 <= 4 * MiB, "small region");
constexpr size_t WS_WUP = 4 * MiB, WS_WDOWN = 36 * MiB, WS_XB = 68 * MiB;
constexpr size_t WS_H = 102 * MiB;
constexpr size_t WS_WIN = 102 * MiB, WS_WGLU = 114 * MiB, WS_WOUT = 116 * MiB;
constexpr size_t WS_M1 = 124 * MiB;
constexpr size_t WS_KG = 132 * MiB;
constexpr size_t WS_A2 = 156 * MiB;
constexpr size_t WS_US = 180 * MiB;
constexpr size_t WS_S = 182 * MiB;
constexpr size_t WS_MIX = 198 * MiB;
constexpr size_t WS_END = 246 * MiB;
constexpr size_t WS_AGG = 238 * MiB;
constexpr size_t WS_HIN = 242 * MiB;
static_assert(WS_XB + (size_t)MT * DM * 2 <= WS_H && WS_H + (size_t)MT * DFF * 2 <= WS_AGG && WS_MIX + (size_t)MT * DM * 2 <= WS_AGG, "ws map");
constexpr size_t DO_XLRU = 0, DO_GLRU = (size_t)MT * DLRU * 4, DO_G = DO_GLRU + (size_t)MT * DLRU * 2;
constexpr size_t O_Y = 0, O_CONVP = (size_t)MT * DM, O_LRUP = O_CONVP + 4 * 3 * 1024, O_REP = O_LRUP + 4 * 1024, O_IMP = O_REP + 4 * 64 * 64,
                 O_CONVS = O_IMP + 4 * 64 * 64, O_LRUS = O_CONVS + 128 * 3 * 1024, O_RES = O_LRUS + 128 * 1024, O_IMS = O_RES + 128 * 64 * 64, O_END = O_IMS + 128 * 64 * 64;

constexpr int RING_BYTES = 131072, MISC_OFF = RING_BYTES, LDS_BYTES = 147456;

#define LAS __attribute__((address_space(3)))
typedef unsigned short bf16;
typedef unsigned v4u __attribute__((ext_vector_type(4)));
typedef unsigned v2u __attribute__((ext_vector_type(2)));
typedef float f32x4 __attribute__((ext_vector_type(4)));
typedef short bf16x8 __attribute__((ext_vector_type(8)));
#define LDS_WAIT() asm volatile("s_waitcnt lgkmcnt(0)" ::: "memory")

__device__ __forceinline__ unsigned f2bf(float f) { unsigned u = __builtin_bit_cast(unsigned, f); return (u + 0x7fffu + ((u >> 16) & 1u)) >> 16; }
__device__ __forceinline__ unsigned pk2(float lo, float hi) { return f2bf(lo) | (f2bf(hi) << 16); }
__device__ __forceinline__ float bf2f(unsigned b) { return __builtin_bit_cast(float, b << 16); }
__device__ __forceinline__ float bflo(unsigned w) { return __builtin_bit_cast(float, w << 16); }
__device__ __forceinline__ float bfhi(unsigned w) { return __builtin_bit_cast(float, w & 0xffff0000u); }
__device__ __forceinline__ float sigmoidf_(float x) { return __builtin_amdgcn_rcpf(1.f + __expf(-x)); }
__device__ __forceinline__ float gelu_tanh(float x) { const float u = 1.5957691216f * (x + 0.044715f * x * x * x); return x * __builtin_amdgcn_rcpf(1.f + __expf(-u)); }
__device__ __forceinline__ float wave_sum(float v) {
#pragma unroll
    for (int o = 1; o < 64; o <<= 1) v += __shfl_xor(v, o);
    return v;
}
__device__ __forceinline__ void sincos_d(double x, double& s, double& c) {
    const double q = rint(x * 0.63661977236758134308), r = (x - q * 1.57079632679489655800) - q * 6.12323399573676603587e-17, r2 = r * r;
    double sr = 1.0 - r2 / 210.0; sr = 1.0 - r2 / 156.0 * sr; sr = 1.0 - r2 / 110.0 * sr; sr = 1.0 - r2 / 72.0 * sr; sr = 1.0 - r2 / 42.0 * sr; sr = 1.0 - r2 / 20.0 * sr; sr = 1.0 - r2 / 6.0 * sr; sr *= r;
    double cr = 1.0 - r2 / 182.0; cr = 1.0 - r2 / 132.0 * cr; cr = 1.0 - r2 / 90.0 * cr; cr = 1.0 - r2 / 56.0 * cr; cr = 1.0 - r2 / 30.0 * cr; cr = 1.0 - r2 / 12.0 * cr; cr = 1.0 - r2 / 2.0 * cr;
    const int qi = ((int)q) & 3;
    s = (qi == 0) ? sr : (qi == 1) ? cr : (qi == 2) ? -sr : -cr;
    c = (qi == 0) ? cr : (qi == 1) ? -sr : (qi == 2) ? -cr : sr;
}

namespace pg8 {
#define EPI_ROWS_BEGIN const int row0 = u.pm * BM + wr * 64 + fr; _Pragma("unroll") for (int ai = 0; ai < 2; ++ai) _Pragma("unroll") for (int m = 0; m < 4; ++m) { const int row = row0 + ai * HALF + m * 16;
#define EPI_ROWS_END }
__device__ __forceinline__ float fq_sum(float v) { v += __shfl_xor(v, 16); v += __shfl_xor(v, 32); return v; }
__device__ __forceinline__ float sq8(const f32x4& a, const f32x4& b) { return (a[0] * a[0] + a[1] * a[1]) + (a[2] * a[2] + a[3] * a[3]) + (b[0] * b[0] + b[1] * b[1]) + (b[2] * b[2] + b[3] * b[3]); }
__device__ __forceinline__ u32x4 pack8(const f32x4& a, const f32x4& b) { u32x4 w; w.x = cvt_pk_bf16(a[0], a[1]); w.y = cvt_pk_bf16(a[2], a[3]); w.z = cvt_pk_bf16(b[0], b[1]); w.w = cvt_pk_bf16(b[2], b[3]); return w; }

struct EpiZ {
    static constexpr bool PERM = true, AFTER_DRAIN = false, TWO_PART = false;
    const float* rs0; float* xlru; bf16_t* glru; bf16_t* A2; bf16_t* us;
    __device__ __forceinline__ void operator()(const f32x4 (&acc)[2][2][4][2], const Unit& u, int wr, int wc, int fr, int fq) const {
        const int colt = u.pn * BM + wc * 32 + 8 * fq;
        EPI_ROWS_BEGIN
            const float s = rs0[row];
#pragma unroll
            for (int bj = 0; bj < 2; ++bj) { const int col = colt + bj * HALF; const f32x4 v0 = acc[ai][bj][m][0] * s, v1 = acc[ai][bj][m][1] * s;
                if (u.pn < 4) { float* p = xlru + (size_t)row * DLRU + col; *(f32x4*)p = v0; *(f32x4*)(p + 4) = v1; }
                else if (u.pn < 8) { *(u32x4*)(glru + (size_t)row * DLRU + (col - 1024)) = pack8(v0, v1); }
                else { const int c = col - 2048;
                    if (u.pm < 32) *(u32x4*)(A2 + ((size_t)(c >> 5) * A2_ROWS + (row >> 4)) * A2_LD + (row & 15) * 32 + (c & 31)) = pack8(v0, v1);
                    else *(u32x4*)(us + (size_t)(row - MP) * DS5 + c) = pack8(v0, v1); } }
        EPI_ROWS_END
    }
};
struct EpiS {
    static constexpr bool PERM = true, AFTER_DRAIN = false, TWO_PART = false;
    float* S;
    __device__ __forceinline__ void operator()(const f32x4 (&acc)[2][2][4][2], const Unit& u, int wr, int wc, int fr, int fq) const {
        const int colt = u.pn * BM + wc * 32 + 8 * fq;
        EPI_ROWS_BEGIN
#pragma unroll
            for (int bj = 0; bj < 2; ++bj) { float* p = S + ((size_t)u.z * A2_ROWS + row) * 256 + colt + bj * HALF; *(f32x4*)p = acc[ai][bj][m][0]; *(f32x4*)(p + 4) = acc[ai][bj][m][1]; }
        EPI_ROWS_END
    }
};
struct EpiY {
    static constexpr bool PERM = true, AFTER_DRAIN = false, TWO_PART = false;
    bf16_t* gbuf;
    __device__ __forceinline__ void operator()(const f32x4 (&acc)[2][2][4][2], const Unit& u, int wr, int wc, int fr, int fq) const {
        EPI_ROWS_BEGIN
#pragma unroll
            for (int bj = 0; bj < 2; ++bj) { const int j = 8 * u.pn + 4 * bj + wc; f32x4 v0 = acc[ai][bj][m][0], v1 = acc[ai][bj][m][1];
#pragma unroll
                for (int e = 0; e < 4; ++e) { v0[e] = gelu_tanh(v0[e]); v1[e] = gelu_tanh(v1[e]); }
                *(u32x4*)(gbuf + (size_t)(row * 16 + j) * DS5 + u.z * 32 + 8 * fq) = pack8(v0, v1); }
        EPI_ROWS_END
    }
};
struct EpiGlu {
    static constexpr bool PERM = true, AFTER_DRAIN = false, TWO_PART = false;
    const bf16_t* gbuf; const float* bglu; bf16_t* mix; float* ssqb;
    __device__ __forceinline__ void operator()(const f32x4 (&acc)[2][2][4][2], const Unit& u, int wr, int wc, int fr, int fq) const {
        const int colt = u.pn * BM + wc * 32 + 8 * fq;
        EPI_ROWS_BEGIN
            float sum = 0.f;
#pragma unroll
            for (int bj = 0; bj < 2; ++bj) { const int col = colt + bj * HALF; const u32x4 gw = *(const u32x4*)(gbuf + (size_t)row * DS5 + col);
                const f32x4 b0 = *(const f32x4*)(bglu + col), b1 = *(const f32x4*)(bglu + col + 4);
                f32x4 v0 = acc[ai][bj][m][0] + b0, v1 = acc[ai][bj][m][1] + b1;
                v0[0] = bflo(gw.x) * sigmoidf_(v0[0]); v0[1] = bfhi(gw.x) * sigmoidf_(v0[1]); v0[2] = bflo(gw.y) * sigmoidf_(v0[2]); v0[3] = bfhi(gw.y) * sigmoidf_(v0[3]);
                v1[0] = bflo(gw.z) * sigmoidf_(v1[0]); v1[1] = bfhi(gw.z) * sigmoidf_(v1[1]); v1[2] = bflo(gw.w) * sigmoidf_(v1[2]); v1[3] = bfhi(gw.w) * sigmoidf_(v1[3]);
                sum += sq8(v0, v1);
                *(u32x4*)(mix + (size_t)row * DM + 1024 + col) = pack8(v0, v1); }
            sum = fq_sum(sum); if (fq == 0) atomicAdd(ssqb + row, sum);
        EPI_ROWS_END
    }
};
struct EpiOut {
    static constexpr bool PERM = true, AFTER_DRAIN = false, TWO_PART = true;
    const float* ssqa; const float* ssqb; const float* xp; const float* xs; float* x1; bf16_t* x1b; float* ssq1;
    __device__ __forceinline__ void operator()(f32x4 (&acc)[2][2][4][2], const Unit& u, int wr, int wc, int fr, int fq) const {
        const int colt = u.pn * BM + wc * 32 + 8 * fq;
        if (u.z == 0) {
            EPI_ROWS_BEGIN
                const float ra = ssqa[row] * (1.f / DLRU) + EPS, rb = ssqb[row] * (1.f / DS5) + EPS, ratio = sqrtf(rb / ra);
#pragma unroll
                for (int bj = 0; bj < 2; ++bj) { acc[ai][bj][m][0] = acc[ai][bj][m][0] * ratio; acc[ai][bj][m][1] = acc[ai][bj][m][1] * ratio; }
            EPI_ROWS_END
        } else {
            EPI_ROWS_BEGIN
                const float rb = 1.f / sqrtf(ssqb[row] * (1.f / DS5) + EPS);
                const float* xr = (row < MP) ? xp + (size_t)row * DM : xs + (size_t)(row - MP) * DM;
                float sum = 0.f;
#pragma unroll
                for (int bj = 0; bj < 2; ++bj) { const int col = colt + bj * HALF;
                    const f32x4 v0 = *(const f32x4*)(xr + col) + acc[ai][bj][m][0] * rb, v1 = *(const f32x4*)(xr + col + 4) + acc[ai][bj][m][1] * rb;
                    *(u32x4*)(x1b + (size_t)row * DM + col) = pack8(v0, v1);
                    sum += sq8(v0, v1); }
                sum = fq_sum(sum); if (fq == 0) atomicAdd(ssq1 + row, sum);
            EPI_ROWS_END
        }
    }
};
struct EpiUp {
    static constexpr bool PERM = true, AFTER_DRAIN = false, TWO_PART = false;
    const float* ssq1; bf16_t* h;
    __device__ __forceinline__ void operator()(const f32x4 (&acc)[2][2][4][2], const Unit& u, int wr, int wc, int fr, int fq) const {
        const int colt = u.pn * BM + wc * 32 + 8 * fq;
        EPI_ROWS_BEGIN
            const float rs = 1.f / sqrtf(ssq1[row] * (1.f / DM) + EPS);
#pragma unroll
            for (int bj = 0; bj < 2; ++bj) { f32x4 v0 = acc[ai][bj][m][0] * rs, v1 = acc[ai][bj][m][1] * rs;
#pragma unroll
                for (int e = 0; e < 4; ++e) { const float a = fmaxf(v0[e], 0.f), b = fmaxf(v1[e], 0.f); v0[e] = a * a; v1[e] = b * b; }
                *(u32x4*)(h + (size_t)row * DFF + colt + bj * HALF) = pack8(v0, v1); }
        EPI_ROWS_END
    }
};
struct EpiDown {
    static constexpr bool PERM = true, AFTER_DRAIN = false, TWO_PART = false;
    float* x; const bf16_t* x1b; float mul;
    __device__ __forceinline__ void operator()(const f32x4 (&acc)[2][2][4][2], const Unit& u, int wr, int wc, int fr, int fq) const {
        const int colt = u.pn * BM + wc * 32 + 8 * fq;
        EPI_ROWS_BEGIN
#pragma unroll
            for (int bj = 0; bj < 2; ++bj) { float* p = x + (size_t)row * DM + colt + bj * HALF; const u32x4 w = *(const u32x4*)(x1b + (size_t)row * DM + colt + bj * HALF);
                const f32x4 v0 = (f32x4){bflo(w.x), bfhi(w.x), bflo(w.y), bfhi(w.y)} + acc[ai][bj][m][0] * mul, v1 = (f32x4){bflo(w.z), bfhi(w.z), bflo(w.w), bfhi(w.w)} + acc[ai][bj][m][1] * mul;
                (void)p; *(u32x4*)((bf16_t*)(x + (size_t)row * DM) + colt + bj * HALF) = pack8(v0, v1); }
        EPI_ROWS_END
    }
};
struct EpiPart {
    static constexpr bool PERM = true, AFTER_DRAIN = false, TWO_PART = false;
    float* P0; float* P1; int nsl;
    __device__ __forceinline__ void operator()(const f32x4 (&acc)[2][2][4][2], const Unit& u, int wr, int wc, int fr, int fq) const {
        const int t = ((u.pm - 32) * 8 + u.pn) * nsl + u.z, half = 8 * nsl;
        float* base = (t < half ? P0 + (size_t)t * 65536 : P1 + (size_t)(t - half) * 65536) + wc * 32 + 8 * fq;
        const int row0 = wr * 64 + fr;
#pragma unroll
        for (int ai = 0; ai < 2; ++ai)
#pragma unroll
            for (int m = 0; m < 4; ++m) { const int row = row0 + ai * HALF + m * 16;
#pragma unroll
                for (int bj = 0; bj < 2; ++bj) { float* p = base + row * 256 + bj * HALF; *(f32x4*)p = acc[ai][bj][m][0]; *(f32x4*)(p + 4) = acc[ai][bj][m][1]; } }
    }
};
struct EpiPartB {
    static constexpr bool PERM = true, AFTER_DRAIN = false, TWO_PART = false;
    bf16_t* P0; bf16_t* P1; int nsl;
    __device__ __forceinline__ void operator()(const f32x4 (&acc)[2][2][4][2], const Unit& u, int wr, int wc, int fr, int fq) const {
        const int t = ((u.pm - 32) * 8 + u.pn) * nsl + u.z, half = 8 * nsl;
        bf16_t* base = (t < half ? P0 + (size_t)t * 65536 : P1 + (size_t)(t - half) * 65536) + wc * 32 + 8 * fq;
        const int row0 = wr * 64 + fr;
#pragma unroll
        for (int ai = 0; ai < 2; ++ai)
#pragma unroll
            for (int m = 0; m < 4; ++m) { const int row = row0 + ai * HALF + m * 16;
#pragma unroll
                for (int bj = 0; bj < 2; ++bj) *(u32x4*)(base + row * 256 + bj * HALF) = pack8(acc[ai][bj][m][0], acc[ai][bj][m][1]); }
    }
};
struct SliceOrder {
    int c, nsl, G;
    __device__ bool next(int i, Unit& u) const { const int L = i * G + c; if (L >= 16 * nsl) return false; const int j = L / nsl; u.pm = 32 + (j >> 3); u.pn = j & 7; u.z = L - j * nsl; return true; }
    __device__ __forceinline__ void a_ready(const Unit&) const {}
    __device__ __forceinline__ void done(const Unit&) const {}
};
}

#define XB_TMO      128
#define XB_XCNT(j)  (256  + 64 * (j))
#define XB_XSUB(j)  (1280 + 64 * (j))
#define XB_XGEN(j)  (2304 + 64 * (j))
#define XB_TOP      3328
#define XB_TOPGEN   3392
#define XCD_BAR_WORDS 3456
#define XB_SPIN_CAP (1u << 18)

__device__ __forceinline__ unsigned xb_ld(unsigned* p)              { return __hip_atomic_load(p, __ATOMIC_RELAXED, __HIP_MEMORY_SCOPE_AGENT); }
__device__ __forceinline__ unsigned xb_add(unsigned* p, unsigned v) { return __hip_atomic_fetch_add(p, v, __ATOMIC_RELAXED, __HIP_MEMORY_SCOPE_AGENT); }
__device__ __forceinline__ unsigned xb_xcc_id() { return (unsigned)__builtin_amdgcn_s_getreg((3 << 11) | 20) & 0xFu; }
#define XB_SPIN(cond, bar) do { unsigned _sp = 0; while (cond) { __builtin_amdgcn_s_sleep(1); \
    if ((++_sp & 255u) == 0u) { if (xb_ld(&(bar)[XB_TMO])) break; if (_sp > XB_SPIN_CAP) { atomicAdd(&(bar)[XB_TMO], 1u); break; } } } } while (0)

struct XcdBarrier {
    unsigned* bar; unsigned x;
    volatile LAS unsigned* st;
};

__device__ __forceinline__ XcdBarrier xcd_barrier_post(unsigned* bar, volatile LAS unsigned* st) {
    XcdBarrier b; b.bar = bar; b.x = xb_xcc_id(); b.st = st;
    if (threadIdx.x == 0) (void)xb_add(&bar[XB_XCNT(b.x)], 1u);
    return b;
}
__device__ __forceinline__ void xcd_barrier_complete(unsigned* bar, unsigned x, unsigned& nloc, unsigned& nx) {
    const unsigned G = gridDim.x * gridDim.y * gridDim.z;
    unsigned sum, cnt, mine, sp = 0u;
    for (;;) {
        sum = 0u; cnt = 0u; mine = 0u;
#pragma unroll
        for (unsigned j = 0; j < 16; ++j) { const unsigned c = xb_ld(&bar[XB_XCNT(j)]); sum += c; cnt += (c > 0u) ? 1u : 0u; mine = (j == x) ? c : mine; }
        if (sum == G) break;
        __builtin_amdgcn_s_sleep(1);
        if ((++sp & 255u) == 0u) { if (xb_ld(&bar[XB_TMO])) break; if (sp > XB_SPIN_CAP) { atomicAdd(&bar[XB_TMO], 1u); break; } }
    }
    nloc = mine > 0u ? mine : 1u; nx = cnt > 0u ? cnt : 1u;
}

__device__ __forceinline__ void xcd_barrier(const XcdBarrier& b) {
    asm volatile("s_waitcnt vmcnt(0)" ::: "memory");
    __syncthreads();
    if (threadIdx.x == 0) {
        unsigned* bar = b.bar;
        __builtin_amdgcn_s_waitcnt(0);
        unsigned nloc = b.st[0], nx = b.st[1];
        if (nloc == 0u) { xcd_barrier_complete(bar, b.x, nloc, nx); b.st[0] = nloc; b.st[1] = nx; }
        const unsigned old = xb_add(&bar[XB_XSUB(b.x)], 1u);
        const unsigned gen = old / nloc;
        if (old + 1u == (gen + 1u) * nloc) {
            __builtin_amdgcn_fence(__ATOMIC_RELEASE, "agent");
            asm volatile("s_waitcnt vmcnt(0)" ::: "memory");
            const unsigned og = xb_add(&bar[XB_TOP], 1u);
            const unsigned tg = og / nx;
            if (og + 1u == (tg + 1u) * nx) xb_add(&bar[XB_TOPGEN], 1u);
            else XB_SPIN(xb_ld(&bar[XB_TOPGEN]) == tg, bar);
            __builtin_amdgcn_fence(__ATOMIC_ACQUIRE, "agent");
            xb_add(&bar[XB_XGEN(b.x)], 1u);
            asm volatile("s_waitcnt vmcnt(0)" ::: "memory");
        } else {
            XB_SPIN(xb_ld(&bar[XB_XGEN(b.x)]) == gen, bar);
            __builtin_amdgcn_fence(__ATOMIC_ACQUIRE, "agent");
            asm volatile("s_waitcnt vmcnt(0)" ::: "memory");
        }
    }
    __syncthreads();
}


struct Args { const float* in[32]; float* out; unsigned char* ws; int ph_lo, ph_hi; };
struct Frame {
    LAS unsigned char* lds;
    int tid, lane, wave, G, bid;
    float* out; unsigned char* ws;
};
constexpr int PTR_OFF = MISC_OFF + 256;
__device__ __forceinline__ const float* inp(const Frame& F, int i) {
    const LAS unsigned* T = (const LAS unsigned*)(F.lds + PTR_OFF);
    const unsigned lo = __builtin_amdgcn_readfirstlane(T[2 * i]), hi = __builtin_amdgcn_readfirstlane(T[2 * i + 1]);
    return (const float*)(((unsigned long long)hi << 32) | lo);
}
enum { I_XP = 0, I_XS, I_SCONV, I_SLRU, I_SRE, I_SIM, I_NMIX, I_WIN, I_CONVW, I_CONVB, I_WGA, I_BGA, I_WGX, I_BGX, I_LAMBDA, I_ARE, I_AIM, I_LOGSTEP, I_BRE, I_BIM, I_CRE, I_CIM,
       I_D, I_WGLU, I_BGLU, I_NOUTA, I_NOUTB, I_WOUT, I_NMLP, I_WUP, I_WDOWN, I_NFINAL };

__device__ __forceinline__ void tr_item(const float* __restrict__ W, const float* __restrict__ sc, int K, int N, bf16* __restrict__ WT, int item, int wave, int lane) {
    const int nblk = N >> 8, kb = item / nblk, nb = item - kb * nblk, k0 = kb * 64 + wave * 8, n0 = nb * 256 + 4 * lane;
    f32x4 v[8];
#pragma unroll
    for (int j = 0; j < 8; ++j) v[j] = *(const f32x4*)(W + (size_t)(k0 + j) * N + n0);
    if (sc) {
#pragma unroll
        for (int j = 0; j < 8; ++j) v[j] = v[j] * sc[k0 + j];
    }
#pragma unroll
    for (int e = 0; e < 4; ++e) { v4u o; o.x = pk2(v[0][e], v[1][e]); o.y = pk2(v[2][e], v[3][e]); o.z = pk2(v[4][e], v[5][e]); o.w = pk2(v[6][e], v[7][e]);
        *(v4u*)(WT + (size_t)(n0 + e) * K + k0) = o; }
}
__device__ __forceinline__ void tr_items_dyn(Frame& F, const float* W, const float* sc, int K, int N, bf16* WT, unsigned* counter, const float* sc_hi = nullptr) {
    LAS int* slot = (LAS int*)(F.lds + MISC_OFF + 64);
    const int nitems = (K >> 6) * (N >> 8);
    for (;;) {
        if (F.tid == 0) *slot = (int)atomicAdd(counter, 1u);
        __syncthreads();
        const int it = *slot;
        __syncthreads();
        if (it >= nitems) break;
        tr_item(W, (sc_hi && (it / (N >> 8)) >= 16) ? sc_hi - 1024 : sc, K, N, WT, it, F.wave, F.lane);
    }
}
__device__ __forceinline__ void p0_x_row(const float* xrow, bf16* orow, float* rs, int lane) {
    const f32x4* xr = (const f32x4*)xrow + lane; f32x4 v[8]; float s = 0.f;
#pragma unroll
    for (int j = 0; j < 8; ++j) { v[j] = xr[64 * j]; s += (v[j].x * v[j].x + v[j].y * v[j].y) + (v[j].z * v[j].z + v[j].w * v[j].w); }
    s = wave_sum(s);
    if (lane == 0) *rs = 1.f / sqrtf(s * (1.f / DM) + EPS);
    v2u* o8 = (v2u*)orow + lane;
#pragma unroll
    for (int j = 0; j < 8; ++j) { v2u w; w.x = pk2(v[j].x, v[j].y); w.y = pk2(v[j].z, v[j].w); o8[64 * j] = w; }
}
__device__ __forceinline__ void p0_x_row(const float* xrow, bf16* orow, float* rs, int lane);
__device__ __forceinline__ void p0_s5_group(Frame& F, int g, int part, bool xrows) {
    const float* are = inp(F, I_ARE) + g * 64; const float* aim = inp(F, I_AIM) + g * 64;
    const float* bre = inp(F, I_BRE) + g * 1024; const float* bim = inp(F, I_BIM) + g * 1024;
    const float* cre = inp(F, I_CRE) + g * 1024; const float* cim = inp(F, I_CIM) + g * 1024;
    const float* dd = inp(F, I_D) + g * 16;
    LAS float* Ere = (LAS float*)F.lds;
    LAS float* Eim = Ere + 17 * 64;
    LAS float* Bre = Eim + 17 * 64;
    LAS float* Bim = Bre + 1024;
    LAS float* Cre = Bim + 1024;
    LAS float* Cim = Cre + 1024;
    LAS float* Kt = Cim + 1024;
    const int tid = F.tid;
    const double dt = exp((double)inp(F, I_LOGSTEP)[g]);
    if (tid < 64) {
        const int p = tid; const double lr = (double)are[p], li = (double)aim[p];
        double s1, c1; sincos_d(li * dt, s1, c1); const double mg = exp(lr * dt); const double e1r = mg * c1, e1i = mg * s1;
        double er = 1.0, ei = 0.0;
        for (int k = 0; k <= 16; ++k) { Ere[k * 64 + p] = (float)er; Eim[k * 64 + p] = (float)ei; const double nr = er * e1r - ei * e1i, ni = er * e1i + ei * e1r; er = nr; ei = ni; }
        const double nr_ = e1r - 1.0, ni_ = e1i, den = lr * lr + li * li; const double fr_ = (nr_ * lr + ni_ * li) / den, fi_ = (ni_ * lr - nr_ * li) / den;
        if (part == 0) { float* e1 = (float*)(F.ws + SM_E1) + (g * 64 + p) * 2; e1[0] = (float)e1r; e1[1] = (float)e1i;
        float* e16 = (float*)(F.ws + SM_E16) + (g * 64 + p) * 2; e16[0] = Ere[16 * 64 + p]; e16[1] = Eim[16 * 64 + p]; }
        float* bb = (float*)(F.ws + SM_BBAR) + (size_t)(g * 64 + p) * 32;
        for (int c = 0; c < 16; ++c) { const double br = (double)bre[p * 16 + c], bi = (double)bim[p * 16 + c]; const float xr = (float)(fr_ * br - fi_ * bi), xi = (float)(fr_ * bi + fi_ * br);
            Bre[p * 16 + c] = xr; Bim[p * 16 + c] = xi; if (part == 0) { bb[2 * c] = xr; bb[2 * c + 1] = xi; } }
    }
    for (int i = tid; i < 1024; i += NTHR) { Cre[i] = cre[i]; Cim[i] = cim[i]; }
    if (xrows && F.wave > 0) {
        bf16* XB = (bf16*)(F.ws + WS_XB); float* rs0 = (float*)(F.ws + SM_RS0);
        for (int m = F.bid * 7 + (F.wave - 1); m < MT; m += F.G * 7) { const float* xr = (m < MP) ? inp(F, I_XP) + (size_t)m * DM : inp(F, I_XS) + (size_t)(m - MP) * DM; p0_x_row(xr, XB + (size_t)m * DM, rs0 + m, F.lane); }
    }
    __syncthreads();
    for (int e = tid; e < 1024; e += NTHR) { const int d = e >> 6, co = 4 * part + ((e >> 4) & 3), ci = e & 15; float acc = 0.f;
        for (int p = 0; p < 64; ++p) { const float cr = Cre[co * 64 + p], ci_ = Cim[co * 64 + p], er = Ere[d * 64 + p], ei = Eim[d * 64 + p], br = Bre[p * 16 + ci], bi = Bim[p * 16 + ci];
            const float wr_ = cr * er - ci_ * ei, wi_ = cr * ei + ci_ * er; acc += wr_ * br - wi_ * bi; }
        if (d == 0 && co == ci) acc += dd[co];
        Kt[e] = acc; }
    __syncthreads();
    const int z = g >> 1, gl = g & 1;
    bf16* KG = (bf16*)(F.ws + WS_KG) + (size_t)z * 512 * 768;
    for (int it = tid; it < 64 * 96; it += NTHR) { const int rr = it / 96, kc = it % 96; const int j = rr >> 2, col = rr & 3, co = 4 * part + col, n = j * 32 + gl * 16 + co, k0 = kc * 8; float v[8];
#pragma unroll
        for (int e = 0; e < 8; ++e) { const int k = k0 + e; float x = 0.f;
            if (k < 512) { const int i = k >> 5, glk = (k >> 4) & 1, ci = k & 15; if (glk == gl && j >= i) x = Kt[((j - i) * 4 + col) * 16 + ci]; }
            else { const int kk = k - 512, glk = kk >> 7, q = kk & 127, p = q & 63; if (glk == gl) { const float cr = Cre[co * 64 + p], ci_ = Cim[co * 64 + p], er = Ere[(j + 1) * 64 + p], ei = Eim[(j + 1) * 64 + p];
                    x = (q < 64) ? (cr * er - ci_ * ei) : -(cr * ei + ci_ * er); } }
            v[e] = x; }
        v4u o; o.x = pk2(v[0], v[1]); o.y = pk2(v[2], v[3]); o.z = pk2(v[4], v[5]); o.w = pk2(v[6], v[7]);
        *(v4u*)(KG + (size_t)n * 768 + k0) = o; }
    bf16* M1 = (bf16*)(F.ws + WS_M1) + (size_t)z * 256 * 512;
    for (int it = tid; it < 32 * 64; it += NTHR) { const int q = 32 * part + (it >> 6), kc = it & 63, n = gl * 128 + q, p = q & 63, k0 = kc * 8; float v[8];
#pragma unroll
        for (int e = 0; e < 8; ++e) { const int k = k0 + e, i = k >> 5, glk = (k >> 4) & 1, ch = k & 15; float x = 0.f;
            if (glk == gl) { const float er = Ere[(15 - i) * 64 + p], ei = Eim[(15 - i) * 64 + p], br = Bre[p * 16 + ch], bi = Bim[p * 16 + ch]; x = (q < 64) ? (er * br - ei * bi) : (er * bi + ei * br); }
            v[e] = x; }
        v4u o; o.x = pk2(v[0], v[1]); o.y = pk2(v[2], v[3]); o.z = pk2(v[4], v[5]); o.w = pk2(v[6], v[7]);
        *(v4u*)(M1 + (size_t)n * 512 + k0) = o; }
    __syncthreads();
}

#ifndef P0_MASK
#define P0_MASK 7
#endif
__device__ __forceinline__ void p0_prologue(Frame& F, int mask) {
    bf16* WinT = (bf16*)(F.ws + WS_WIN);
    const bool xfused = (F.G == 256) && ((mask & 5) == 5);
    if (mask & 1) for (int it = F.bid; it < 256; it += F.G) p0_s5_group(F, it >> 2, it & 3, xfused);
    constexpr int I_1 = (DM / 64) * (NZ / 256);
    if (mask & 2) for (int it = F.bid; it < I_1; it += F.G) tr_item(inp(F, I_WIN), inp(F, I_NMIX), DM, NZ, WinT, it, F.wave, F.lane);
    const int gw = F.bid * NWAVES + F.wave, NGW = F.G * NWAVES;
    bf16* XB = (bf16*)(F.ws + WS_XB); float* rs0 = (float*)(F.ws + SM_RS0);
    if ((mask & 4) && !xfused) for (int m = gw; m < MT; m += NGW) { const float* xr = (m < MP) ? inp(F, I_XP) + (size_t)m * DM : inp(F, I_XS) + (size_t)(m - MP) * DM; p0_x_row(xr, XB + (size_t)m * DM, rs0 + m, F.lane); }
    bf16* WGA = (bf16*)(F.ws + SM_WGA); bf16* WGX = (bf16*)(F.ws + SM_WGX);
    for (int e = F.bid * NTHR + F.tid; e < DLRU; e += F.G * NTHR) ((float*)(F.ws + SM_SP))[e] = log1pf(__expf(-inp(F, I_LAMBDA)[e]));
    for (int e = F.bid * NTHR + F.tid; e < 65536; e += F.G * NTHR) { const int h = e >> 12, j = (e >> 6) & 63, i = e & 63; WGA[e] = (bf16)f2bf(inp(F, I_WGA)[(h * 64 + i) * 64 + j]); WGX[e] = (bf16)f2bf(inp(F, I_WGX)[(h * 64 + i) * 64 + j]); }
}

__device__ __forceinline__ void s5_sample_item(Frame& F, int item) {
    const int g = item >> 5, sq0 = (item & 31) * 4, lane = F.lane, p = lane;
    LAS float* hs = (LAS float*)(F.lds + F.wave * 2048);
    const float* e1 = (const float*)(F.ws + SM_E1) + (g * 64 + p) * 2; const float ar = e1[0], ai = e1[1];
    const float* bb = (const float*)(F.ws + SM_BBAR) + (size_t)(g * 64 + p) * 32;
    float br[16], bi[16];
#pragma unroll
    for (int c = 0; c < 16; ++c) { br[c] = bb[2 * c]; bi[c] = bb[2 * c + 1]; }
    const int cc = lane & 15, part = lane >> 4;
    float cr[16], ci[16];
#pragma unroll
    for (int j = 0; j < 16; ++j) { cr[j] = inp(F, I_CRE)[(g * 16 + cc) * 64 + part * 16 + j]; ci[j] = inp(F, I_CIM)[(g * 16 + cc) * 64 + part * 16 + j]; }
    const float dv = inp(F, I_D)[g * 16 + cc];
    const bf16* us = (const bf16*)(F.ws + WS_US); bf16* gbuf = (bf16*)((unsigned char*)F.out + DO_G);
    float bur[16], bui[16], ucc[16];
#pragma unroll
    for (int t = 0; t < 16; ++t) { const int tok = sq0 * 4 + t;
        const v4u u0 = *(const v4u*)(us + (size_t)tok * DS5 + g * 16), u1 = *(const v4u*)(us + (size_t)tok * DS5 + g * 16 + 8);
        float uf[16]; uf[0] = bflo(u0.x); uf[1] = bfhi(u0.x); uf[2] = bflo(u0.y); uf[3] = bfhi(u0.y); uf[4] = bflo(u0.z); uf[5] = bfhi(u0.z); uf[6] = bflo(u0.w); uf[7] = bfhi(u0.w);
        uf[8] = bflo(u1.x); uf[9] = bfhi(u1.x); uf[10] = bflo(u1.y); uf[11] = bfhi(u1.y); uf[12] = bflo(u1.z); uf[13] = bfhi(u1.z); uf[14] = bflo(u1.w); uf[15] = bfhi(u1.w);
        float a = 0.f, b = 0.f;
#pragma unroll
        for (int c = 0; c < 16; ++c) { a += br[c] * uf[c]; b += bi[c] * uf[c]; }
        bur[t] = a; bui[t] = b; ucc[t] = bf2f(us[(size_t)tok * DS5 + g * 16 + cc]); }
    float hr[4], hi[4];
#pragma unroll
    for (int q = 0; q < 4; ++q) { hr[q] = inp(F, I_SRE)[((sq0 + q) * 64 + g) * 64 + p]; hi[q] = inp(F, I_SIM)[((sq0 + q) * 64 + g) * 64 + p]; }
#pragma unroll
    for (int s = 0; s < 4; ++s) {
#pragma unroll
        for (int q = 0; q < 4; ++q) { const int t = q * 4 + s; const float nr = ar * hr[q] - ai * hi[q] + bur[t], ni = ar * hi[q] + ai * hr[q] + bui[t]; hr[q] = nr; hi[q] = ni;
            hs[q * 128 + p] = nr; hs[q * 128 + 64 + p] = ni; }
        LDS_WAIT();
#pragma unroll
        for (int q = 0; q < 4; ++q) { float y = 0.f;
#pragma unroll
            for (int j = 0; j < 16; ++j) y += cr[j] * hs[q * 128 + part * 16 + j] - ci[j] * hs[q * 128 + 64 + part * 16 + j];
            y += __shfl_xor(y, 16); y += __shfl_xor(y, 32);
            y += dv * ucc[q * 4 + s];
            if (lane < 16) gbuf[(size_t)(MP + sq0 * 4 + q * 4 + s) * DS5 + g * 16 + cc] = (bf16)f2bf(gelu_tanh(y)); }
        LDS_WAIT();
    }
#pragma unroll
    for (int q = 0; q < 4; ++q) { F.out[O_RES + (size_t)((sq0 + q) * 64 + g) * 64 + p] = hr[q]; F.out[O_IMS + (size_t)((sq0 + q) * 64 + g) * 64 + p] = hi[q]; }
}

constexpr int LW_XS = 0, LW_XC = 4864, LW_XF = 7168, LW_AB = 11264, LW_BYTES = 16384;
struct LruPre { f32x4 xs[5]; float hin; };
__device__ __forceinline__ void lruw_load(Frame& F, int hd, int idx, int pass, LruPre& R) {
    const int lane = F.lane; const bool sample = idx >= 512;
    const int gc = idx, b = gc >> 7, c = gc & 127, tok0 = sample ? MP + 16 * (idx - 512) : 16 * gc, cgl = hd * 64 + lane;
    const float* xlru = (const float*)((unsigned char*)F.out + DO_XLRU);
#pragma unroll
    for (int k = 0; k < 5; ++k) { const int i = lane + 64 * k, r = i >> 4, q = i & 15, t = c * 16 - 3 + r; f32x4 v = {0.f, 0.f, 0.f, 0.f};
        if (!sample && i < 19 * 16 && t >= 0) v = *(const f32x4*)(xlru + (size_t)(b * SEQ + t) * DLRU + hd * 64 + 4 * q);
        R.xs[k] = v; }
    R.hin = 0.f;
    if (pass == 2) {
        if (!sample) R.hin = ((const float*)(F.ws + WS_HIN))[(size_t)gc * DLRU + cgl];
    }
}
#ifndef LRU_MODE
#define LRU_MODE 0
#endif
__device__ __forceinline__ void lruw_tile(Frame& F, int hd, int idx, int pass, float* ssqa_p, const LruPre& R, int mode = 0) {
    const int lane = F.lane;
    const bool sample = idx >= 512;
    const int gc = idx, b = gc >> 7, c = gc & 127, sb = idx - 512;
    const int tok0 = sample ? MP + 16 * sb : 16 * gc, cgl = hd * 64 + lane;
    const float* xlru = (const float*)((unsigned char*)F.out + DO_XLRU);
    bf16* mix = (bf16*)(F.ws + WS_MIX);
    LAS unsigned char* wl = F.lds + F.wave * LW_BYTES;
    LAS float* XS = (LAS float*)(wl + LW_XS); LAS bf16* XC = (LAS bf16*)(wl + LW_XC); LAS float* XF = (LAS float*)(wl + LW_XF); LAS float* AB = (LAS float*)(wl + LW_AB);
    const float* cw = inp(F, I_CONVW); const float* cb = inp(F, I_CONVB);
    const int fr = lane & 15, fq = lane >> 4;
    const bf16* WGA = (const bf16*)(F.ws + SM_WGA) + hd * 4096; const bf16* WGX = (const bf16*)(F.ws + SM_WGX) + hd * 4096;
    float vbga[4], vbgx[4], vsp[4];
#pragma unroll
    for (int nt = 0; nt < 4; ++nt) { const int ch = nt * 16 + fr; vbga[nt] = inp(F, I_BGA)[hd * 64 + ch]; vbgx[nt] = inp(F, I_BGX)[hd * 64 + ch]; vsp[nt] = ((const float*)(F.ws + SM_SP))[hd * 64 + ch]; }
    const int qc = lane & 15;
    f32x4 cwv[4], cbv = *(const f32x4*)(cb + hd * 64 + 4 * qc);
#pragma unroll
    for (int kk = 0; kk < 4; ++kk) cwv[kk] = *(const f32x4*)(cw + kk * DLRU + hd * 64 + 4 * qc);
    float h = R.hin, h0v[4], gvv[16];
#pragma unroll
    for (int q = 0; q < 4; ++q) h0v[q] = (pass == 2 && sample) ? inp(F, I_SLRU)[(size_t)(sb * 4 + q) * DLRU + cgl] : 0.f;
    if (pass == 2) { const bf16* glru = (const bf16*)((unsigned char*)F.out + DO_GLRU);
#pragma unroll
        for (int s = 0; s < 16; ++s) gvv[s] = bf2f(glru[(size_t)(tok0 + s) * DLRU + cgl]); }
    if (!sample) {
#pragma unroll
        for (int k = 0; k < 5; ++k) { const int i = lane + 64 * k; if (i < 19 * 16) { const int r = i >> 4, q = i & 15; *(LAS f32x4*)(XS + r * 64 + 4 * q) = R.xs[k]; } }
        LDS_WAIT();
#pragma unroll
        for (int k = 0; k < 4; ++k) { const int i = lane + 64 * k, t = i >> 4, q = i & 15;
            f32x4 a = cbv;
#pragma unroll
            for (int kk = 0; kk < 4; ++kk) a += cwv[kk] * *(LAS f32x4*)(XS + (t + kk) * 64 + 4 * q);
            *(LAS f32x4*)(XF + t * 64 + 4 * q) = a; v2u pk; pk.x = pk2(a.x, a.y); pk.y = pk2(a.z, a.w); *(LAS v2u*)(XC + t * 72 + 4 * q) = pk; }
    } else {
        const float* sconv = inp(F, I_SCONV);
#pragma unroll
        for (int k = 0; k < 4; ++k) { const int i = lane + 64 * k, t = i >> 4, q = i & 15, ch = hd * 64 + 4 * q, sq = sb * 4 + (t >> 2), s = t & 3;
            f32x4 a = cbv;
#pragma unroll
            for (int kk = 0; kk < 4; ++kk) { const int j = s + kk; const f32x4 xv = (j < 3) ? *(const f32x4*)(sconv + (size_t)(sq * 3 + j) * DLRU + ch) : *(const f32x4*)(xlru + (size_t)(MP + sq * 4 + j - 3) * DLRU + ch);
                a += cwv[kk] * xv; }
            *(LAS f32x4*)(XF + t * 64 + 4 * q) = a; v2u pk; pk.x = pk2(a.x, a.y); pk.y = pk2(a.z, a.w); *(LAS v2u*)(XC + t * 72 + 4 * q) = pk; }
    }
    bf16x8 wba0[4], wba1[4], wbx0[4], wbx1[4];
#pragma unroll
    for (int nt = 0; nt < 4; ++nt) { const int ch = nt * 16 + fr;
        wba0[nt] = *(const bf16x8*)(WGA + ch * 64 + fq * 8); wba1[nt] = *(const bf16x8*)(WGA + ch * 64 + 32 + fq * 8);
        wbx0[nt] = *(const bf16x8*)(WGX + ch * 64 + fq * 8); wbx1[nt] = *(const bf16x8*)(WGX + ch * 64 + 32 + fq * 8); }
    LDS_WAIT();
    {
        const bf16x8 a0 = *(LAS bf16x8*)(XC + fr * 72 + fq * 8), a1 = *(LAS bf16x8*)(XC + fr * 72 + 32 + fq * 8);
#pragma unroll
        for (int nt = 0; nt < 4; ++nt) {
            const int ch = nt * 16 + fr;
            f32x4 ga = {0.f, 0.f, 0.f, 0.f}, gx = {0.f, 0.f, 0.f, 0.f};
            ga = __builtin_amdgcn_mfma_f32_16x16x32_bf16(a0, wba0[nt], ga, 0, 0, 0); ga = __builtin_amdgcn_mfma_f32_16x16x32_bf16(a1, wba1[nt], ga, 0, 0, 0);
            gx = __builtin_amdgcn_mfma_f32_16x16x32_bf16(a0, wbx0[nt], gx, 0, 0, 0); gx = __builtin_amdgcn_mfma_f32_16x16x32_bf16(a1, wbx1[nt], gx, 0, 0, 0);
            const float bga = vbga[nt], bgx = vbgx[nt], sp = vsp[nt];
#pragma unroll
            for (int r = 0; r < 4; ++r) { const int t = fq * 4 + r; const float xc = XF[t * 64 + ch];
                const float rg = sigmoidf_(ga[r] + bga), ig = sigmoidf_(gx[r] + bgx), la = -8.f * rg * sp, av = __expf(la), x2 = 2.f * la;
                const float m1 = -x2 * (1.f + x2 * (0.5f + x2 * (0.16666667f + x2 * (0.041666668f + x2 * (0.0083333338f + x2 * 0.0013888889f)))));
                const float mult = __builtin_amdgcn_sqrtf((x2 > -0.25f) ? m1 : 1.f - __expf(x2));
                (void)av; XS[t * 64 + ch] = la; XF[t * 64 + ch] = mult * ig * xc; }
        }
    }
    LDS_WAIT();
    {
        bf16* LA = (bf16*)(F.ws + WS_XB); bf16* LB = LA + (size_t)MT * DLRU;
        float Ap = 1.f; unsigned lw[8], bw[8];
#pragma unroll
        for (int s = 0; s < 16; ++s) { const unsigned lab = f2bf(XS[s * 64 + lane]), bb = f2bf(XF[s * 64 + lane]);
            if (s & 1) { lw[s >> 1] |= lab << 16; bw[s >> 1] |= bb << 16; } else { lw[s >> 1] = lab; bw[s >> 1] = bb; }
            const float av = __expf(bf2f(lab)); h = av * h + bf2f(bb); Ap *= av; }
        { const size_t o = ((size_t)(idx * 16 + hd) * 64 + lane) * 16;
          *(v4u*)(LA + o) = (v4u){lw[0], lw[1], lw[2], lw[3]}; *(v4u*)(LA + o + 8) = (v4u){lw[4], lw[5], lw[6], lw[7]};
          *(v4u*)(LB + o) = (v4u){bw[0], bw[1], bw[2], bw[3]}; *(v4u*)(LB + o + 8) = (v4u){bw[4], bw[5], bw[6], bw[7]}; }
        if (!sample) { float* o = (float*)(F.ws + WS_AGG) + ((size_t)gc * DLRU + cgl) * 2; *(v2u*)o = (v2u){__builtin_bit_cast(unsigned, Ap), __builtin_bit_cast(unsigned, h)}; }
        LDS_WAIT();
    }
}
struct Lru2Pre { v4u la0, la1, lb0, lb1; float g[16]; float hin; };
__device__ __forceinline__ void lruw2_load(Frame& F, int hd, int idx, Lru2Pre& R) {
    const int lane = F.lane; const bool sample = idx >= 512;
    const int tok0 = sample ? MP + 16 * (idx - 512) : 16 * idx, cgl = hd * 64 + lane;
    const bf16* glru = (const bf16*)((unsigned char*)F.out + DO_GLRU);
    const bf16* LA = (const bf16*)(F.ws + WS_XB); const bf16* LB = LA + (size_t)MT * DLRU;
    const size_t o = ((size_t)(idx * 16 + hd) * 64 + lane) * 16;
    R.la0 = *(const v4u*)(LA + o); R.la1 = *(const v4u*)(LA + o + 8); R.lb0 = *(const v4u*)(LB + o); R.lb1 = *(const v4u*)(LB + o + 8);
#pragma unroll
    for (int s = 0; s < 16; ++s) R.g[s] = bf2f(glru[(size_t)(tok0 + s) * DLRU + cgl]);
    R.hin = sample ? 0.f : ((const float*)(F.ws + WS_HIN))[(size_t)idx * DLRU + cgl];
}
__device__ __forceinline__ void lruw2_tile(Frame& F, int hd, int idx, float* ssqa_p, const Lru2Pre& R) {
    const int lane = F.lane;
    const bool sample = idx >= 512;
    const int gc = idx, b = gc >> 7, c = gc & 127, sb = idx - 512;
    const int tok0 = sample ? MP + 16 * sb : 16 * gc, cgl = hd * 64 + lane;
    const float* xlru = (const float*)((unsigned char*)F.out + DO_XLRU);
    bf16* mix = (bf16*)(F.ws + WS_MIX);
    float lav[16], bvv[16], h0v[4];
    { const unsigned lw[8] = {R.la0.x, R.la0.y, R.la0.z, R.la0.w, R.la1.x, R.la1.y, R.la1.z, R.la1.w}, bw[8] = {R.lb0.x, R.lb0.y, R.lb0.z, R.lb0.w, R.lb1.x, R.lb1.y, R.lb1.z, R.lb1.w};
#pragma unroll
      for (int k = 0; k < 8; ++k) { lav[2 * k] = bflo(lw[k]); lav[2 * k + 1] = bfhi(lw[k]); bvv[2 * k] = bflo(bw[k]); bvv[2 * k + 1] = bfhi(bw[k]); } }
    float h = R.hin;
#pragma unroll
    for (int q = 0; q < 4; ++q) h0v[q] = sample ? inp(F, I_SLRU)[(size_t)(sb * 4 + q) * DLRU + cgl] : 0.f;
    float sq[16];
#pragma unroll
    for (int s = 0; s < 16; ++s) {
        if (sample && (s & 3) == 0) h = h0v[s >> 2];
        h = __expf(lav[s]) * h + bvv[s];
        const float o = h * gelu_tanh(R.g[s]);
        mix[(size_t)(tok0 + s) * DM + cgl] = (bf16)f2bf(o); sq[s] = o * o;
        if (sample && (s & 3) == 3) F.out[O_LRUS + (size_t)(sb * 4 + (s >> 2)) * DLRU + cgl] = h;
    }
    if (!sample && c == 127) { F.out[O_LRUP + (size_t)b * DLRU + cgl] = h;
#pragma unroll
        for (int j = 0; j < 3; ++j) F.out[O_CONVP + (size_t)(b * 3 + j) * DLRU + cgl] = xlru[(size_t)(b * SEQ + 2045 + j) * DLRU + cgl]; }
    if (sample) {
#pragma unroll
        for (int e = 0; e < 12; ++e) { const int sqn = sb * 4 + e / 3, j = e % 3; F.out[O_CONVS + (size_t)(sqn * 3 + j) * DLRU + cgl] = xlru[(size_t)(MP + sqn * 4 + 1 + j) * DLRU + cgl]; }
    }
    const bool b5 = lane & 32, b4 = lane & 16, b3 = lane & 8, b2 = lane & 4;
    float r8[8], r4[4], r2[2], r1;
#pragma unroll
    for (int k = 0; k < 8; ++k) { const float mine = b5 ? sq[8 + k] : sq[k], send = b5 ? sq[k] : sq[8 + k]; r8[k] = mine + __shfl_xor(send, 32); }
#pragma unroll
    for (int k = 0; k < 4; ++k) { const float mine = b4 ? r8[4 + k] : r8[k], send = b4 ? r8[k] : r8[4 + k]; r4[k] = mine + __shfl_xor(send, 16); }
#pragma unroll
    for (int k = 0; k < 2; ++k) { const float mine = b3 ? r4[2 + k] : r4[k], send = b3 ? r4[k] : r4[2 + k]; r2[k] = mine + __shfl_xor(send, 8); }
    { const float mine = b2 ? r2[1] : r2[0], send = b2 ? r2[0] : r2[1]; r1 = mine + __shfl_xor(send, 4); }
    r1 += __shfl_xor(r1, 1); r1 += __shfl_xor(r1, 2);
    if ((lane & 3) == 0) atomicAdd(ssqa_p + tok0 + ((lane >> 5) & 1) * 8 + ((lane >> 4) & 1) * 4 + ((lane >> 3) & 1) * 2 + ((lane >> 2) & 1), r1);
}
__device__ __forceinline__ void lruw_tiles(Frame& F, int pass, int nper, unsigned* counters, float* ssqa_p, int mode = 0) {
    const int hd = F.bid & 15; unsigned* cp = counters + 16 * hd;
    unsigned v0 = 0u, v1 = 0u; if (F.lane == 0) { v0 = atomicAdd(cp, 1u); v1 = atomicAdd(cp, 1u); }
    int t = (int)__builtin_amdgcn_readfirstlane(v0), nx = (int)__builtin_amdgcn_readfirstlane(v1);
    if (pass == 2) {
        Lru2Pre Q; if (t < nper) lruw2_load(F, hd, t, Q);
        while (t < nper) {
            unsigned v2 = 0u; if (F.lane == 0) v2 = atomicAdd(cp, 1u);
            Lru2Pre Qn; if (nx < nper) lruw2_load(F, hd, nx, Qn);
            lruw2_tile(F, hd, t, ssqa_p, Q);
            t = nx; Q = Qn; nx = (int)__builtin_amdgcn_readfirstlane(v2);
        }
        return;
    }
    LruPre R; if (t < nper) lruw_load(F, hd, t, pass, R);
    while (t < nper) {
        unsigned v2 = 0u; if (F.lane == 0) v2 = atomicAdd(cp, 1u);
        LruPre Rn; if (nx < nper) lruw_load(F, hd, nx, pass, Rn);
        lruw_tile(F, hd, t, pass, ssqa_p, R, mode);
        t = nx; R = Rn; nx = (int)__builtin_amdgcn_readfirstlane(v2);
    }
}

constexpr int NPHASE = 10;
#ifndef LRU_N4
#define LRU_N4 256
#endif
#ifndef DUP_PHASE
#define DUP_PHASE (-1)
#endif

__global__ void __launch_bounds__(NTHR, 2) fwd_megakernel(Args args) {
    extern __shared__ __attribute__((aligned(16))) unsigned char lds_raw[];
    cg::grid_group grid = cg::this_grid();
    Frame F; F.lds = (LAS unsigned char*)lds_raw; F.tid = threadIdx.x; F.lane = F.tid & 63; F.wave = __builtin_amdgcn_readfirstlane(F.tid >> 6); F.G = gridDim.x; F.bid = blockIdx.x;
    F.out = args.out; F.ws = args.ws;
    if (F.tid == 0) {
#pragma unroll
        for (int i = 0; i < 32; ++i) { const unsigned long long pv = (unsigned long long)args.in[i]; ((LAS unsigned*)(F.lds + PTR_OFF))[2 * i] = (unsigned)pv; ((LAS unsigned*)(F.lds + PTR_OFF))[2 * i + 1] = (unsigned)(pv >> 32); }
    }
    const int lo = args.ph_lo, hi = args.ph_hi;
    volatile LAS unsigned* MISC = (volatile LAS unsigned*)(F.lds + MISC_OFF);
    if (F.tid < 32) MISC[F.tid] = 0u;
    __syncthreads();
    if (lo > hi) grid.sync();
    XcdBarrier xbar = xcd_barrier_post((unsigned*)(args.ws + WS_CTL + CTL_BAR), MISC + 8);
#define IN(k) (lo <= (k) && (k) < hi)
#define SEAM(k) do { if (IN(k) && IN((k) + 1)) { xcd_barrier(xbar); } } while (0)
    unsigned char* ws = args.ws;
    bf16* WinT = (bf16*)(ws + WS_WIN); bf16* WgluT = (bf16*)(ws + WS_WGLU); bf16* WoutT = (bf16*)(ws + WS_WOUT); bf16* WupT = (bf16*)(ws + WS_WUP); bf16* WdownT = (bf16*)(ws + WS_WDOWN);
    bf16* XB = (bf16*)(ws + WS_XB); bf16* HB = (bf16*)(ws + WS_H); bf16* A2 = (bf16*)(ws + WS_A2); bf16* US = (bf16*)(ws + WS_US); bf16* MIX = (bf16*)(ws + WS_MIX);
    bf16* M1 = (bf16*)(ws + WS_M1); bf16* KG = (bf16*)(ws + WS_KG); float* SB = (float*)(ws + WS_S);
    float* ssqa = (float*)(ws + WS_CTL + CTL_SSQA); float* ssqb = (float*)(ws + WS_CTL + CTL_SSQB); float* ssq1 = (float*)(ws + WS_CTL + CTL_SSQ1); float* ssq2 = (float*)(ws + WS_CTL + CTL_SSQ2);
    unsigned* cnt = (unsigned*)(ws + WS_CTL + CTL_CNT); float* ssqd = (float*)(ws + WS_CTL + 320 * 1024);
    float* xlru = (float*)((unsigned char*)args.out + DO_XLRU); bf16* glru = (bf16*)((unsigned char*)args.out + DO_GLRU); bf16* gbuf = (bf16*)((unsigned char*)args.out + DO_G);

    if (IN(0)) {
        if (DUP_PHASE == 0) { constexpr bool dup = true; (void)dup; { p0_prologue(F, P0_MASK); } xcd_barrier(xbar); }
        { constexpr bool dup = false; (void)dup; { p0_prologue(F, 7); } }
    }
    SEAM(0);
    if (IN(1)) {
        if (DUP_PHASE == 1) { constexpr bool dup = true; (void)dup; { {
        pg8::Gemm g{XB, WinT, DM, DM, DM, 0, 0}; pg8::Order S; S.init(MT, NZ, 1, F.G, F.bid);
        pg8::EpiZ E{(const float*)(ws + SM_RS0), xlru, glru, A2, US};
        pg8::gemm_phase<pg8::EpiZ, pg8::Order, true, true>(F.lds, g, S, E);
        __syncthreads();
        if constexpr (!dup) { tr_items_dyn(F, inp(F, I_WGLU), nullptr, DS5, DS5, WgluT, cnt + 10);
          tr_items_dyn(F, inp(F, I_WUP), inp(F, I_NMLP), DM, DFF, WupT, cnt + 8); }
    } } xcd_barrier(xbar); }
        { constexpr bool dup = false; (void)dup; { {
        pg8::Gemm g{XB, WinT, DM, DM, DM, 0, 0}; pg8::Order S; S.init(MT, NZ, 1, F.G, F.bid);
        pg8::EpiZ E{(const float*)(ws + SM_RS0), xlru, glru, A2, US};
        pg8::gemm_phase<pg8::EpiZ, pg8::Order, true, true>(F.lds, g, S, E);
        __syncthreads();
        if constexpr (!dup) { tr_items_dyn(F, inp(F, I_WGLU), nullptr, DS5, DS5, WgluT, cnt + 10);
          tr_items_dyn(F, inp(F, I_WUP), inp(F, I_NMLP), DM, DFF, WupT, cnt + 8); }
    } } }
    }
    SEAM(1);
    if (IN(2)) {
        if (DUP_PHASE == 2) { constexpr bool dup = true; (void)dup; { {
        { pg8::Gemm g{A2, M1, A2_LD, 512, 512, (size_t)A2_ROWS * A2_LD, (size_t)256 * 512}; pg8::Order S; S.init(A2_ROWS, 256, NPAIR, F.G, F.bid);
          pg8::EpiS E{SB};
          pg8::gemm_phase<pg8::EpiS, pg8::Order, true, true>(F.lds, g, S, E); }
#ifdef SMP_REP
        if constexpr (!dup) { xcd_barrier(xbar); for (int it = F.bid * NWAVES + F.wave; it < 2048; it += F.G * NWAVES) s5_sample_item(F, it); xcd_barrier(xbar); }
#endif
        __syncthreads();
        lruw_tiles(F, 1, 544, cnt + (dup ? 1024 : 512), ssqa); __syncthreads();
    } } xcd_barrier(xbar); }
        { constexpr bool dup = false; (void)dup; { {
        { pg8::Gemm g{A2, M1, A2_LD, 512, 512, (size_t)A2_ROWS * A2_LD, (size_t)256 * 512}; pg8::Order S; S.init(A2_ROWS, 256, NPAIR, F.G, F.bid);
          pg8::EpiS E{SB};
          pg8::gemm_phase<pg8::EpiS, pg8::Order, true, true>(F.lds, g, S, E); }
#ifdef SMP_REP
        if constexpr (!dup) { xcd_barrier(xbar); for (int it = F.bid * NWAVES + F.wave; it < 2048; it += F.G * NWAVES) s5_sample_item(F, it); xcd_barrier(xbar); }
#endif
        __syncthreads();
        lruw_tiles(F, 1, 544, cnt + (dup ? 1024 : 512), ssqa); __syncthreads();
    } } }
    }
    SEAM(2);
    if (IN(3)) {
        if (DUP_PHASE == 3) { constexpr bool dup = true; (void)dup; { {
        for (int e = F.bid * 64 + F.tid; F.tid < 64 && e < NPAIR * NB * 128; e += F.G * 64) {
            const int z = e >> 9, b = (e >> 7) & 3, q = e & 127, gl = q >> 6, p = q & 63, g = z * 2 + gl;
            const float* e16 = (const float*)(ws + SM_E16) + (g * 64 + p) * 2; const float ar = e16[0], ai = e16[1];
            float hr = 0.f, hi = 0.f;
            const float* __restrict__ Sp = SB + ((size_t)z * A2_ROWS + b * NCH) * 256 + gl * 128 + p;
            bf16* __restrict__ Hp = A2 + ((size_t)z * A2_ROWS + b * NCH) * A2_LD + 512 + gl * 128 + p;
            for (int c0 = 0; c0 < NCH; c0 += 32) {
                float sr[32], si[32];
#pragma unroll
                for (int j = 0; j < 32; ++j) { sr[j] = Sp[(size_t)(c0 + j) * 256]; si[j] = Sp[(size_t)(c0 + j) * 256 + 64]; }
#pragma unroll
                for (int j = 0; j < 32; ++j) { Hp[(size_t)(c0 + j) * A2_LD] = (bf16)f2bf(hr); Hp[(size_t)(c0 + j) * A2_LD + 64] = (bf16)f2bf(hi);
                    const float nr = ar * hr - ai * hi + sr[j], ni = ar * hi + ai * hr + si[j]; hr = nr; hi = ni; }
            }
            args.out[O_REP + (size_t)(b * 64 + g) * 64 + p] = hr; args.out[O_IMP + (size_t)(b * 64 + g) * 64 + p] = hi;
        }
        for (int e = F.bid * 64 + (F.tid - 64); F.tid >= 64 && F.tid < 128 && e < NB * DLRU; e += F.G * 64) {
            const int b = e >> 10, chn = e & 1023;
            const float* __restrict__ ag = (const float*)(ws + WS_AGG) + ((size_t)(b * 128) * DLRU + chn) * 2; float* __restrict__ hn = (float*)(ws + WS_HIN) + (size_t)(b * 128) * DLRU + chn;
            float h = 0.f;
            for (int c0 = 0; c0 < 128; c0 += 32) {
                float aa[32], hh[32];
#pragma unroll
                for (int j = 0; j < 32; ++j) { aa[j] = ag[(size_t)(c0 + j) * DLRU * 2]; hh[j] = ag[(size_t)(c0 + j) * DLRU * 2 + 1]; }
#pragma unroll
                for (int j = 0; j < 32; ++j) { hn[(size_t)(c0 + j) * DLRU] = h; h = aa[j] * h + hh[j]; }
            }
        }
    } } xcd_barrier(xbar); }
        { constexpr bool dup = false; (void)dup; { {
        for (int e = F.bid * 64 + F.tid; F.tid < 64 && e < NPAIR * NB * 128; e += F.G * 64) {
            const int z = e >> 9, b = (e >> 7) & 3, q = e & 127, gl = q >> 6, p = q & 63, g = z * 2 + gl;
            const float* e16 = (const float*)(ws + SM_E16) + (g * 64 + p) * 2; const float ar = e16[0], ai = e16[1];
            float hr = 0.f, hi = 0.f;
            const float* __restrict__ Sp = SB + ((size_t)z * A2_ROWS + b * NCH) * 256 + gl * 128 + p;
            bf16* __restrict__ Hp = A2 + ((size_t)z * A2_ROWS + b * NCH) * A2_LD + 512 + gl * 128 + p;
            for (int c0 = 0; c0 < NCH; c0 += 32) {
                float sr[32], si[32];
#pragma unroll
                for (int j = 0; j < 32; ++j) { sr[j] = Sp[(size_t)(c0 + j) * 256]; si[j] = Sp[(size_t)(c0 + j) * 256 + 64]; }
#pragma unroll
                for (int j = 0; j < 32; ++j) { Hp[(size_t)(c0 + j) * A2_LD] = (bf16)f2bf(hr); Hp[(size_t)(c0 + j) * A2_LD + 64] = (bf16)f2bf(hi);
                    const float nr = ar * hr - ai * hi + sr[j], ni = ar * hi + ai * hr + si[j]; hr = nr; hi = ni; }
            }
            args.out[O_REP + (size_t)(b * 64 + g) * 64 + p] = hr; args.out[O_IMP + (size_t)(b * 64 + g) * 64 + p] = hi;
        }
        for (int e = F.bid * 64 + (F.tid - 64); F.tid >= 64 && F.tid < 128 && e < NB * DLRU; e += F.G * 64) {
            const int b = e >> 10, chn = e & 1023;
            const float* __restrict__ ag = (const float*)(ws + WS_AGG) + ((size_t)(b * 128) * DLRU + chn) * 2; float* __restrict__ hn = (float*)(ws + WS_HIN) + (size_t)(b * 128) * DLRU + chn;
            float h = 0.f;
            for (int c0 = 0; c0 < 128; c0 += 32) {
                float aa[32], hh[32];
#pragma unroll
                for (int j = 0; j < 32; ++j) { aa[j] = ag[(size_t)(c0 + j) * DLRU * 2]; hh[j] = ag[(size_t)(c0 + j) * DLRU * 2 + 1]; }
#pragma unroll
                for (int j = 0; j < 32; ++j) { hn[(size_t)(c0 + j) * DLRU] = h; h = aa[j] * h + hh[j]; }
            }
        }
    } } }
    }
    SEAM(3);
    if (IN(4)) {
        if (DUP_PHASE == 4) { constexpr bool dup = true; (void)dup; { {
        if constexpr (!dup) { pg8::Gemm g{A2, KG, A2_LD, 768, 768, (size_t)A2_ROWS * A2_LD, (size_t)512 * 768}; pg8::Order S; S.init(A2_ROWS, 512, NPAIR, F.G, F.bid);
          pg8::EpiY E{gbuf};
          pg8::gemm_phase<pg8::EpiY, pg8::Order, true, true>(F.lds, g, S, E); }
        __syncthreads();
        if constexpr (!dup) { const int nyu = NPAIR * 4, nidle = F.G > nyu ? F.G - nyu : F.G, rank = F.G > nyu ? F.bid - nyu : F.bid;
          if (rank >= 0) for (int it = rank * NWAVES + F.wave; it < 2048; it += nidle * NWAVES) s5_sample_item(F, it);
          __syncthreads(); }
#ifdef YG_REP
        if constexpr (!dup) { xcd_barrier(xbar); pg8::Gemm g{A2, KG, A2_LD, 768, 768, (size_t)A2_ROWS * A2_LD, (size_t)512 * 768}; pg8::Order S; S.init(A2_ROWS, 512, NPAIR, F.G, F.bid);
          pg8::EpiY E{gbuf};
          pg8::gemm_phase<pg8::EpiY, pg8::Order, true, true>(F.lds, g, S, E); xcd_barrier(xbar); }
#endif
        __syncthreads();
#ifdef LRU2_REP
#pragma nounroll
        for (int rep = 0; rep < LRU2_REP; ++rep) { lruw_tiles(F, 2, 544, cnt + 2048 + 256 * rep, ssqd, LRU_MODE); xcd_barrier(xbar); }
#endif
        lruw_tiles(F, 2, 544, cnt + (dup ? 1536 : 1280), dup ? ssqd : ssqa); __syncthreads();
    } } xcd_barrier(xbar); }
        { constexpr bool dup = false; (void)dup; { {
        if constexpr (!dup) { pg8::Gemm g{A2, KG, A2_LD, 768, 768, (size_t)A2_ROWS * A2_LD, (size_t)512 * 768}; pg8::Order S; S.init(A2_ROWS, 512, NPAIR, F.G, F.bid);
          pg8::EpiY E{gbuf};
          pg8::gemm_phase<pg8::EpiY, pg8::Order, true, true>(F.lds, g, S, E); }
        __syncthreads();
        if constexpr (!dup) { const int nyu = NPAIR * 4, nidle = F.G > nyu ? F.G - nyu : F.G, rank = F.G > nyu ? F.bid - nyu : F.bid;
          if (rank >= 0) for (int it = rank * NWAVES + F.wave; it < 2048; it += nidle * NWAVES) s5_sample_item(F, it);
          __syncthreads(); }
#ifdef YG_REP
        if constexpr (!dup) { xcd_barrier(xbar); pg8::Gemm g{A2, KG, A2_LD, 768, 768, (size_t)A2_ROWS * A2_LD, (size_t)512 * 768}; pg8::Order S; S.init(A2_ROWS, 512, NPAIR, F.G, F.bid);
          pg8::EpiY E{gbuf};
          pg8::gemm_phase<pg8::EpiY, pg8::Order, true, true>(F.lds, g, S, E); xcd_barrier(xbar); }
#endif
        __syncthreads();
#ifdef LRU2_REP
#pragma nounroll
        for (int rep = 0; rep < LRU2_REP; ++rep) { lruw_tiles(F, 2, 544, cnt + 2048 + 256 * rep, ssqd, LRU_MODE); xcd_barrier(xbar); }
#endif
        lruw_tiles(F, 2, 544, cnt + (dup ? 1536 : 1280), dup ? ssqd : ssqa); __syncthreads();
    } } }
    }
    SEAM(4);
    if (IN(5)) {
        if (DUP_PHASE == 5) { constexpr bool dup = true; (void)dup; { {
        pg8::Gemm g{gbuf, WgluT, DS5, DS5, DS5, 0, 0}; pg8::Order S; S.init(MT, DS5, 1, F.G, F.bid);
        pg8::EpiGlu E{gbuf, inp(F, I_BGLU), MIX, dup ? ssqd : ssqb};
        pg8::gemm_phase<pg8::EpiGlu, pg8::Order, true, true>(F.lds, g, S, E);
        __syncthreads();
        if constexpr (!dup) tr_items_dyn(F, inp(F, I_WOUT), inp(F, I_NOUTA), DM, DM, WoutT, cnt + 11, inp(F, I_NOUTB));
    } } xcd_barrier(xbar); }
        { constexpr bool dup = false; (void)dup; { {
        pg8::Gemm g{gbuf, WgluT, DS5, DS5, DS5, 0, 0}; pg8::Order S; S.init(MT, DS5, 1, F.G, F.bid);
        pg8::EpiGlu E{gbuf, inp(F, I_BGLU), MIX, dup ? ssqd : ssqb};
        pg8::gemm_phase<pg8::EpiGlu, pg8::Order, true, true>(F.lds, g, S, E);
        __syncthreads();
        if constexpr (!dup) tr_items_dyn(F, inp(F, I_WOUT), inp(F, I_NOUTA), DM, DM, WoutT, cnt + 11, inp(F, I_NOUTB));
    } } }
    }
    SEAM(5);
    if (IN(6)) {
        if (DUP_PHASE == 6) { constexpr bool dup = true; (void)dup; { {
        { pg8::Gemm g{MIX, WoutT, DM, DM, 1024, 1024, 1024}; pg8::Order S; S.init(MP, DM, -1, F.G, F.bid);
          pg8::EpiOut E{ssqa, ssqb, inp(F, I_XP), inp(F, I_XS), args.out, XB, dup ? ssqd : ssq1};
          pg8::gemm_phase<pg8::EpiOut, pg8::Order, true, true>(F.lds, g, S, E); }
        { pg8::Gemm g{MIX, WoutT, DM, DM, 256, 256, 256}; pg8::SliceOrder S{F.bid, 8, F.G};
          pg8::EpiPart E{(float*)(ws + WS_KG), (float*)(ws + WS_A2), 8};
          pg8::gemm_phase<pg8::EpiPart, pg8::SliceOrder, true, true>(F.lds, g, S, E); }
        if constexpr (!dup) { if (hi - lo > 1) xcd_barrier(xbar);
          for (int r2 = F.bid; r2 < MS / 2; r2 += F.G) {
            const int row = MP + 2 * r2 + (F.wave >> 2), qd = F.wave & 3, pm = row >> 8, rl = row & 255;
            const float* Pb = (const float*)(ws + (pm == 32 ? WS_KG : WS_A2));
            const float ra = 1.f / sqrtf(ssqa[row] * (1.f / DLRU) + EPS), rb = 1.f / sqrtf(ssqb[row] * (1.f / DS5) + EPS);
            float sq = 0.f;
#pragma unroll
            for (int jj = 0; jj < 2; ++jj) { const int col = 512 * qd + 256 * jj + 4 * F.lane, pn = col >> 8, cl = col & 255;
                const float* pp = Pb + (size_t)(pn * 8) * 65536 + rl * 256 + cl;
                f32x4 sa = {0.f, 0.f, 0.f, 0.f}, sb2 = {0.f, 0.f, 0.f, 0.f};
#pragma unroll
                for (int sl = 0; sl < 4; ++sl) { sa += *(const f32x4*)(pp + (size_t)sl * 65536); sb2 += *(const f32x4*)(pp + (size_t)(sl + 4) * 65536); }
                const f32x4 v = *(const f32x4*)(inp(F, I_XS) + (size_t)(row - MP) * DM + col) + sa * ra + sb2 * rb;
                *(f32x4*)(args.out + (size_t)row * DM + col) = v;
                v2u pk; pk.x = pk2(v.x, v.y); pk.y = pk2(v.z, v.w); *(v2u*)(XB + (size_t)row * DM + col) = pk;
                sq += (v.x * v.x + v.y * v.y) + (v.z * v.z + v.w * v.w); }
            sq = wave_sum(sq);
            if (F.lane == 0) atomicAdd(ssq1 + row, sq);
          } }
    } } xcd_barrier(xbar); }
        { constexpr bool dup = false; (void)dup; { {
        { pg8::Gemm g{MIX, WoutT, DM, DM, 1024, 1024, 1024}; pg8::Order S; S.init(MP, DM, -1, F.G, F.bid);
          pg8::EpiOut E{ssqa, ssqb, inp(F, I_XP), inp(F, I_XS), args.out, XB, dup ? ssqd : ssq1};
          pg8::gemm_phase<pg8::EpiOut, pg8::Order, true, true>(F.lds, g, S, E); }
        { pg8::Gemm g{MIX, WoutT, DM, DM, 256, 256, 256}; pg8::SliceOrder S{F.bid, 8, F.G};
          pg8::EpiPart E{(float*)(ws + WS_KG), (float*)(ws + WS_A2), 8};
          pg8::gemm_phase<pg8::EpiPart, pg8::SliceOrder, true, true>(F.lds, g, S, E); }
        if constexpr (!dup) { if (hi - lo > 1) xcd_barrier(xbar);
          for (int r2 = F.bid; r2 < MS / 2; r2 += F.G) {
            const int row = MP + 2 * r2 + (F.wave >> 2), qd = F.wave & 3, pm = row >> 8, rl = row & 255;
            const float* Pb = (const float*)(ws + (pm == 32 ? WS_KG : WS_A2));
            const float ra = 1.f / sqrtf(ssqa[row] * (1.f / DLRU) + EPS), rb = 1.f / sqrtf(ssqb[row] * (1.f / DS5) + EPS);
            float sq = 0.f;
#pragma unroll
            for (int jj = 0; jj < 2; ++jj) { const int col = 512 * qd + 256 * jj + 4 * F.lane, pn = col >> 8, cl = col & 255;
                const float* pp = Pb + (size_t)(pn * 8) * 65536 + rl * 256 + cl;
                f32x4 sa = {0.f, 0.f, 0.f, 0.f}, sb2 = {0.f, 0.f, 0.f, 0.f};
#pragma unroll
                for (int sl = 0; sl < 4; ++sl) { sa += *(const f32x4*)(pp + (size_t)sl * 65536); sb2 += *(const f32x4*)(pp + (size_t)(sl + 4) * 65536); }
                const f32x4 v = *(const f32x4*)(inp(F, I_XS) + (size_t)(row - MP) * DM + col) + sa * ra + sb2 * rb;
                *(f32x4*)(args.out + (size_t)row * DM + col) = v;
                v2u pk; pk.x = pk2(v.x, v.y); pk.y = pk2(v.z, v.w); *(v2u*)(XB + (size_t)row * DM + col) = pk;
                sq += (v.x * v.x + v.y * v.y) + (v.z * v.z + v.w * v.w); }
            sq = wave_sum(sq);
            if (F.lane == 0) atomicAdd(ssq1 + row, sq);
          } }
    } } }
    }
    SEAM(6);
    if (IN(7)) {
        if (DUP_PHASE == 7) { constexpr bool dup = true; (void)dup; { {
        pg8::Gemm g{XB, WupT, DM, DM, DM, 0, 0}; pg8::Order S; S.init(MT, DFF, 1, F.G, F.bid);
        pg8::EpiUp E{ssq1, HB};
        pg8::gemm_phase<pg8::EpiUp, pg8::Order, true, true>(F.lds, g, S, E);
        __syncthreads();
        if constexpr (!dup) tr_items_dyn(F, inp(F, I_WDOWN), nullptr, DFF, DM, WdownT, cnt + 9);
    } } xcd_barrier(xbar); }
        { constexpr bool dup = false; (void)dup; { {
        pg8::Gemm g{XB, WupT, DM, DM, DM, 0, 0}; pg8::Order S; S.init(MT, DFF, 1, F.G, F.bid);
        pg8::EpiUp E{ssq1, HB};
        pg8::gemm_phase<pg8::EpiUp, pg8::Order, true, true>(F.lds, g, S, E);
        __syncthreads();
        if constexpr (!dup) tr_items_dyn(F, inp(F, I_WDOWN), nullptr, DFF, DM, WdownT, cnt + 9);
    } } }
    }
    SEAM(7);
    if (IN(8)) {
        if (DUP_PHASE == 8) { constexpr bool dup = true; (void)dup; { {
        { pg8::Gemm g{HB, WdownT, DFF, DFF, DFF, 0, 0}; pg8::Order S; S.init(MP, DM, 1, F.G, F.bid);
          pg8::EpiDown E{args.out, XB, dup ? 0.f : 1.f};
          pg8::gemm_phase<pg8::EpiDown, pg8::Order, true, true>(F.lds, g, S, E); }
        if constexpr (!dup) { if (hi - lo > 1) xcd_barrier(xbar); }
        { pg8::Gemm g{HB, WdownT, DFF, DFF, 512, 512, 512}; pg8::SliceOrder S{F.bid, 16, F.G};
          pg8::EpiPart E{(float*)(ws + WS_WUP), (float*)(ws + WS_XB), 16};
          pg8::gemm_phase<pg8::EpiPart, pg8::SliceOrder, true, true>(F.lds, g, S, E); }
    } } xcd_barrier(xbar); }
        { constexpr bool dup = false; (void)dup; { {
        { pg8::Gemm g{HB, WdownT, DFF, DFF, DFF, 0, 0}; pg8::Order S; S.init(MP, DM, 1, F.G, F.bid);
          pg8::EpiDown E{args.out, XB, dup ? 0.f : 1.f};
          pg8::gemm_phase<pg8::EpiDown, pg8::Order, true, true>(F.lds, g, S, E); }
        if constexpr (!dup) { if (hi - lo > 1) xcd_barrier(xbar); }
        { pg8::Gemm g{HB, WdownT, DFF, DFF, 512, 512, 512}; pg8::SliceOrder S{F.bid, 16, F.G};
          pg8::EpiPart E{(float*)(ws + WS_WUP), (float*)(ws + WS_XB), 16};
          pg8::gemm_phase<pg8::EpiPart, pg8::SliceOrder, true, true>(F.lds, g, S, E); }
    } } }
    }
    SEAM(8);
    if (IN(9)) {
        if (DUP_PHASE == 9) { constexpr bool dup = true; (void)dup; { {
        const float* gf = inp(F, I_NFINAL);
        for (int r2 = F.bid; r2 < MS / 2; r2 += F.G) {
            const int row = MP + 2 * r2 + (F.wave >> 2), qd = F.wave & 3, pm = row >> 8, rl = row & 255;
            const float* Pb = (const float*)(ws + (pm == 32 ? WS_WUP : WS_XB));
            f32x4 v[2]; float sq = 0.f;
#pragma unroll
            for (int jj = 0; jj < 2; ++jj) { const int col = 512 * qd + 256 * jj + 4 * F.lane, pn = col >> 8, cl = col & 255;
                f32x4 a = *(const f32x4*)(args.out + (size_t)row * DM + col);
                const float* pp = Pb + (size_t)(pn * 16) * 65536 + rl * 256 + cl;
#pragma unroll
                for (int sl = 0; sl < 16; ++sl) a += *(const f32x4*)(pp + (size_t)sl * 65536);
                v[jj] = a; sq += (a.x * a.x + a.y * a.y) + (a.z * a.z + a.w * a.w); }
            sq = wave_sum(sq);
            LAS float* red = (LAS float*)(F.lds + MISC_OFF + 128);
            if (F.lane == 0) red[F.wave] = sq;
            __syncthreads();
            const int w0 = F.wave & 4; const float tot = (red[w0] + red[w0 + 1]) + (red[w0 + 2] + red[w0 + 3]);
            __syncthreads();
            const float rs = dup ? 1.f : 1.f / sqrtf(tot * (1.f / DM) + EPS);
#pragma unroll
            for (int jj = 0; jj < 2; ++jj) { const int col = 512 * qd + 256 * jj + 4 * F.lane; const f32x4 gr = dup ? (f32x4){1.f, 1.f, 1.f, 1.f} : *(const f32x4*)(gf + col);
                f32x4 o = v[jj] * rs * gr; if (dup) o = *(const f32x4*)(args.out + (size_t)row * DM + col);
                *(f32x4*)(args.out + (size_t)row * DM + col) = o; }
        }
        for (int m = F.bid * NWAVES + F.wave; m < MP; m += F.G * NWAVES) {
            const v4u* xb = (const v4u*)(args.out + (size_t)m * DM) + F.lane; float* xo = args.out + (size_t)m * DM;
            v4u w[4]; float sq = 0.f; f32x4 v[8];
#pragma unroll
            for (int j = 0; j < 4; ++j) w[j] = xb[64 * j];
#pragma unroll
            for (int j = 0; j < 4; ++j) { v[2 * j] = (f32x4){bflo(w[j].x), bfhi(w[j].x), bflo(w[j].y), bfhi(w[j].y)}; v[2 * j + 1] = (f32x4){bflo(w[j].z), bfhi(w[j].z), bflo(w[j].w), bfhi(w[j].w)};
                sq += (v[2 * j].x * v[2 * j].x + v[2 * j].y * v[2 * j].y) + (v[2 * j].z * v[2 * j].z + v[2 * j].w * v[2 * j].w) + (v[2 * j + 1].x * v[2 * j + 1].x + v[2 * j + 1].y * v[2 * j + 1].y) + (v[2 * j + 1].z * v[2 * j + 1].z + v[2 * j + 1].w * v[2 * j + 1].w); }
            sq = wave_sum(sq);
            const float rs = 1.f / sqrtf(sq * (1.f / DM) + EPS);
            asm volatile("s_waitcnt vmcnt(0)" ::: "memory");
#pragma unroll
            for (int j = 0; j < 4; ++j) { const int c0 = 8 * (F.lane + 64 * j); const f32x4 g0 = *(const f32x4*)(gf + c0), g1 = *(const f32x4*)(gf + c0 + 4);
                __builtin_nontemporal_store(v[2 * j] * rs * g0, (f32x4*)(xo + c0)); __builtin_nontemporal_store(v[2 * j + 1] * rs * g1, (f32x4*)(xo + c0 + 4)); }
        }
    } } xcd_barrier(xbar); }
        { constexpr bool dup = false; (void)dup; { {
        const float* gf = inp(F, I_NFINAL);
        for (int r2 = F.bid; r2 < MS / 2; r2 += F.G) {
            const int row = MP + 2 * r2 + (F.wave >> 2), qd = F.wave & 3, pm = row >> 8, rl = row & 255;
            const float* Pb = (const float*)(ws + (pm == 32 ? WS_WUP : WS_XB));
            f32x4 v[2]; float sq = 0.f;
#pragma unroll
            for (int jj = 0; jj < 2; ++jj) { const int col = 512 * qd + 256 * jj + 4 * F.lane, pn = col >> 8, cl = col & 255;
                f32x4 a = *(const f32x4*)(args.out + (size_t)row * DM + col);
                const float* pp = Pb + (size_t)(pn * 16) * 65536 + rl * 256 + cl;
#pragma unroll
                for (int sl = 0; sl < 16; ++sl) a += *(const f32x4*)(pp + (size_t)sl * 65536);
                v[jj] = a; sq += (a.x * a.x + a.y * a.y) + (a.z * a.z + a.w * a.w); }
            sq = wave_sum(sq);
            LAS float* red = (LAS float*)(F.lds + MISC_OFF + 128);
            if (F.lane == 0) red[F.wave] = sq;
            __syncthreads();
            const int w0 = F.wave & 4; const float tot = (red[w0] + red[w0 + 1]) + (red[w0 + 2] + red[w0 + 3]);
            __syncthreads();
            const float rs = dup ? 1.f : 1.f / sqrtf(tot * (1.f / DM) + EPS);
#pragma unroll
            for (int jj = 0; jj < 2; ++jj) { const int col = 512 * qd + 256 * jj + 4 * F.lane; const f32x4 gr = dup ? (f32x4){1.f, 1.f, 1.f, 1.f} : *(const f32x4*)(gf + col);
                f32x4 o = v[jj] * rs * gr; if (dup) o = *(const f32x4*)(args.out + (size_t)row * DM + col);
                *(f32x4*)(args.out + (size_t)row * DM + col) = o; }
        }
        for (int m = F.bid * NWAVES + F.wave; m < MP; m += F.G * NWAVES) {
            const v4u* xb = (const v4u*)(args.out + (size_t)m * DM) + F.lane; float* xo = args.out + (size_t)m * DM;
            v4u w[4]; float sq = 0.f; f32x4 v[8];
#pragma unroll
            for (int j = 0; j < 4; ++j) w[j] = xb[64 * j];
#pragma unroll
            for (int j = 0; j < 4; ++j) { v[2 * j] = (f32x4){bflo(w[j].x), bfhi(w[j].x), bflo(w[j].y), bfhi(w[j].y)}; v[2 * j + 1] = (f32x4){bflo(w[j].z), bfhi(w[j].z), bflo(w[j].w), bfhi(w[j].w)};
                sq += (v[2 * j].x * v[2 * j].x + v[2 * j].y * v[2 * j].y) + (v[2 * j].z * v[2 * j].z + v[2 * j].w * v[2 * j].w) + (v[2 * j + 1].x * v[2 * j + 1].x + v[2 * j + 1].y * v[2 * j + 1].y) + (v[2 * j + 1].z * v[2 * j + 1].z + v[2 * j + 1].w * v[2 * j + 1].w); }
            sq = wave_sum(sq);
            const float rs = 1.f / sqrtf(sq * (1.f / DM) + EPS);
            asm volatile("s_waitcnt vmcnt(0)" ::: "memory");
#pragma unroll
            for (int j = 0; j < 4; ++j) { const int c0 = 8 * (F.lane + 64 * j); const f32x4 g0 = *(const f32x4*)(gf + c0), g1 = *(const f32x4*)(gf + c0 + 4);
                __builtin_nontemporal_store(v[2 * j] * rs * g0, (f32x4*)(xo + c0)); __builtin_nontemporal_store(v[2 * j + 1] * rs * g1, (f32x4*)(xo + c0 + 4)); }
        }
    } } }
    }
#undef IN
#undef SEAM
}

#ifndef MK_MULTI_LAUNCH
#define MK_MULTI_LAUNCH 0
#endif
extern "C" void kernel_launch(void* const* d_in, const int* in_sizes, int n_in, void* d_out, int out_size, void* d_ws, size_t ws_size, hipStream_t stream) {
    static int grid = 0;
    if (grid == 0) {
        if (n_in != 32 || (size_t)out_size != O_END || ws_size < WS_END) { fprintf(stderr, "kernel_launch: unexpected sizes n_in %d out %d ws %zu\n", n_in, out_size, ws_size); grid = -1; return; }
        int dev = 0, cus = 0, per_cu = 0;
        hipGetDevice(&dev); hipDeviceGetAttribute(&cus, hipDeviceAttributeMultiprocessorCount, dev);
        if (hipFuncSetAttribute((const void*)fwd_megakernel, hipFuncAttributeMaxDynamicSharedMemorySize, LDS_BYTES) != hipSuccess) { fprintf(stderr, "kernel_launch: hipFuncSetAttribute failed\n"); grid = -1; return; }
        if (hipOccupancyMaxActiveBlocksPerMultiprocessor(&per_cu, (const void*)fwd_megakernel, NTHR, LDS_BYTES) != hipSuccess || per_cu < 1) { fprintf(stderr, "kernel_launch: occupancy query says %d\n", per_cu); per_cu = 1; }
        (void)hipGetLastError();
        grid = cus * 1;
        fprintf(stderr, "kernel_launch: grid %d (cus %d, per_cu %d)\n", grid, cus, per_cu);
    }
    if (grid < 0) return;
    hipMemsetAsync((char*)d_ws + WS_CTL, 0, CTL_BYTES, stream);
    Args a{};
    for (int i = 0; i < 32; ++i) a.in[i] = (const float*)d_in[i];
    a.out = (float*)d_out; a.ws = (unsigned char*)d_ws;
#if MK_MULTI_LAUNCH
    for (int p = 0; p < NPHASE; ++p) { a.ph_lo = p; a.ph_hi = p + 1; hipLaunchKernelGGL(fwd_megakernel, dim3(grid), dim3(NTHR), LDS_BYTES, stream, a); }
#else
    a.ph_lo = 0; a.ph_hi = NPHASE;
    void* kargs[] = {&a};
    hipError_t e = hipLaunchCooperativeKernel((const void*)fwd_megakernel, dim3(grid), dim3(NTHR), kargs, LDS_BYTES, stream);
    if (e != hipSuccess) fprintf(stderr, "kernel_launch: cooperative launch failed: %s (grid %d)\n", hipGetErrorString(e), grid);
#endif
}
```

```cpp
#include <hip/hip_runtime.h>
#include <hip/hip_cooperative_groups.h>
#include <cstdio>
#include <cstdint>
namespace cg = cooperative_groups;

namespace pg8 {
#define PG8_LAS __attribute__((address_space(3)))
typedef unsigned short bf16_t;
typedef short bf16x8 __attribute__((ext_vector_type(8)));
typedef float f32x4 __attribute__((ext_vector_type(4)));
typedef unsigned u32x4 __attribute__((ext_vector_type(4)));
constexpr int BM = 256, BK = 64, HALF = 128, HTB = HALF * BK * 2  , STAGE_BYTES = 8 * HTB, NXCD = 8, WGM = 8;

__host__ __device__ __forceinline__ int lds_byte(int r, int c) { const int st = (r >> 4) * 2 + (c >> 5), rr = r & 15, cc = c & 31, ob = rr * 64 + cc * 2; return st * 1024 + (ob ^ (((ob >> 9) & 1) << 5)); }
__host__ __device__ __forceinline__ void stage_rc(int b, int& R, int& C) { const int st = b / 1024, sb = b % 1024, swz = sb ^ (((sb >> 9) & 1) << 5); R = (st >> 1) * 16 + swz / 64; C = (st & 1) * 32 + (swz % 64) / 2; }
__host__ __device__ __forceinline__ int perm32(int rho) { const int n = rho >> 4, i = rho & 15; return 8 * (i >> 2) + 4 * n + (i & 3); }

struct Unit { int pm, pn, z; };
struct Gemm { const bf16_t* A; const bf16_t* Bt; int lda, ldb, K; size_t sA, sB; };

struct Order {
    int nM, nN, nZ, G, c;
    __device__ void init(int M, int N, int Z, int G_, int c_) { nM = M / BM; nN = N / BM; nZ = Z; G = G_; c = c_; }
    __device__ bool next(int i, Unit& u) const {
        int zz = 0; if (nZ < 0) { zz = i & 1; i >>= 1; }
        const long L = (long)i * G + c; const int nwg = nM * nN; if (L >= (long)nwg * (nZ < 0 ? 1 : nZ)) return false;
        if (nZ > 1) { const int z = (int)(L / nwg), r = (int)(L % nwg); u.z = z; u.pm = r % nM; u.pn = r / nM; return true; }
        int wgid = (int)L; { const int q = nwg / NXCD, r = nwg % NXCD, xcd = wgid % NXCD, off = wgid / NXCD; wgid = (xcd < r ? xcd * (q + 1) : r * (q + 1) + (xcd - r) * q) + off; }
        const int nig = WGM * nN, gid = wgid / nig, fm = gid * WGM, gsz = (nM - fm) < WGM ? (nM - fm) : WGM;
        u.pm = fm + ((wgid % nig) % gsz); u.pn = (wgid % nig) / gsz; u.z = zz; return true;
    }
    __device__ __forceinline__ void a_ready(const Unit&) const {}
    __device__ __forceinline__ void done(const Unit&) const {}
};

__device__ __forceinline__ unsigned cvt_pk_bf16(float lo, float hi) { unsigned r; asm volatile("v_cvt_pk_bf16_f32 %0, %1, %2" : "=v"(r) : "v"(lo), "v"(hi)); return r; }

template <class Epi, class Sched, bool ALIGN_EPI = false, bool SP2 = false>
__device__ __forceinline__ void gemm_phase(PG8_LAS unsigned char* lds, const Gemm g, const Sched& S, const Epi& E) {
    const int tid = threadIdx.x, wid = __builtin_amdgcn_readfirstlane(tid >> 6), lane = tid & 63, wr = wid >> 2, wc = wid & 3, fr = lane & 15, fq = lane >> 4;
    const int K = g.K, nt = K / BK;
    unsigned voffA[2], voffB[2];
#pragma unroll
    for (int i = 0; i < 2; ++i) { int R, C; stage_rc(tid * 16 + i * 8192, R, C); const int Rb = Epi::PERM ? ((R & ~31) + perm32(R & 31)) : R;
        voffA[i] = (unsigned)(R * g.lda + C) * 2u; voffB[i] = (unsigned)(Rb * g.ldb + C) * 2u; }
    const size_t kstep = (size_t)(BK * 2);
    const size_t hstepA = (size_t)HALF * g.lda * 2, hstepB = (size_t)HALF * g.ldb * 2;
    const size_t tstepA = 2 * hstepA, tstepB = 2 * hstepB;
    const unsigned ldsw = (unsigned)wid * 1024u;
    const int aoff = lds_byte(wr * 64 + fr, fq * 8), boff = lds_byte(wc * 32 + fr, fq * 8);
#define PG8_SA(b, h) (((b) * 2 + (h)) * HTB)
#define PG8_SB(b, h) ((4 + (b) * 2 + (h)) * HTB)
#define PG8_STAGE(bufoff, gbase, voff) do { _Pragma("unroll") for (int _i = 0; _i < 2; ++_i) \
        __builtin_amdgcn_global_load_lds((const unsigned*)((const char*)(gbase) + (voff)[_i]), (PG8_LAS unsigned*)(lds + (bufoff) + ldsw + _i * 8192), 16, 0, 0); } while (0)
#define PG8_LDA(dst, b, h) do { _Pragma("unroll") for (int m = 0; m < 4; ++m) _Pragma("unroll") for (int k = 0; k < 2; ++k) dst[m][k] = *(const PG8_LAS bf16x8*)(lds + PG8_SA(b, h) + aoff + m * 2048 + k * 1024); } while (0)
#define PG8_LDB(dst, b, h) do { _Pragma("unroll") for (int n = 0; n < 2; ++n) _Pragma("unroll") for (int k = 0; k < 2; ++k) dst[n][k] = *(const PG8_LAS bf16x8*)(lds + PG8_SB(b, h) + boff + n * 2048 + k * 1024); } while (0)
#define PG8_MMA(ai, bj, At, Bt) do { __builtin_amdgcn_s_setprio(1); _Pragma("unroll") for (int m = 0; m < 4; ++m) _Pragma("unroll") for (int n = 0; n < 2; ++n) _Pragma("unroll") for (int k = 0; k < 2; ++k) \
        acc[ai][bj][m][n] = __builtin_amdgcn_mfma_f32_16x16x32_bf16(Bt[n][k], At[m][k], acc[ai][bj][m][n], 0, 0, 0); __builtin_amdgcn_s_setprio(0); } while (0)
#define PG8_WAIT_V(n) asm volatile("s_waitcnt vmcnt(" #n ")" ::: "memory")
#define PG8_WAIT_L(n) asm volatile("s_waitcnt lgkmcnt(" #n ")" ::: "memory")
#define PG8_BAR __builtin_amdgcn_s_barrier()
#define PG8_SCHED __builtin_amdgcn_sched_barrier(0)
    Unit cur, nxt; int ui = 0;
    if (!S.next(0, cur)) return;
    f32x4 acc[2][2][4][2];
#pragma unroll
    for (int a = 0; a < 2; ++a)
#pragma unroll
        for (int b = 0; b < 2; ++b)
#pragma unroll
            for (int m = 0; m < 4; ++m)
#pragma unroll
                for (int n = 0; n < 2; ++n) acc[a][b][m][n] = (f32x4){0.f, 0.f, 0.f, 0.f};
    bf16x8 At[4][2], B0[2][2], B1[2][2];
    const char* cA = (const char*)g.A + (size_t)cur.z * g.sA * 2 + (size_t)cur.pm * tstepA; const char* cB = (const char*)g.Bt + (size_t)cur.z * g.sB * 2 + (size_t)cur.pn * tstepB;
    S.a_ready(cur);
    if constexpr (SP2) {
        PG8_STAGE(PG8_SB(0, 0), cB, voffB); PG8_STAGE(PG8_SB(0, 1), cB + hstepB, voffB); PG8_STAGE(PG8_SA(0, 0), cA, voffA); PG8_STAGE(PG8_SA(0, 1), cA + hstepA, voffA);
        if (wr == 1) PG8_BAR;
        PG8_WAIT_V(2); PG8_BAR;
        PG8_STAGE(PG8_SB(1, 0), cB + kstep, voffB); PG8_STAGE(PG8_SA(1, 0), cA + kstep, voffA); PG8_STAGE(PG8_SB(1, 1), cB + hstepB + kstep, voffB);
        PG8_WAIT_V(6); PG8_BAR;
    } else {
        PG8_STAGE(PG8_SB(0, 0), cB, voffB); PG8_STAGE(PG8_SA(0, 0), cA, voffA); PG8_STAGE(PG8_SB(0, 1), cB + hstepB, voffB); PG8_STAGE(PG8_SA(0, 1), cA + hstepA, voffA);
        if (wr == 1) PG8_BAR;
        PG8_WAIT_V(4); PG8_BAR;
        PG8_STAGE(PG8_SB(1, 0), cB + kstep, voffB); PG8_STAGE(PG8_SA(1, 0), cA + kstep, voffA); PG8_STAGE(PG8_SB(1, 1), cB + hstepB + kstep, voffB);
        PG8_WAIT_V(6); PG8_BAR;
    }
    for (;;) {
        const bool has_next = S.next(ui + 1, nxt);
        const char* nA = has_next ? (const char*)g.A + (size_t)nxt.z * g.sA * 2 + (size_t)nxt.pm * tstepA : cA; const char* nB = has_next ? (const char*)g.Bt + (size_t)nxt.z * g.sB * 2 + (size_t)nxt.pn * tstepB : cB;
        for (int t = 0; t < nt; t += 2) {
            const bool last = (t == nt - 2);
            const char* a1 = cA + (size_t)(t + 1) * kstep;
            const char* a2 = last ? nA : cA + (size_t)(t + 2) * kstep; const char* b2 = last ? nB : cB + (size_t)(t + 2) * kstep;
            const char* a3 = a2 + kstep; const char* b3 = b2 + kstep;
            if (last && has_next) S.a_ready(nxt);
            if constexpr (SP2) {
            PG8_LDB(B0, 0, 0); PG8_LDB(B1, 0, 1); PG8_SCHED; PG8_LDA(At, 0, 0); PG8_STAGE(PG8_SA(1, 1), a1 + hstepA, voffA);
            PG8_WAIT_V(8); PG8_WAIT_L(0); PG8_BAR; PG8_MMA(0, 0, At, B0); PG8_MMA(0, 1, At, B1); PG8_BAR; PG8_SCHED;
            PG8_LDA(At, 0, 1); PG8_STAGE(PG8_SB(0, 0), b2, voffB); PG8_STAGE(PG8_SB(0, 1), b2 + hstepB, voffB); PG8_STAGE(PG8_SA(0, 0), a2, voffA);
            PG8_WAIT_V(8); PG8_WAIT_L(0); PG8_BAR; PG8_MMA(1, 0, At, B0); PG8_MMA(1, 1, At, B1); PG8_BAR; PG8_SCHED;
            PG8_LDB(B0, 1, 0); PG8_LDB(B1, 1, 1); PG8_SCHED; PG8_LDA(At, 1, 0); PG8_STAGE(PG8_SA(0, 1), a2 + hstepA, voffA);
            PG8_WAIT_V(8); PG8_WAIT_L(0); PG8_BAR; PG8_MMA(0, 0, At, B0); PG8_MMA(0, 1, At, B1); PG8_BAR; PG8_SCHED;
            PG8_LDA(At, 1, 1); PG8_STAGE(PG8_SB(1, 0), b3, voffB); PG8_STAGE(PG8_SB(1, 1), b3 + hstepB, voffB); PG8_STAGE(PG8_SA(1, 0), a3, voffA);
            PG8_WAIT_V(8); PG8_WAIT_L(0); PG8_BAR; PG8_MMA(1, 0, At, B0); PG8_MMA(1, 1, At, B1); PG8_BAR; PG8_SCHED;
            } else {
            PG8_LDB(B0, 0, 0); PG8_SCHED; PG8_LDA(At, 0, 0); PG8_STAGE(PG8_SA(1, 1), a1 + hstepA, voffA);
            PG8_WAIT_L(8); PG8_BAR; PG8_WAIT_L(0); PG8_MMA(0, 0, At, B0); PG8_BAR; PG8_SCHED;
            PG8_LDB(B1, 0, 1); PG8_STAGE(PG8_SB(0, 0), b2, voffB);
            PG8_BAR; PG8_WAIT_L(0); PG8_MMA(0, 1, At, B1); PG8_BAR;
            PG8_LDA(At, 0, 1); PG8_STAGE(PG8_SA(0, 0), a2, voffA);
            PG8_BAR; PG8_WAIT_L(0); PG8_MMA(1, 0, At, B0); PG8_BAR; PG8_SCHED;
            PG8_STAGE(PG8_SB(0, 1), b2 + hstepB, voffB);
            PG8_WAIT_V(6); PG8_BAR; PG8_MMA(1, 1, At, B1); PG8_BAR;
            PG8_LDB(B0, 1, 0); PG8_SCHED; PG8_LDA(At, 1, 0); PG8_STAGE(PG8_SA(0, 1), a2 + hstepA, voffA);
            PG8_WAIT_L(8); PG8_BAR; PG8_WAIT_L(0); PG8_MMA(0, 0, At, B0); PG8_BAR; PG8_SCHED;
            PG8_LDB(B1, 1, 1); PG8_STAGE(PG8_SB(1, 0), b3, voffB);
            PG8_BAR; PG8_WAIT_L(0); PG8_MMA(0, 1, At, B1); PG8_BAR;
            PG8_LDA(At, 1, 1); PG8_STAGE(PG8_SA(1, 0), a3, voffA);
            PG8_BAR; PG8_WAIT_L(0); PG8_MMA(1, 0, At, B0); PG8_BAR; PG8_SCHED;
            PG8_STAGE(PG8_SB(1, 1), b3 + hstepB, voffB);
            PG8_WAIT_V(6); PG8_BAR; PG8_MMA(1, 1, At, B1); PG8_BAR;
            }
        }
        if constexpr (ALIGN_EPI) { if (wr == 0) PG8_BAR; }
        if constexpr (!Epi::AFTER_DRAIN) { E(acc, cur, wr, wc, fr, fq); S.done(cur); }
        if (!has_next) break;
        if (!(Epi::TWO_PART && cur.z == 0)) {
#pragma unroll
        for (int a = 0; a < 2; ++a)
#pragma unroll
            for (int b = 0; b < 2; ++b)
#pragma unroll
                for (int m = 0; m < 4; ++m)
#pragma unroll
                    for (int n = 0; n < 2; ++n) acc[a][b][m][n] = (f32x4){0.f, 0.f, 0.f, 0.f};
        }
        cur = nxt; cA = nA; cB = nB; ++ui;
        if constexpr (ALIGN_EPI) { if (wr == 1) PG8_BAR; }
    }
    PG8_WAIT_V(0);
    if constexpr (!ALIGN_EPI) { if (wr == 0) PG8_BAR; }
    PG8_BAR;
    if constexpr (Epi::AFTER_DRAIN) { E.fused(acc, cur, wr, wc, fr, fq, lds, wid, lane); S.done(cur); }
#undef PG8_SA
#undef PG8_SB
#undef PG8_STAGE
#undef PG8_LDA
#undef PG8_LDB
#undef PG8_MMA
#undef PG8_WAIT_V
#undef PG8_WAIT_L
#undef PG8_BAR
#undef PG8_SCHED
}
}

constexpr int NWAVES = 8, NTHR = 512;
constexpr int DM = 2048, DLRU = 1024, DS5 = 1024, DFF = 8192, NZ = 3072;
constexpr int MP = 8192, MS = 512, MT = MP + MS;
constexpr int SEQ = 2048, NB = 4, NSEQ = 128;
constexpr int NG = 64, NPAIR = 32, LCH = 16, NCH = 128;
constexpr int A2_LD = 768, A2_ROWS = 512;
constexpr float EPS = 1e-6f;

constexpr size_t MiB = 1u << 20;
constexpr size_t WS_CTL = 0, CTL_BYTES = 1 * MiB;
constexpr size_t CTL_SSQA = 0, CTL_SSQB = 64 * 1024, CTL_SSQ1 = 128 * 1024, CTL_SSQ2 = 192 * 1024, CTL_CNT = 256 * 1024, CTL_BAR = 512 * 1024;
constexpr size_t WS_SMALL = 1 * MiB;
constexpr size_t SM_WGA = WS_SMALL, SM_WGX = SM_WGA + 131072;
constexpr size_t SM_AGG = SM_WGX + 131072;
constexpr size_t SM_RS0 = SM_AGG + 524288;
constexpr size_t SM_E1 = SM_RS0 + 65536, SM_E16 = SM_E1 + 32768;
constexpr size_t SM_BBAR = SM_E16 + 32768;
constexpr size_t SM_SP = SM_BBAR + 524288;
static_assert(SM_SP + 4096 <= 4 * MiB, "small region");
constexpr size_t WS_WUP = 4 * MiB, WS_WDOWN = 36 * MiB, WS_XB = 68 * MiB;
constexpr size_t WS_H = 102 * MiB;
constexpr size_t WS_WIN = 102 * MiB, WS_WGLU = 114 * MiB, WS_WOUT = 116 * MiB;
constexpr size_t WS_M1 = 124 * MiB;
constexpr size_t WS_KG = 132 * MiB;
constexpr size_t WS_A2 = 156 * MiB;
constexpr size_t WS_US = 180 * MiB;
constexpr size_t WS_S = 182 * MiB;
constexpr size_t WS_MIX = 198 * MiB;
constexpr size_t WS_END = 246 * MiB;
constexpr size_t WS_AGG = 238 * MiB;
constexpr size_t WS_HIN = 242 * MiB;
static_assert(WS_XB + (size_t)MT * DM * 2 <= WS_H && WS_H + (size_t)MT * DFF * 2 <= WS_AGG && WS_MIX + (size_t)MT * DM * 2 <= WS_AGG, "ws map");
constexpr size_t DO_XLRU = 0, DO_GLRU = (size_t)MT * DLRU * 4, DO_G = DO_GLRU + (size_t)MT * DLRU * 2;
constexpr size_t O_Y = 0, O_CONVP = (size_t)MT * DM, O_LRUP = O_CONVP + 4 * 3 * 1024, O_REP = O_LRUP + 4 * 1024, O_IMP = O_REP + 4 * 64 * 64,
                 O_CONVS = O_IMP + 4 * 64 * 64, O_LRUS = O_CONVS + 128 * 3 * 1024, O_RES = O_LRUS + 128 * 1024, O_IMS = O_RES + 128 * 64 * 64, O_END = O_IMS + 128 * 64 * 64;

constexpr int RING_BYTES = 131072, MISC_OFF = RING_BYTES, LDS_BYTES = 147456;

#define LAS __attribute__((address_space(3)))
typedef unsigned short bf16;
typedef unsigned v4u __attribute__((ext_vector_type(4)));
typedef unsigned v2u __attribute__((ext_vector_type(2)));
typedef float f32x4 __attribute__((ext_vector_type(4)));
typedef short bf16x8 __attribute__((ext_vector_type(8)));
#define LDS_WAIT() asm volatile("s_waitcnt lgkmcnt(0)" ::: "memory")

__device__ __forceinline__ unsigned f2bf(float f) { unsigned u = __builtin_bit_cast(unsigned, f); return (u + 0x7fffu + ((u >> 16) & 1u)) >> 16; }
__device__ __forceinline__ unsigned pk2(float lo, float hi) { return f2bf(lo) | (f2bf(hi) << 16); }
__device__ __forceinline__ float bf2f(unsigned b) { return __builtin_bit_cast(float, b << 16); }
__device__ __forceinline__ float bflo(unsigned w) { return __builtin_bit_cast(float, w << 16); }
__device__ __forceinline__ float bfhi(unsigned w) { return __builtin_bit_cast(float, w & 0xffff0000u); }
__device__ __forceinline__ float sigmoidf_(float x) { return __builtin_amdgcn_rcpf(1.f + __expf(-x)); }
__device__ __forceinline__ float gelu_tanh(float x) { const float u = 1.5957691216f * (x + 0.044715f * x * x * x); return x * __builtin_amdgcn_rcpf(1.f + __expf(-u)); }
__device__ __forceinline__ float wave_sum(float v) {
#pragma unroll
    for (int o = 1; o < 64; o <<= 1) v += __shfl_xor(v, o);
    return v;
}
__device__ __forceinline__ void sincos_d(double x, double& s, double& c) {
    const double q = rint(x * 0.63661977236758134308), r = (x - q * 1.57079632679489655800) - q * 6.12323399573676603587e-17, r2 = r * r;
    double sr = 1.0 - r2 / 210.0; sr = 1.0 - r2 / 156.0 * sr; sr = 1.0 - r2 / 110.0 * sr; sr = 1.0 - r2 / 72.0 * sr; sr = 1.0 - r2 / 42.0 * sr; sr = 1.0 - r2 / 20.0 * sr; sr = 1.0 - r2 / 6.0 * sr; sr *= r;
    double cr = 1.0 - r2 / 182.0; cr = 1.0 - r2 / 132.0 * cr; cr = 1.0 - r2 / 90.0 * cr; cr = 1.0 - r2 / 56.0 * cr; cr = 1.0 - r2 / 30.0 * cr; cr = 1.0 - r2 / 12.0 * cr; cr = 1.0 - r2 / 2.0 * cr;
    const int qi = ((int)q) & 3;
    s = (qi == 0) ? sr : (qi == 1) ? cr : (qi == 2) ? -sr : -cr;
    c = (qi == 0) ? cr : (qi == 1) ? -sr : (qi == 2) ? -cr : sr;
}

namespace pg8 {
#define EPI_ROWS_BEGIN const int row0 = u.pm * BM + wr * 64 + fr; _Pragma("unroll") for (int ai = 0; ai < 2; ++ai) _Pragma("unroll") for (int m = 0; m < 4; ++m) { const int row = row0 + ai * HALF + m * 16;
#define EPI_ROWS_END }
__device__ __forceinline__ float fq_sum(float v) { v += __shfl_xor(v, 16); v += __shfl_xor(v, 32); return v; }
__device__ __forceinline__ float sq8(const f32x4& a, const f32x4& b) { return (a[0] * a[0] + a[1] * a[1]) + (a[2] * a[2] + a[3] * a[3]) + (b[0] * b[0] + b[1] * b[1]) + (b[2] * b[2] + b[3] * b[3]); }
__device__ __forceinline__ u32x4 pack8(const f32x4& a, const f32x4& b) { u32x4 w; w.x = cvt_pk_bf16(a[0], a[1]); w.y = cvt_pk_bf16(a[2], a[3]); w.z = cvt_pk_bf16(b[0], b[1]); w.w = cvt_pk_bf16(b[2], b[3]); return w; }

struct EpiZ {
    static constexpr bool PERM = true, AFTER_DRAIN = false, TWO_PART = false;
    const float* rs0; float* xlru; bf16_t* glru; bf16_t* A2; bf16_t* us;
    __device__ __forceinline__ void operator()(const f32x4 (&acc)[2][2][4][2], const Unit& u, int wr, int wc, int fr, int fq) const {
        const int colt = u.pn * BM + wc * 32 + 8 * fq;
        EPI_ROWS_BEGIN
            const float s = rs0[row];
#pragma unroll
            for (int bj = 0; bj < 2; ++bj) { const int col = colt + bj * HALF; const f32x4 v0 = acc[ai][bj][m][0] * s, v1 = acc[ai][bj][m][1] * s;
                if (u.pn < 4) { float* p = xlru + (size_t)row * DLRU + col; *(f32x4*)p = v0; *(f32x4*)(p + 4) = v1; }
                else if (u.pn < 8) { *(u32x4*)(glru + (size_t)row * DLRU + (col - 1024)) = pack8(v0, v1); }
                else { const int c = col - 2048;
                    if (u.pm < 32) *(u32x4*)(A2 + ((size_t)(c >> 5) * A2_ROWS + (row >> 4)) * A2_LD + (row & 15) * 32 + (c & 31)) = pack8(v0, v1);
                    else *(u32x4*)(us + (size_t)(row - MP) * DS5 + c) = pack8(v0, v1); } }
        EPI_ROWS_END
    }
};
struct EpiS {
    static constexpr bool PERM = true, AFTER_DRAIN = false, TWO_PART = false;
    float* S;
    __device__ __forceinline__ void operator()(const f32x4 (&acc)[2][2][4][2], const Unit& u, int wr, int wc, int fr, int fq) const {
        const int colt = u.pn * BM + wc * 32 + 8 * fq;
        EPI_ROWS_BEGIN
#pragma unroll
            for (int bj = 0; bj < 2; ++bj) { float* p = S + ((size_t)u.z * A2_ROWS + row) * 256 + colt + bj * HALF; *(f32x4*)p = acc[ai][bj][m][0]; *(f32x4*)(p + 4) = acc[ai][bj][m][1]; }
        EPI_ROWS_END
    }
};
struct EpiY {
    static constexpr bool PERM = true, AFTER_DRAIN = false, TWO_PART = false;
    bf16_t* gbuf;
    __device__ __forceinline__ void operator()(const f32x4 (&acc)[2][2][4][2], const Unit& u, int wr, int wc, int fr, int fq) const {
        EPI_ROWS_BEGIN
#pragma unroll
            for (int bj = 0; bj < 2; ++bj) { const int j = 8 * u.pn + 4 * bj + wc; f32x4 v0 = acc[ai][bj][m][0], v1 = acc[ai][bj][m][1];
#pragma unroll
                for (int e = 0; e < 4; ++e) { v0[e] = gelu_tanh(v0[e]); v1[e] = gelu_tanh(v1[e]); }
                *(u32x4*)(gbuf + (size_t)(row * 16 + j) * DS5 + u.z * 32 + 8 * fq) = pack8(v0, v1); }
        EPI_ROWS_END
    }
};
struct EpiGlu {
    static constexpr bool PERM = true, AFTER_DRAIN = false, TWO_PART = false;
    const bf16_t* gbuf; const float* bglu; bf16_t* mix; float* ssqb;
    __device__ __forceinline__ void operator()(const f32x4 (&acc)[2][2][4][2], const Unit& u, int wr, int wc, int fr, int fq) const {
        const int colt = u.pn * BM + wc * 32 + 8 * fq;
        EPI_ROWS_BEGIN
            float sum = 0.f;
#pragma unroll
            for (int bj = 0; bj < 2; ++bj) { const int col = colt + bj * HALF; const u32x4 gw = *(const u32x4*)(gbuf + (size_t)row * DS5 + col);
                const f32x4 b0 = *(const f32x4*)(bglu + col), b1 = *(const f32x4*)(bglu + col + 4);
                f32x4 v0 = acc[ai][bj][m][0] + b0, v1 = acc[ai][bj][m][1] + b1;
                v0[0] = bflo(gw.x) * sigmoidf_(v0[0]); v0[1] = bfhi(gw.x) * sigmoidf_(v0[1]); v0[2] = bflo(gw.y) * sigmoidf_(v0[2]); v0[3] = bfhi(gw.y) * sigmoidf_(v0[3]);
                v1[0] = bflo(gw.z) * sigmoidf_(v1[0]); v1[1] = bfhi(gw.z) * sigmoidf_(v1[1]); v1[2] = bflo(gw.w) * sigmoidf_(v1[2]); v1[3] = bfhi(gw.w) * sigmoidf_(v1[3]);
                sum += sq8(v0, v1);
                *(u32x4*)(mix + (size_t)row * DM + 1024 + col) = pack8(v0, v1); }
            sum = fq_sum(sum); if (fq == 0) atomicAdd(ssqb + row, sum);
        EPI_ROWS_END
    }
};
struct EpiOut {
    static constexpr bool PERM = true, AFTER_DRAIN = false, TWO_PART = true;
    const float* ssqa; const float* ssqb; const float* xp; const float* xs; float* x1; bf16_t* x1b; float* ssq1;
    __device__ __forceinline__ void operator()(f32x4 (&acc)[2][2][4][2], const Unit& u, int wr, int wc, int fr, int fq) const {
        const int colt = u.pn * BM + wc * 32 + 8 * fq;
        if (u.z == 0) {
            EPI_ROWS_BEGIN
                const float ra = ssqa[row] * (1.f / DLRU) + EPS, rb = ssqb[row] * (1.f / DS5) + EPS, ratio = sqrtf(rb / ra);
#pragma unroll
                for (int bj = 0; bj < 2; ++bj) { acc[ai][bj][m][0] = acc[ai][bj][m][0] * ratio; acc[ai][bj][m][1] = acc[ai][bj][m][1] * ratio; }
            EPI_ROWS_END
        } else {
            EPI_ROWS_BEGIN
                const float rb = 1.f / sqrtf(ssqb[row] * (1.f / DS5) + EPS);
                const float* xr = (row < MP) ? xp + (size_t)row * DM : xs + (size_t)(row - MP) * DM;
                float sum = 0.f;
#pragma unroll
                for (int bj = 0; bj < 2; ++bj) { const int col = colt + bj * HALF;
                    const f32x4 v0 = *(const f32x4*)(xr + col) + acc[ai][bj][m][0] * rb, v1 = *(const f32x4*)(xr + col + 4) + acc[ai][bj][m][1] * rb;
                    *(u32x4*)(x1b + (size_t)row * DM + col) = pack8(v0, v1);
                    sum += sq8(v0, v1); }
                sum = fq_sum(sum); if (fq == 0) atomicAdd(ssq1 + row, sum);
            EPI_ROWS_END
        }
    }
};
struct EpiUp {
    static constexpr bool PERM = true, AFTER_DRAIN = false, TWO_PART = false;
    const float* ssq1; bf16_t* h;
    __device__ __forceinline__ void operator()(const f32x4 (&acc)[2][2][4][2], const Unit& u, int wr, int wc, int fr, int fq) const {
        const int colt = u.pn * BM + wc * 32 + 8 * fq;
        EPI_ROWS_BEGIN
            const float rs = 1.f / sqrtf(ssq1[row] * (1.f / DM) + EPS);
#pragma unroll
            for (int bj = 0; bj < 2; ++bj) { f32x4 v0 = acc[ai][bj][m][0] * rs, v1 = acc[ai][bj][m][1] * rs;
#pragma unroll
                for (int e = 0; e < 4; ++e) { const float a = fmaxf(v0[e], 0.f), b = fmaxf(v1[e], 0.f); v0[e] = a * a; v1[e] = b * b; }
                *(u32x4*)(h + (size_t)row * DFF + colt + bj * HALF) = pack8(v0, v1); }
        EPI_ROWS_END
    }
};
struct EpiDown {
    static constexpr bool PERM = true, AFTER_DRAIN = false, TWO_PART = false;
    float* x; const bf16_t* x1b; float mul;
    __device__ __forceinline__ void operator()(const f32x4 (&acc)[2][2][4][2], const Unit& u, int wr, int wc, int fr, int fq) const {
        const int colt = u.pn * BM + wc * 32 + 8 * fq;
        EPI_ROWS_BEGIN
#pragma unroll
            for (int bj = 0; bj < 2; ++bj) { float* p = x + (size_t)row * DM + colt + bj * HALF; const u32x4 w = *(const u32x4*)(x1b + (size_t)row * DM + colt + bj * HALF);
                const f32x4 v0 = (f32x4){bflo(w.x), bfhi(w.x), bflo(w.y), bfhi(w.y)} + acc[ai][bj][m][0] * mul, v1 = (f32x4){bflo(w.z), bfhi(w.z), bflo(w.w), bfhi(w.w)} + acc[ai][bj][m][1] * mul;
                (void)p; *(u32x4*)((bf16_t*)(x + (size_t)row * DM) + colt + bj * HALF) = pack8(v0, v1); }
        EPI_ROWS_END
    }
};
struct EpiPart {
    static constexpr bool PERM = true, AFTER_DRAIN = false, TWO_PART = false;
    float* P0; float* P1; int nsl;
    __device__ __forceinline__ void operator()(const f32x4 (&acc)[2][2][4][2], const Unit& u, int wr, int wc, int fr, int fq) const {
        const int t = ((u.pm - 32) * 8 + u.pn) * nsl + u.z, half = 8 * nsl;
        float* base = (t < half ? P0 + (size_t)t * 65536 : P1 + (size_t)(t - half) * 65536) + wc * 32 + 8 * fq;
        const int row0 = wr * 64 + fr;
#pragma unroll
        for (int ai = 0; ai < 2; ++ai)
#pragma unroll
            for (int m = 0; m < 4; ++m) { const int row = row0 + ai * HALF + m * 16;
#pragma unroll
                for (int bj = 0; bj < 2; ++bj) { float* p = base + row * 256 + bj * HALF; *(f32x4*)p = acc[ai][bj][m][0]; *(f32x4*)(p + 4) = acc[ai][bj][m][1]; } }
    }
};
struct EpiPartB {
    static constexpr bool PERM = true, AFTER_DRAIN = false, TWO_PART = false;
    bf16_t* P0; bf16_t* P1; int nsl;
    __device__ __forceinline__ void operator()(const f32x4 (&acc)[2][2][4][2], const Unit& u, int wr, int wc, int fr, int fq) const {
        const int t = ((u.pm - 32) * 8 + u.pn) * nsl + u.z, half = 8 * nsl;
        bf16_t* base = (t < half ? P0 + (size_t)t * 65536 : P1 + (size_t)(t - half) * 65536) + wc * 32 + 8 * fq;
        const int row0 = wr * 64 + fr;
#pragma unroll
        for (int ai = 0; ai < 2; ++ai)
#pragma unroll
            for (int m = 0; m < 4; ++m) { const int row = row0 + ai * HALF + m * 16;
#pragma unroll
                for (int bj = 0; bj < 2; ++bj) *(u32x4*)(base + row * 256 + bj * HALF) = pack8(acc[ai][bj][m][0], acc[ai][bj][m][1]); }
    }
};
struct SliceOrder {
    int c, nsl, G;
    __device__ bool next(int i, Unit& u) const { const int L = i * G + c; if (L >= 16 * nsl) return false; const int j = L / nsl; u.pm = 32 + (j >> 3); u.pn = j & 7; u.z = L - j * nsl; return true; }
    __device__ __forceinline__ void a_ready(const Unit&) const {}
    __device__ __forceinline__ void done(const Unit&) const {}
};
}

#define XB_TMO      128
#define XB_XCNT(j)  (256  + 64 * (j))
#define XB_XSUB(j)  (1280 + 64 * (j))
#define XB_XGEN(j)  (2304 + 64 * (j))
#define XB_TOP      3328
#define XB_TOPGEN   3392
#define XCD_BAR_WORDS 3456
#define XB_SPIN_CAP (1u << 18)

__device__ __forceinline__ unsigned xb_ld(unsigned* p)              { return __hip_atomic_load(p, __ATOMIC_RELAXED, __HIP_MEMORY_SCOPE_AGENT); }
__device__ __forceinline__ unsigned xb_add(unsigned* p, unsigned v) { return __hip_atomic_fetch_add(p, v, __ATOMIC_RELAXED, __HIP_MEMORY_SCOPE_AGENT); }
__device__ __forceinline__ unsigned xb_xcc_id() { return (unsigned)__builtin_amdgcn_s_getreg((3 << 11) | 20) & 0xFu; }
#define XB_SPIN(cond, bar) do { unsigned _sp = 0; while (cond) { __builtin_amdgcn_s_sleep(1); \
    if ((++_sp & 255u) == 0u) { if (xb_ld(&(bar)[XB_TMO])) break; if (_sp > XB_SPIN_CAP) { atomicAdd(&(bar)[XB_TMO], 1u); break; } } } } while (0)

struct XcdBarrier {
    unsigned* bar; unsigned x;
    volatile LAS unsigned* st;
};

__device__ __forceinline__ XcdBarrier xcd_barrier_post(unsigned* bar, volatile LAS unsigned* st) {
    XcdBarrier b; b.bar = bar; b.x = xb_xcc_id(); b.st = st;
    if (threadIdx.x == 0) (void)xb_add(&bar[XB_XCNT(b.x)], 1u);
    return b;
}
__device__ __forceinline__ void xcd_barrier_complete(unsigned* bar, unsigned x, unsigned& nloc, unsigned& nx) {
    const unsigned G = gridDim.x * gridDim.y * gridDim.z;
    unsigned sum, cnt, mine, sp = 0u;
    for (;;) {
        sum = 0u; cnt = 0u; mine = 0u;
#pragma unroll
        for (unsigned j = 0; j < 16; ++j) { const unsigned c = xb_ld(&bar[XB_XCNT(j)]); sum += c; cnt += (c > 0u) ? 1u : 0u; mine = (j == x) ? c : mine; }
        if (sum == G) break;
        __builtin_amdgcn_s_sleep(1);
        if ((++sp & 255u) == 0u) { if (xb_ld(&bar[XB_TMO])) break; if (sp > XB_SPIN_CAP) { atomicAdd(&bar[XB_TMO], 1u); break; } }
    }
    nloc = mine > 0u ? mine : 1u; nx = cnt > 0u ? cnt : 1u;
}

__device__ __forceinline__ void xcd_barrier(const XcdBarrier& b) {
    asm volatile("s_waitcnt vmcnt(0)" ::: "memory");
    __syncthreads();
    if (threadIdx.x == 0) {
        unsigned* bar = b.bar;
        __builtin_amdgcn_s_waitcnt(0);
        unsigned nloc = b.st[0], nx = b.st[1];
        if (nloc == 0u) { xcd_barrier_complete(bar, b.x, nloc, nx); b.st[0] = nloc; b.st[1] = nx; }
        const unsigned old = xb_add(&bar[XB_XSUB(b.x)], 1u);
        const unsigned gen = old / nloc;
        if (old + 1u == (gen + 1u) * nloc) {
            __builtin_amdgcn_fence(__ATOMIC_RELEASE, "agent");
            asm volatile("s_waitcnt vmcnt(0)" ::: "memory");
            const unsigned og = xb_add(&bar[XB_TOP], 1u);
            const unsigned tg = og / nx;
            if (og + 1u == (tg + 1u) * nx) xb_add(&bar[XB_TOPGEN], 1u);
            else XB_SPIN(xb_ld(&bar[XB_TOPGEN]) == tg, bar);
            __builtin_amdgcn_fence(__ATOMIC_ACQUIRE, "agent");
            xb_add(&bar[XB_XGEN(b.x)], 1u);
            asm volatile("s_waitcnt vmcnt(0)" ::: "memory");
        } else {
            XB_SPIN(xb_ld(&bar[XB_XGEN(b.x)]) == gen, bar);
            __builtin_amdgcn_fence(__ATOMIC_ACQUIRE, "agent");
            asm volatile("s_waitcnt vmcnt(0)" ::: "memory");
        }
    }
    __syncthreads();
}


struct Args { const float* in[32]; float* out; unsigned char* ws; int ph_lo, ph_hi; };
struct Frame {
    LAS unsigned char* lds;
    int tid, lane, wave, G, bid;
    float* out; unsigned char* ws;
};
constexpr int PTR_OFF = MISC_OFF + 256;
__device__ __forceinline__ const float* inp(const Frame& F, int i) {
    const LAS unsigned* T = (const LAS unsigned*)(F.lds + PTR_OFF);
    const unsigned lo = __builtin_amdgcn_readfirstlane(T[2 * i]), hi = __builtin_amdgcn_readfirstlane(T[2 * i + 1]);
    return (const float*)(((unsigned long long)hi << 32) | lo);
}
enum { I_XP = 0, I_XS, I_SCONV, I_SLRU, I_SRE, I_SIM, I_NMIX, I_WIN, I_CONVW, I_CONVB, I_WGA, I_BGA, I_WGX, I_BGX, I_LAMBDA, I_ARE, I_AIM, I_LOGSTEP, I_BRE, I_BIM, I_CRE, I_CIM,
       I_D, I_WGLU, I_BGLU, I_NOUTA, I_NOUTB, I_WOUT, I_NMLP, I_WUP, I_WDOWN, I_NFINAL };

__device__ __forceinline__ void tr_item(const float* __restrict__ W, const float* __restrict__ sc, int K, int N, bf16* __restrict__ WT, int item, int wave, int lane) {
    const int nblk = N >> 8, kb = item / nblk, nb = item - kb * nblk, k0 = kb * 64 + wave * 8, n0 = nb * 256 + 4 * lane;
    f32x4 v[8];
#pragma unroll
    for (int j = 0; j < 8; ++j) v[j] = *(const f32x4*)(W + (size_t)(k0 + j) * N + n0);
    if (sc) {
#pragma unroll
        for (int j = 0; j < 8; ++j) v[j] = v[j] * sc[k0 + j];
    }
#pragma unroll
    for (int e = 0; e < 4; ++e) { v4u o; o.x = pk2(v[0][e], v[1][e]); o.y = pk2(v[2][e], v[3][e]); o.z = pk2(v[4][e], v[5][e]); o.w = pk2(v[6][e], v[7][e]);
        *(v4u*)(WT + (size_t)(n0 + e) * K + k0) = o; }
}
__device__ __forceinline__ void tr_items_dyn(Frame& F, const float* W, const float* sc, int K, int N, bf16* WT, unsigned* counter, const float* sc_hi = nullptr) {
    LAS int* slot = (LAS int*)(F.lds + MISC_OFF + 64);
    const int nitems = (K >> 6) * (N >> 8);
    for (;;) {
        if (F.tid == 0) *slot = (int)atomicAdd(counter, 1u);
        __syncthreads();
        const int it = *slot;
        __syncthreads();
        if (it >= nitems) break;
        tr_item(W, (sc_hi && (it / (N >> 8)) >= 16) ? sc_hi - 1024 : sc, K, N, WT, it, F.wave, F.lane);
    }
}
__device__ __forceinline__ void p0_x_row(const float* xrow, bf16* orow, float* rs, int lane) {
    const f32x4* xr = (const f32x4*)xrow + lane; f32x4 v[8]; float s = 0.f;
#pragma unroll
    for (int j = 0; j < 8; ++j) { v[j] = xr[64 * j]; s += (v[j].x * v[j].x + v[j].y * v[j].y) + (v[j].z * v[j].z + v[j].w * v[j].w); }
    s = wave_sum(s);
    if (lane == 0) *rs = 1.f / sqrtf(s * (1.f / DM) + EPS);
    v2u* o8 = (v2u*)orow + lane;
#pragma unroll
    for (int j = 0; j < 8; ++j) { v2u w; w.x = pk2(v[j].x, v[j].y); w.y = pk2(v[j].z, v[j].w); o8[64 * j] = w; }
}
__device__ __forceinline__ void p0_x_row(const float* xrow, bf16* orow, float* rs, int lane);
__device__ __forceinline__ void p0_s5_group(Frame& F, int g, int part, bool xrows) {
    const float* are = inp(F, I_ARE) + g * 64; const float* aim = inp(F, I_AIM) + g * 64;
    const float* bre = inp(F, I_BRE) + g * 1024; const float* bim = inp(F, I_BIM) + g * 1024;
    const float* cre = inp(F, I_CRE) + g * 1024; const float* cim = inp(F, I_CIM) + g * 1024;
    const float* dd = inp(F, I_D) + g * 16;
    LAS float* Ere = (LAS float*)F.lds;
    LAS float* Eim = Ere + 17 * 64;
    LAS float* Bre = Eim + 17 * 64;
    LAS float* Bim = Bre + 1024;
    LAS float* Cre = Bim + 1024;
    LAS float* Cim = Cre + 1024;
    LAS float* Kt = Cim + 1024;
    const int tid = F.tid;
    const double dt = exp((double)inp(F, I_LOGSTEP)[g]);
    if (tid < 64) {
        const int p = tid; const double lr = (double)are[p], li = (double)aim[p];
        double s1, c1; sincos_d(li * dt, s1, c1); const double mg = exp(lr * dt); const double e1r = mg * c1, e1i = mg * s1;
        double er = 1.0, ei = 0.0;
        for (int k = 0; k <= 16; ++k) { Ere[k * 64 + p] = (float)er; Eim[k * 64 + p] = (float)ei; const double nr = er * e1r - ei * e1i, ni = er * e1i + ei * e1r; er = nr; ei = ni; }
        const double nr_ = e1r - 1.0, ni_ = e1i, den = lr * lr + li * li; const double fr_ = (nr_ * lr + ni_ * li) / den, fi_ = (ni_ * lr - nr_ * li) / den;
        if (part == 0) { float* e1 = (float*)(F.ws + SM_E1) + (g * 64 + p) * 2; e1[0] = (float)e1r; e1[1] = (float)e1i;
        float* e16 = (float*)(F.ws + SM_E16) + (g * 64 + p) * 2; e16[0] = Ere[16 * 64 + p]; e16[1] = Eim[16 * 64 + p]; }
        float* bb = (float*)(F.ws + SM_BBAR) + (size_t)(g * 64 + p) * 32;
        for (int c = 0; c < 16; ++c) { const double br = (double)bre[p * 16 + c], bi = (double)bim[p * 16 + c]; const float xr = (float)(fr_ * br - fi_ * bi), xi = (float)(fr_ * bi + fi_ * br);
            Bre[p * 16 + c] = xr; Bim[p * 16 + c] = xi; if (part == 0) { bb[2 * c] = xr; bb[2 * c + 1] = xi; } }
    }
    for (int i = tid; i < 1024; i += NTHR) { Cre[i] = cre[i]; Cim[i] = cim[i]; }
    if (xrows && F.wave > 0) {
        bf16* XB = (bf16*)(F.ws + WS_XB); float* rs0 = (float*)(F.ws + SM_RS0);
        for (int m = F.bid * 7 + (F.wave - 1); m < MT; m += F.G * 7) { const float* xr = (m < MP) ? inp(F, I_XP) + (size_t)m * DM : inp(F, I_XS) + (size_t)(m - MP) * DM; p0_x_row(xr, XB + (size_t)m * DM, rs0 + m, F.lane); }
    }
    __syncthreads();
    for (int e = tid; e < 1024; e += NTHR) { const int d = e >> 6, co = 4 * part + ((e >> 4) & 3), ci = e & 15; float acc = 0.f;
        for (int p = 0; p < 64; ++p) { const float cr = Cre[co * 64 + p], ci_ = Cim[co * 64 + p], er = Ere[d * 64 + p], ei = Eim[d * 64 + p], br = Bre[p * 16 + ci], bi = Bim[p * 16 + ci];
            const float wr_ = cr * er - ci_ * ei, wi_ = cr * ei + ci_ * er; acc += wr_ * br - wi_ * bi; }
        if (d == 0 && co == ci) acc += dd[co];
        Kt[e] = acc; }
    __syncthreads();
    const int z = g >> 1, gl = g & 1;
    bf16* KG = (bf16*)(F.ws + WS_KG) + (size_t)z * 512 * 768;
    for (int it = tid; it < 64 * 96; it += NTHR) { const int rr = it / 96, kc = it % 96; const int j = rr >> 2, col = rr & 3, co = 4 * part + col, n = j * 32 + gl * 16 + co, k0 = kc * 8; float v[8];
#pragma unroll
        for (int e = 0; e < 8; ++e) { const int k = k0 + e; float x = 0.f;
            if (k < 512) { const int i = k >> 5, glk = (k >> 4) & 1, ci = k & 15; if (glk == gl && j >= i) x = Kt[((j - i) * 4 + col) * 16 + ci]; }
            else { const int kk = k - 512, glk = kk >> 7, q = kk & 127, p = q & 63; if (glk == gl) { const float cr = Cre[co * 64 + p], ci_ = Cim[co * 64 + p], er = Ere[(j + 1) * 64 + p], ei = Eim[(j + 1) * 64 + p];
                    x = (q < 64) ? (cr * er - ci_ * ei) : -(cr * ei + ci_ * er); } }
            v[e] = x; }
        v4u o; o.x = pk2(v[0], v[1]); o.y = pk2(v[2], v[3]); o.z = pk2(v[4], v[5]); o.w = pk2(v[6], v[7]);
        *(v4u*)(KG + (size_t)n * 768 + k0) = o; }
    bf16* M1 = (bf16*)(F.ws + WS_M1) + (size_t)z * 256 * 512;
    for (int it = tid; it < 32 * 64; it += NTHR) { const int q = 32 * part + (it >> 6), kc = it & 63, n = gl * 128 + q, p = q & 63, k0 = kc * 8; float v[8];
#pragma unroll
        for (int e = 0; e < 8; ++e) { const int k = k0 + e, i = k >> 5, glk = (k >> 4) & 1, ch = k & 15; float x = 0.f;
            if (glk == gl) { const float er = Ere[(15 - i) * 64 + p], ei = Eim[(15 - i) * 64 + p], br = Bre[p * 16 + ch], bi = Bim[p * 16 + ch]; x = (q < 64) ? (er * br - ei * bi) : (er * bi + ei * br); }
            v[e] = x; }
        v4u o; o.x = pk2(v[0], v[1]); o.y = pk2(v[2], v[3]); o.z = pk2(v[4], v[5]); o.w = pk2(v[6], v[7]);
        *(v4u*)(M1 + (size_t)n * 512 + k0) = o; }
    __syncthreads();
}

#ifndef P0_MASK
#define P0_MASK 7
#endif
__device__ __forceinline__ void p0_prologue(Frame& F, int mask) {
    bf16* WinT = (bf16*)(F.ws + WS_WIN);
    const bool xfused = (F.G == 256) && ((mask & 5) == 5);
    if (mask & 1) for (int it = F.bid; it < 256; it += F.G) p0_s5_group(F, it >> 2, it & 3, xfused);
    constexpr int I_1 = (DM / 64) * (NZ / 256);
    if (mask & 2) for (int it = F.bid; it < I_1; it += F.G) tr_item(inp(F, I_WIN), inp(F, I_NMIX), DM, NZ, WinT, it, F.wave, F.lane);
    const int gw = F.bid * NWAVES + F.wave, NGW = F.G * NWAVES;
    bf16* XB = (bf16*)(F.ws + WS_XB); float* rs0 = (float*)(F.ws + SM_RS0);
    if ((mask & 4) && !xfused) for (int m = gw; m < MT; m += NGW) { const float* xr = (m < MP) ? inp(F, I_XP) + (size_t)m * DM : inp(F, I_XS) + (size_t)(m - MP) * DM; p0_x_row(xr, XB + (size_t)m * DM, rs0 + m, F.lane); }
    bf16* WGA = (bf16*)(F.ws + SM_WGA); bf16* WGX = (bf16*)(F.ws + SM_WGX);
    for (int e = F.bid * NTHR + F.tid; e < DLRU; e += F.G * NTHR) ((float*)(F.ws + SM_SP))[e] = log1pf(__expf(-inp(F, I_LAMBDA)[e]));
    for (int e = F.bid * NTHR + F.tid; e < 65536; e += F.G * NTHR) { const int h = e >> 12, j = (e >> 6) & 63, i = e & 63; WGA[e] = (bf16)f2bf(inp(F, I_WGA)[(h * 64 + i) * 64 + j]); WGX[e] = (bf16)f2bf(inp(F, I_WGX)[(h * 64 + i) * 64 + j]); }
}

__device__ __forceinline__ void s5_sample_item(Frame& F, int item) {
    const int g = item >> 5, sq0 = (item & 31) * 4, lane = F.lane, p = lane;
    LAS float* hs = (LAS float*)(F.lds + F.wave * 2048);
    const float* e1 = (const float*)(F.ws + SM_E1) + (g * 64 + p) * 2; const float ar = e1[0], ai = e1[1];
    const float* bb = (const float*)(F.ws + SM_BBAR) + (size_t)(g * 64 + p) * 32;
    float br[16], bi[16];
#pragma unroll
    for (int c = 0; c < 16; ++c) { br[c] = bb[2 * c]; bi[c] = bb[2 * c + 1]; }
    const int cc = lane & 15, part = lane >> 4;
    float cr[16], ci[16];
#pragma unroll
    for (int j = 0; j < 16; ++j) { cr[j] = inp(F, I_CRE)[(g * 16 + cc) * 64 + part * 16 + j]; ci[j] = inp(F, I_CIM)[(g * 16 + cc) * 64 + part * 16 + j]; }
    const float dv = inp(F, I_D)[g * 16 + cc];
    const bf16* us = (const bf16*)(F.ws + WS_US); bf16* gbuf = (bf16*)((unsigned char*)F.out + DO_G);
    float bur[16], bui[16], ucc[16];
#pragma unroll
    for (int t = 0; t < 16; ++t) { const int tok = sq0 * 4 + t;
        const v4u u0 = *(const v4u*)(us + (size_t)tok * DS5 + g * 16), u1 = *(const v4u*)(us + (size_t)tok * DS5 + g * 16 + 8);
        float uf[16]; uf[0] = bflo(u0.x); uf[1] = bfhi(u0.x); uf[2] = bflo(u0.y); uf[3] = bfhi(u0.y); uf[4] = bflo(u0.z); uf[5] = bfhi(u0.z); uf[6] = bflo(u0.w); uf[7] = bfhi(u0.w);
        uf[8] = bflo(u1.x); uf[9] = bfhi(u1.x); uf[10] = bflo(u1.y); uf[11] = bfhi(u1.y); uf[12] = bflo(u1.z); uf[13] = bfhi(u1.z); uf[14] = bflo(u1.w); uf[15] = bfhi(u1.w);
        float a = 0.f, b = 0.f;
#pragma unroll
        for (int c = 0; c < 16; ++c) { a += br[c] * uf[c]; b += bi[c] * uf[c]; }
        bur[t] = a; bui[t] = b; ucc[t] = bf2f(us[(size_t)tok * DS5 + g * 16 + cc]); }
    float hr[4], hi[4];
#pragma unroll
    for (int q = 0; q < 4; ++q) { hr[q] = inp(F, I_SRE)[((sq0 + q) * 64 + g) * 64 + p]; hi[q] = inp(F, I_SIM)[((sq0 + q) * 64 + g) * 64 + p]; }
#pragma unroll
    for (int s = 0; s < 4; ++s) {
#pragma unroll
        for (int q = 0; q < 4; ++q) { const int t = q * 4 + s; const float nr = ar * hr[q] - ai * hi[q] + bur[t], ni = ar * hi[q] + ai * hr[q] + bui[t]; hr[q] = nr; hi[q] = ni;
            hs[q * 128 + p] = nr; hs[q * 128 + 64 + p] = ni; }
        LDS_WAIT();
#pragma unroll
        for (int q = 0; q < 4; ++q) { float y = 0.f;
#pragma unroll
            for (int j = 0; j < 16; ++j) y += cr[j] * hs[q * 128 + part * 16 + j] - ci[j] * hs[q * 128 + 64 + part * 16 + j];
            y += __shfl_xor(y, 16); y += __shfl_xor(y, 32);
            y += dv * ucc[q * 4 + s];
            if (lane < 16) gbuf[(size_t)(MP + sq0 * 4 + q * 4 + s) * DS5 + g * 16 + cc] = (bf16)f2bf(gelu_tanh(y)); }
        LDS_WAIT();
    }
#pragma unroll
    for (int q = 0; q < 4; ++q) { F.out[O_RES + (size_t)((sq0 + q) * 64 + g) * 64 + p] = hr[q]; F.out[O_IMS + (size_t)((sq0 + q) * 64 + g) * 64 + p] = hi[q]; }
}

constexpr int LW_XS = 0, LW_XC = 4864, LW_XF = 7168, LW_AB = 11264, LW_BYTES = 16384;
struct LruPre { f32x4 xs[5]; float hin; };
__device__ __forceinline__ void lruw_load(Frame& F, int hd, int idx, int pass, LruPre& R) {
    const int lane = F.lane; const bool sample = idx >= 512;
    const int gc = idx, b = gc >> 7, c = gc & 127, tok0 = sample ? MP + 16 * (idx - 512) : 16 * gc, cgl = hd * 64 + lane;
    const float* xlru = (const float*)((unsigned char*)F.out + DO_XLRU);
#pragma unroll
    for (int k = 0; k < 5; ++k) { const int i = lane + 64 * k, r = i >> 4, q = i & 15, t = c * 16 - 3 + r; f32x4 v = {0.f, 0.f, 0.f, 0.f};
        if (!sample && i < 19 * 16 && t >= 0) v = *(const f32x4*)(xlru + (size_t)(b * SEQ + t) * DLRU + hd * 64 + 4 * q);
        R.xs[k] = v; }
    R.hin = 0.f;
    if (pass == 2) {
        if (!sample) R.hin = ((const float*)(F.ws + WS_HIN))[(size_t)gc * DLRU + cgl];
    }
}
#ifndef LRU_MODE
#define LRU_MODE 0
#endif
__device__ __forceinline__ void lruw_tile(Frame& F, int hd, int idx, int pass, float* ssqa_p, const LruPre& R, int mode = 0) {
    const int lane = F.lane;
    const bool sample = idx >= 512;
    const int gc = idx, b = gc >> 7, c = gc & 127, sb = idx - 512;
    const int tok0 = sample ? MP + 16 * sb : 16 * gc, cgl = hd * 64 + lane;
    const float* xlru = (const float*)((unsigned char*)F.out + DO_XLRU);
    bf16* mix = (bf16*)(F.ws + WS_MIX);
    LAS unsigned char* wl = F.lds + F.wave * LW_BYTES;
    LAS float* XS = (LAS float*)(wl + LW_XS); LAS bf16* XC = (LAS bf16*)(wl + LW_XC); LAS float* XF = (LAS float*)(wl + LW_XF); LAS float* AB = (LAS float*)(wl + LW_AB);
    const float* cw = inp(F, I_CONVW); const float* cb = inp(F, I_CONVB);
    const int fr = lane & 15, fq = lane >> 4;
    const bf16* WGA = (const bf16*)(F.ws + SM_WGA) + hd * 4096; const bf16* WGX = (const bf16*)(F.ws + SM_WGX) + hd * 4096;
    float vbga[4], vbgx[4], vsp[4];
#pragma unroll
    for (int nt = 0; nt < 4; ++nt) { const int ch = nt * 16 + fr; vbga[nt] = inp(F, I_BGA)[hd * 64 + ch]; vbgx[nt] = inp(F, I_BGX)[hd * 64 + ch]; vsp[nt] = ((const float*)(F.ws + SM_SP))[hd * 64 + ch]; }
    const int qc = lane & 15;
    f32x4 cwv[4], cbv = *(const f32x4*)(cb + hd * 64 + 4 * qc);
#pragma unroll
    for (int kk = 0; kk < 4; ++kk) cwv[kk] = *(const f32x4*)(cw + kk * DLRU + hd * 64 + 4 * qc);
    float h = R.hin, h0v[4], gvv[16];
#pragma unroll
    for (int q = 0; q < 4; ++q) h0v[q] = (pass == 2 && sample) ? inp(F, I_SLRU)[(size_t)(sb * 4 + q) * DLRU + cgl] : 0.f;
    if (pass == 2) { const bf16* glru = (const bf16*)((unsigned char*)F.out + DO_GLRU);
#pragma unroll
        for (int s = 0; s < 16; ++s) gvv[s] = bf2f(glru[(size_t)(tok0 + s) * DLRU + cgl]); }
    if (!sample) {
#pragma unroll
        for (int k = 0; k < 5; ++k) { const int i = lane + 64 * k; if (i < 19 * 16) { const int r = i >> 4, q = i & 15; *(LAS f32x4*)(XS + r * 64 + 4 * q) = R.xs[k]; } }
        LDS_WAIT();
#pragma unroll
        for (int k = 0; k < 4; ++k) { const int i = lane + 64 * k, t = i >> 4, q = i & 15;
            f32x4 a = cbv;
#pragma unroll
            for (int kk = 0; kk < 4; ++kk) a += cwv[kk] * *(LAS f32x4*)(XS + (t + kk) * 64 + 4 * q);
            *(LAS f32x4*)(XF + t * 64 + 4 * q) = a; v2u pk; pk.x = pk2(a.x, a.y); pk.y = pk2(a.z, a.w); *(LAS v2u*)(XC + t * 72 + 4 * q) = pk; }
    } else {
        const float* sconv = inp(F, I_SCONV);
#pragma unroll
        for (int k = 0; k < 4; ++k) { const int i = lane + 64 * k, t = i >> 4, q = i & 15, ch = hd * 64 + 4 * q, sq = sb * 4 + (t >> 2), s = t & 3;
            f32x4 a = cbv;
#pragma unroll
            for (int kk = 0; kk < 4; ++kk) { const int j = s + kk; const f32x4 xv = (j < 3) ? *(const f32x4*)(sconv + (size_t)(sq * 3 + j) * DLRU + ch) : *(const f32x4*)(xlru + (size_t)(MP + sq * 4 + j - 3) * DLRU + ch);
                a += cwv[kk] * xv; }
            *(LAS f32x4*)(XF + t * 64 + 4 * q) = a; v2u pk; pk.x = pk2(a.x, a.y); pk.y = pk2(a.z, a.w); *(LAS v2u*)(XC + t * 72 + 4 * q) = pk; }
    }
    bf16x8 wba0[4], wba1[4], wbx0[4], wbx1[4];
#pragma unroll
    for (int nt = 0; nt < 4; ++nt) { const int ch = nt * 16 + fr;
        wba0[nt] = *(const bf16x8*)(WGA + ch * 64 + fq * 8); wba1[nt] = *(const bf16x8*)(WGA + ch * 64 + 32 + fq * 8);
        wbx0[nt] = *(const bf16x8*)(WGX + ch * 64 + fq * 8); wbx1[nt] = *(const bf16x8*)(WGX + ch * 64 + 32 + fq * 8); }
    LDS_WAIT();
    {
        const bf16x8 a0 = *(LAS bf16x8*)(XC + fr * 72 + fq * 8), a1 = *(LAS bf16x8*)(XC + fr * 72 + 32 + fq * 8);
#pragma unroll
        for (int nt = 0; nt < 4; ++nt) {
            const int ch = nt * 16 + fr;
            f32x4 ga = {0.f, 0.f, 0.f, 0.f}, gx = {0.f, 0.f, 0.f, 0.f};
            ga = __builtin_amdgcn_mfma_f32_16x16x32_bf16(a0, wba0[nt], ga, 0, 0, 0); ga = __builtin_amdgcn_mfma_f32_16x16x32_bf16(a1, wba1[nt], ga, 0, 0, 0);
            gx = __builtin_amdgcn_mfma_f32_16x16x32_bf16(a0, wbx0[nt], gx, 0, 0, 0); gx = __builtin_amdgcn_mfma_f32_16x16x32_bf16(a1, wbx1[nt], gx, 0, 0, 0);
            const float bga = vbga[nt], bgx = vbgx[nt], sp = vsp[nt];
#pragma unroll
            for (int r = 0; r < 4; ++r) { const int t = fq * 4 + r; const float xc = XF[t * 64 + ch];
                const float rg = sigmoidf_(ga[r] + bga), ig = sigmoidf_(gx[r] + bgx), la = -8.f * rg * sp, av = __expf(la), x2 = 2.f * la;
                const float m1 = -x2 * (1.f + x2 * (0.5f + x2 * (0.16666667f + x2 * (0.041666668f + x2 * (0.0083333338f + x2 * 0.0013888889f)))));
                const float mult = __builtin_amdgcn_sqrtf((x2 > -0.25f) ? m1 : 1.f - __expf(x2));
                (void)av; XS[t * 64 + ch] = la; XF[t * 64 + ch] = mult * ig * xc; }
        }
    }
    LDS_WAIT();
    {
        bf16* LA = (bf16*)(F.ws + WS_XB); bf16* LB = LA + (size_t)MT * DLRU;
        float Ap = 1.f; unsigned lw[8], bw[8];
#pragma unroll
        for (int s = 0; s < 16; ++s) { const unsigned lab = f2bf(XS[s * 64 + lane]), bb = f2bf(XF[s * 64 + lane]);
            if (s & 1) { lw[s >> 1] |= lab << 16; bw[s >> 1] |= bb << 16; } else { lw[s >> 1] = lab; bw[s >> 1] = bb; }
            const float av = __expf(bf2f(lab)); h = av * h + bf2f(bb); Ap *= av; }
        { const size_t o = ((size_t)(idx * 16 + hd) * 64 + lane) * 16;
          *(v4u*)(LA + o) = (v4u){lw[0], lw[1], lw[2], lw[3]}; *(v4u*)(LA + o + 8) = (v4u){lw[4], lw[5], lw[6], lw[7]};
          *(v4u*)(LB + o) = (v4u){bw[0], bw[1], bw[2], bw[3]}; *(v4u*)(LB + o + 8) = (v4u){bw[4], bw[5], bw[6], bw[7]}; }
        if (!sample) { float* o = (float*)(F.ws + WS_AGG) + ((size_t)gc * DLRU + cgl) * 2; *(v2u*)o = (v2u){__builtin_bit_cast(unsigned, Ap), __builtin_bit_cast(unsigned, h)}; }
        LDS_WAIT();
    }
}
struct Lru2Pre { v4u la0, la1, lb0, lb1; float g[16]; float hin; };
__device__ __forceinline__ void lruw2_load(Frame& F, int hd, int idx, Lru2Pre& R) {
    const int lane = F.lane; const bool sample = idx >= 512;
    const int tok0 = sample ? MP + 16 * (idx - 512) : 16 * idx, cgl = hd * 64 + lane;
    const bf16* glru = (const bf16*)((unsigned char*)F.out + DO_GLRU);
    const bf16* LA = (const bf16*)(F.ws + WS_XB); const bf16* LB = LA + (size_t)MT * DLRU;
    const size_t o = ((size_t)(idx * 16 + hd) * 64 + lane) * 16;
    R.la0 = *(const v4u*)(LA + o); R.la1 = *(const v4u*)(LA + o + 8); R.lb0 = *(const v4u*)(LB + o); R.lb1 = *(const v4u*)(LB + o + 8);
#pragma unroll
    for (int s = 0; s < 16; ++s) R.g[s] = bf2f(glru[(size_t)(tok0 + s) * DLRU + cgl]);
    R.hin = sample ? 0.f : ((const float*)(F.ws + WS_HIN))[(size_t)idx * DLRU + cgl];
}
__device__ __forceinline__ void lruw2_tile(Frame& F, int hd, int idx, float* ssqa_p, const Lru2Pre& R) {
    const int lane = F.lane;
    const bool sample = idx >= 512;
    const int gc = idx, b = gc >> 7, c = gc & 127, sb = idx - 512;
    const int tok0 = sample ? MP + 16 * sb : 16 * gc, cgl = hd * 64 + lane;
    const float* xlru = (const float*)((unsigned char*)F.out + DO_XLRU);
    bf16* mix = (bf16*)(F.ws + WS_MIX);
    float lav[16], bvv[16], h0v[4];
    { const unsigned lw[8] = {R.la0.x, R.la0.y, R.la0.z, R.la0.w, R.la1.x, R.la1.y, R.la1.z, R.la1.w}, bw[8] = {R.lb0.x, R.lb0.y, R.lb0.z, R.lb0.w, R.lb1.x, R.lb1.y, R.lb1.z, R.lb1.w};
#pragma unroll
      for (int k = 0; k < 8; ++k) { lav[2 * k] = bflo(lw[k]); lav[2 * k + 1] = bfhi(lw[k]); bvv[2 * k] = bflo(bw[k]); bvv[2 * k + 1] = bfhi(bw[k]); } }
    float h = R.hin;
#pragma unroll
    for (int q = 0; q < 4; ++q) h0v[q] = sample ? inp(F, I_SLRU)[(size_t)(sb * 4 + q) * DLRU + cgl] : 0.f;
    float sq[16];
#pragma unroll
    for (int s = 0; s < 16; ++s) {
        if (sample && (s & 3) == 0) h = h0v[s >> 2];
        h = __expf(lav[s]) * h + bvv[s];
        const float o = h * gelu_tanh(R.g[s]);
        mix[(size_t)(tok0 + s) * DM + cgl] = (bf16)f2bf(o); sq[s] = o * o;
        if (sample && (s & 3) == 3) F.out[O_LRUS + (size_t)(sb * 4 + (s >> 2)) * DLRU + cgl] = h;
    }
    if (!sample && c == 127) { F.out[O_LRUP + (size_t)b * DLRU + cgl] = h;
#pragma unroll
        for (int j = 0; j < 3; ++j) F.out[O_CONVP + (size_t)(b * 3 + j) * DLRU + cgl] = xlru[(size_t)(b * SEQ + 2045 + j) * DLRU + cgl]; }
    if (sample) {
#pragma unroll
        for (int e = 0; e < 12; ++e) { const int sqn = sb * 4 + e / 3, j = e % 3; F.out[O_CONVS + (size_t)(sqn * 3 + j) * DLRU + cgl] = xlru[(size_t)(MP + sqn * 4 + 1 + j) * DLRU + cgl]; }
    }
    const bool b5 = lane & 32, b4 = lane & 16, b3 = lane & 8, b2 = lane & 4;
    float r8[8], r4[4], r2[2], r1;
#pragma unroll
    for (int k = 0; k < 8; ++k) { const float mine = b5 ? sq[8 + k] : sq[k], send = b5 ? sq[k] : sq[8 + k]; r8[k] = mine + __shfl_xor(send, 32); }
#pragma unroll
    for (int k = 0; k < 4; ++k) { const float mine = b4 ? r8[4 + k] : r8[k], send = b4 ? r8[k] : r8[4 + k]; r4[k] = mine + __shfl_xor(send, 16); }
#pragma unroll
    for (int k = 0; k < 2; ++k) { const float mine = b3 ? r4[2 + k] : r4[k], send = b3 ? r4[k] : r4[2 + k]; r2[k] = mine + __shfl_xor(send, 8); }
    { const float mine = b2 ? r2[1] : r2[0], send = b2 ? r2[0] : r2[1]; r1 = mine + __shfl_xor(send, 4); }
    r1 += __shfl_xor(r1, 1); r1 += __shfl_xor(r1, 2);
    if ((lane & 3) == 0) atomicAdd(ssqa_p + tok0 + ((lane >> 5) & 1) * 8 + ((lane >> 4) & 1) * 4 + ((lane >> 3) & 1) * 2 + ((lane >> 2) & 1), r1);
}
__device__ __forceinline__ void lruw_tiles(Frame& F, int pass, int nper, unsigned* counters, float* ssqa_p, int mode = 0) {
    const int hd = F.bid & 15; unsigned* cp = counters + 16 * hd;
    unsigned v0 = 0u, v1 = 0u; if (F.lane == 0) { v0 = atomicAdd(cp, 1u); v1 = atomicAdd(cp, 1u); }
    int t = (int)__builtin_amdgcn_readfirstlane(v0), nx = (int)__builtin_amdgcn_readfirstlane(v1);
    if (pass == 2) {
        Lru2Pre Q; if (t < nper) lruw2_load(F, hd, t, Q);
        while (t < nper) {
            unsigned v2 = 0u; if (F.lane == 0) v2 = atomicAdd(cp, 1u);
            Lru2Pre Qn; if (nx < nper) lruw2_load(F, hd, nx, Qn);
            lruw2_tile(F, hd, t, ssqa_p, Q);
            t = nx; Q = Qn; nx = (int)__builtin_amdgcn_readfirstlane(v2);
        }
        return;
    }
    LruPre R; if (t < nper) lruw_load(F, hd, t, pass, R);
    while (t < nper) {
        unsigned v2 = 0u; if (F.lane == 0) v2 = atomicAdd(cp, 1u);
        LruPre Rn; if (nx < nper) lruw_load(F, hd, nx, pass, Rn);
        lruw_tile(F, hd, t, pass, ssqa_p, R, mode);
        t = nx; R = Rn; nx = (int)__builtin_amdgcn_readfirstlane(v2);
    }
}

constexpr int NPHASE = 10;
#ifndef LRU_N4
#define LRU_N4 256
#endif
#ifndef DUP_PHASE
#define DUP_PHASE (-1)
#endif

__global__ void __launch_bounds__(NTHR, 2) fwd_megakernel(Args args) {
    extern __shared__ __attribute__((aligned(16))) unsigned char lds_raw[];
    cg::grid_group grid = cg::this_grid();
    Frame F; F.lds = (LAS unsigned char*)lds_raw; F.tid = threadIdx.x; F.lane = F.tid & 63; F.wave = __builtin_amdgcn_readfirstlane(F.tid >> 6); F.G = gridDim.x; F.bid = blockIdx.x;
    F.out = args.out; F.ws = args.ws;
    if (F.tid == 0) {
#pragma unroll
        for (int i = 0; i < 32; ++i) { const unsigned long long pv = (unsigned long long)args.in[i]; ((LAS unsigned*)(F.lds + PTR_OFF))[2 * i] = (unsigned)pv; ((LAS unsigned*)(F.lds + PTR_OFF))[2 * i + 1] = (unsigned)(pv >> 32); }
    }
    const int lo = args.ph_lo, hi = args.ph_hi;
    volatile LAS unsigned* MISC = (volatile LAS unsigned*)(F.lds + MISC_OFF);
    if (F.tid < 32) MISC[F.tid] = 0u;
    __syncthreads();
    if (lo > hi) grid.sync();
    XcdBarrier xbar = xcd_barrier_post((unsigned*)(args.ws + WS_CTL + CTL_BAR), MISC + 8);
#define IN(k) (lo <= (k) && (k) < hi)
#define SEAM(k) do { if (IN(k) && IN((k) + 1)) { xcd_barrier(xbar); } } while (0)
    unsigned char* ws = args.ws;
    bf16* WinT = (bf16*)(ws + WS_WIN); bf16* WgluT = (bf16*)(ws + WS_WGLU); bf16* WoutT = (bf16*)(ws + WS_WOUT); bf16* WupT = (bf16*)(ws + WS_WUP); bf16* WdownT = (bf16*)(ws + WS_WDOWN);
    bf16* XB = (bf16*)(ws + WS_XB); bf16* HB = (bf16*)(ws + WS_H); bf16* A2 = (bf16*)(ws + WS_A2); bf16* US = (bf16*)(ws + WS_US); bf16* MIX = (bf16*)(ws + WS_MIX);
    bf16* M1 = (bf16*)(ws + WS_M1); bf16* KG = (bf16*)(ws + WS_KG); float* SB = (float*)(ws + WS_S);
    float* ssqa = (float*)(ws + WS_CTL + CTL_SSQA); float* ssqb = (float*)(ws + WS_CTL + CTL_SSQB); float* ssq1 = (float*)(ws + WS_CTL + CTL_SSQ1); float* ssq2 = (float*)(ws + WS_CTL + CTL_SSQ2);
    unsigned* cnt = (unsigned*)(ws + WS_CTL + CTL_CNT); float* ssqd = (float*)(ws + WS_CTL + 320 * 1024);
    float* xlru = (float*)((unsigned char*)args.out + DO_XLRU); bf16* glru = (bf16*)((unsigned char*)args.out + DO_GLRU); bf16* gbuf = (bf16*)((unsigned char*)args.out + DO_G);

    if (IN(0)) {
        if (DUP_PHASE == 0) { constexpr bool dup = true; (void)dup; { p0_prologue(F, P0_MASK); } xcd_barrier(xbar); }
        { constexpr bool dup = false; (void)dup; { p0_prologue(F, 7); } }
    }
    SEAM(0);
    if (IN(1)) {
        if (DUP_PHASE == 1) { constexpr bool dup = true; (void)dup; { {
        pg8::Gemm g{XB, WinT, DM, DM, DM, 0, 0}; pg8::Order S; S.init(MT, NZ, 1, F.G, F.bid);
        pg8::EpiZ E{(const float*)(ws + SM_RS0), xlru, glru, A2, US};
        pg8::gemm_phase<pg8::EpiZ, pg8::Order, true, true>(F.lds, g, S, E);
        __syncthreads();
        if constexpr (!dup) { tr_items_dyn(F, inp(F, I_WGLU), nullptr, DS5, DS5, WgluT, cnt + 10);
          tr_items_dyn(F, inp(F, I_WUP), inp(F, I_NMLP), DM, DFF, WupT, cnt + 8); }
    } } xcd_barrier(xbar); }
        { constexpr bool dup = false; (void)dup; { {
        pg8::Gemm g{XB, WinT, DM, DM, DM, 0, 0}; pg8::Order S; S.init(MT, NZ, 1, F.G, F.bid);
        pg8::EpiZ E{(const float*)(ws + SM_RS0), xlru, glru, A2, US};
        pg8::gemm_phase<pg8::EpiZ, pg8::Order, true, true>(F.lds, g, S, E);
        __syncthreads();
        if constexpr (!dup) { tr_items_dyn(F, inp(F, I_WGLU), nullptr, DS5, DS5, WgluT, cnt + 10);
          tr_items_dyn(F, inp(F, I_WUP), inp(F, I_NMLP), DM, DFF, WupT, cnt + 8); }
    } } }
    }
    SEAM(1);
    if (IN(2)) {
        if (DUP_PHASE == 2) { constexpr bool dup = true; (void)dup; { {
        { pg8::Gemm g{A2, M1, A2_LD, 512, 512, (size_t)A2_ROWS * A2_LD, (size_t)256 * 512}; pg8::Order S; S.init(A2_ROWS, 256, NPAIR, F.G, F.bid);
          pg8::EpiS E{SB};
          pg8::gemm_phase<pg8::EpiS, pg8::Order, true, true>(F.lds, g, S, E); }
#ifdef SMP_REP
        if constexpr (!dup) { xcd_barrier(xbar); for (int it = F.bid * NWAVES + F.wave; it < 2048; it += F.G * NWAVES) s5_sample_item(F, it); xcd_barrier(xbar); }
#endif
        __syncthreads();
        lruw_tiles(F, 1, 544, cnt + (dup ? 1024 : 512), ssqa); __syncthreads();
    } } xcd_barrier(xbar); }
        { constexpr bool dup = false; (void)dup; { {
        { pg8::Gemm g{A2, M1, A2_LD, 512, 512, (size_t)A2_ROWS * A2_LD, (size_t)256 * 512}; pg8::Order S; S.init(A2_ROWS, 256, NPAIR, F.G, F.bid);
          pg8::EpiS E{SB};
          pg8::gemm_phase<pg8::EpiS, pg8::Order, true, true>(F.lds, g, S, E); }
#ifdef SMP_REP
        if constexpr (!dup) { xcd_barrier(xbar); for (int it = F.bid * NWAVES + F.wave; it < 2048; it += F.G * NWAVES) s5_sample_item(F, it); xcd_barrier(xbar); }
#endif
        __syncthreads();
        lruw_tiles(F, 1, 544, cnt + (dup ? 1024 : 512), ssqa); __syncthreads();
    } } }
    }
    SEAM(2);
    if (IN(3)) {
        if (DUP_PHASE == 3) { constexpr bool dup = true; (void)dup; { {
        for (int e = F.bid * 64 + F.tid; F.tid < 64 && e < NPAIR * NB * 128; e += F.G * 64) {
            const int z = e >> 9, b = (e >> 7) & 3, q = e & 127, gl = q >> 6, p = q & 63, g = z * 2 + gl;
            const float* e16 = (const float*)(ws + SM_E16) + (g * 64 + p) * 2; const float ar = e16[0], ai = e16[1];
            float hr = 0.f, hi = 0.f;
            const float* __restrict__ Sp = SB + ((size_t)z * A2_ROWS + b * NCH) * 256 + gl * 128 + p;
            bf16* __restrict__ Hp = A2 + ((size_t)z * A2_ROWS + b * NCH) * A2_LD + 512 + gl * 128 + p;
            for (int c0 = 0; c0 < NCH; c0 += 32) {
                float sr[32], si[32];
#pragma unroll
                for (int j = 0; j < 32; ++j) { sr[j] = Sp[(size_t)(c0 + j) * 256]; si[j] = Sp[(size_t)(c0 + j) * 256 + 64]; }
#pragma unroll
                for (int j = 0; j < 32; ++j) { Hp[(size_t)(c0 + j) * A2_LD] = (bf16)f2bf(hr); Hp[(size_t)(c0 + j) * A2_LD + 64] = (bf16)f2bf(hi);
                    const float nr = ar * hr - ai * hi + sr[j], ni = ar * hi + ai * hr + si[j]; hr = nr; hi = ni; }
            }
            args.out[O_REP + (size_t)(b * 64 + g) * 64 + p] = hr; args.out[O_IMP + (size_t)(b * 64 + g) * 64 + p] = hi;
        }
        for (int e = F.bid * 64 + (F.tid - 64); F.tid >= 64 && F.tid < 128 && e < NB * DLRU; e += F.G * 64) {
            const int b = e >> 10, chn = e & 1023;
            const float* __restrict__ ag = (const float*)(ws + WS_AGG) + ((size_t)(b * 128) * DLRU + chn) * 2; float* __restrict__ hn = (float*)(ws + WS_HIN) + (size_t)(b * 128) * DLRU + chn;
            float h = 0.f;
            for (int c0 = 0; c0 < 128; c0 += 32) {
                float aa[32], hh[32];
#pragma unroll
                for (int j = 0; j < 32; ++j) { aa[j] = ag[(size_t)(c0 + j) * DLRU * 2]; hh[j] = ag[(size_t)(c0 + j) * DLRU * 2 + 1]; }
#pragma unroll
                for (int j = 0; j < 32; ++j) { hn[(size_t)(c0 + j) * DLRU] = h; h = aa[j] * h + hh[j]; }
            }
        }
    } } xcd_barrier(xbar); }
        { constexpr bool dup = false; (void)dup; { {
        for (int e = F.bid * 64 + F.tid; F.tid < 64 && e < NPAIR * NB * 128; e += F.G * 64) {
            const int z = e >> 9, b = (e >> 7) & 3, q = e & 127, gl = q >> 6, p = q & 63, g = z * 2 + gl;
            const float* e16 = (const float*)(ws + SM_E16) + (g * 64 + p) * 2; const float ar = e16[0], ai = e16[1];
            float hr = 0.f, hi = 0.f;
            const float* __restrict__ Sp = SB + ((size_t)z * A2_ROWS + b * NCH) * 256 + gl * 128 + p;
            bf16* __restrict__ Hp = A2 + ((size_t)z * A2_ROWS + b * NCH) * A2_LD + 512 + gl * 128 + p;
            for (int c0 = 0; c0 < NCH; c0 += 32) {
                float sr[32], si[32];
#pragma unroll
                for (int j = 0; j < 32; ++j) { sr[j] = Sp[(size_t)(c0 + j) * 256]; si[j] = Sp[(size_t)(c0 + j) * 256 + 64]; }
#pragma unroll
                for (int j = 0; j < 32; ++j) { Hp[(size_t)(c0 + j) * A2_LD] = (bf16)f2bf(hr); Hp[(size_t)(c0 + j) * A2_LD + 64] = (bf16)f2bf(hi);
                    const float nr = ar * hr - ai * hi + sr[j], ni = ar * hi + ai * hr + si[j]; hr = nr; hi = ni; }
            }
            args.out[O_REP + (size_t)(b * 64 + g) * 64 + p] = hr; args.out[O_IMP + (size_t)(b * 64 + g) * 64 + p] = hi;
        }
        for (int e = F.bid * 64 + (F.tid - 64); F.tid >= 64 && F.tid < 128 && e < NB * DLRU; e += F.G * 64) {
            const int b = e >> 10, chn = e & 1023;
            const float* __restrict__ ag = (const float*)(ws + WS_AGG) + ((size_t)(b * 128) * DLRU + chn) * 2; float* __restrict__ hn = (float*)(ws + WS_HIN) + (size_t)(b * 128) * DLRU + chn;
            float h = 0.f;
            for (int c0 = 0; c0 < 128; c0 += 32) {
                float aa[32], hh[32];
#pragma unroll
                for (int j = 0; j < 32; ++j) { aa[j] = ag[(size_t)(c0 + j) * DLRU * 2]; hh[j] = ag[(size_t)(c0 + j) * DLRU * 2 + 1]; }
#pragma unroll
                for (int j = 0; j < 32; ++j) { hn[(size_t)(c0 + j) * DLRU] = h; h = aa[j] * h + hh[j]; }
            }
        }
    } } }
    }
    SEAM(3);
    if (IN(4)) {
        if (DUP_PHASE == 4) { constexpr bool dup = true; (void)dup; { {
        if constexpr (!dup) { pg8::Gemm g{A2, KG, A2_LD, 768, 768, (size_t)A2_ROWS * A2_LD, (size_t)512 * 768}; pg8::Order S; S.init(A2_ROWS, 512, NPAIR, F.G, F.bid);
          pg8::EpiY E{gbuf};
          pg8::gemm_phase<pg8::EpiY, pg8::Order, true, true>(F.lds, g, S, E); }
        __syncthreads();
        if constexpr (!dup) { const int nyu = NPAIR * 4, nidle = F.G > nyu ? F.G - nyu : F.G, rank = F.G > nyu ? F.bid - nyu : F.bid;
          if (rank >= 0) for (int it = rank * NWAVES + F.wave; it < 2048; it += nidle * NWAVES) s5_sample_item(F, it);
          __syncthreads(); }
#ifdef YG_REP
        if constexpr (!dup) { xcd_barrier(xbar); pg8::Gemm g{A2, KG, A2_LD, 768, 768, (size_t)A2_ROWS * A2_LD, (size_t)512 * 768}; pg8::Order S; S.init(A2_ROWS, 512, NPAIR, F.G, F.bid);
          pg8::EpiY E{gbuf};
          pg8::gemm_phase<pg8::EpiY, pg8::Order, true, true>(F.lds, g, S, E); xcd_barrier(xbar); }
#endif
        __syncthreads();
#ifdef LRU2_REP
#pragma nounroll
        for (int rep = 0; rep < LRU2_REP; ++rep) { lruw_tiles(F, 2, 544, cnt + 2048 + 256 * rep, ssqd, LRU_MODE); xcd_barrier(xbar); }
#endif
        lruw_tiles(F, 2, 544, cnt + (dup ? 1536 : 1280), dup ? ssqd : ssqa); __syncthreads();
    } } xcd_barrier(xbar); }
        { constexpr bool dup = false; (void)dup; { {
        if constexpr (!dup) { pg8::Gemm g{A2, KG, A2_LD, 768, 768, (size_t)A2_ROWS * A2_LD, (size_t)512 * 768}; pg8::Order S; S.init(A2_ROWS, 512, NPAIR, F.G, F.bid);
          pg8::EpiY E{gbuf};
          pg8::gemm_phase<pg8::EpiY, pg8::Order, true, true>(F.lds, g, S, E); }
        __syncthreads();
        if constexpr (!dup) { const int nyu = NPAIR * 4, nidle = F.G > nyu ? F.G - nyu : F.G, rank = F.G > nyu ? F.bid - nyu : F.bid;
          if (rank >= 0) for (int it = rank * NWAVES + F.wave; it < 2048; it += nidle * NWAVES) s5_sample_item(F, it);
          __syncthreads(); }
#ifdef YG_REP
        if constexpr (!dup) { xcd_barrier(xbar); pg8::Gemm g{A2, KG, A2_LD, 768, 768, (size_t)A2_ROWS * A2_LD, (size_t)512 * 768}; pg8::Order S; S.init(A2_ROWS, 512, NPAIR, F.G, F.bid);
          pg8::EpiY E{gbuf};
          pg8::gemm_phase<pg8::EpiY, pg8::Order, true, true>(F.lds, g, S, E); xcd_barrier(xbar); }
#endif
        __syncthreads();
#ifdef LRU2_REP
#pragma nounroll
        for (int rep = 0; rep < LRU2_REP; ++rep) { lruw_tiles(F, 2, 544, cnt + 2048 + 256 * rep, ssqd, LRU_MODE); xcd_barrier(xbar); }
#endif
        lruw_tiles(F, 2, 544, cnt + (dup ? 1536 : 1280), dup ? ssqd : ssqa); __syncthreads();
    } } }
    }
    SEAM(4);
    if (IN(5)) {
        if (DUP_PHASE == 5) { constexpr bool dup = true; (void)dup; { {
        pg8::Gemm g{gbuf, WgluT, DS5, DS5, DS5, 0, 0}; pg8::Order S; S.init(MT, DS5, 1, F.G, F.bid);
        pg8::EpiGlu E{gbuf, inp(F, I_BGLU), MIX, dup ? ssqd : ssqb};
        pg8::gemm_phase<pg8::EpiGlu, pg8::Order, true, true>(F.lds, g, S, E);
        __syncthreads();
        if constexpr (!dup) tr_items_dyn(F, inp(F, I_WOUT), inp(F, I_NOUTA), DM, DM, WoutT, cnt + 11, inp(F, I_NOUTB));
    } } xcd_barrier(xbar); }
        { constexpr bool dup = false; (void)dup; { {
        pg8::Gemm g{gbuf, WgluT, DS5, DS5, DS5, 0, 0}; pg8::Order S; S.init(MT, DS5, 1, F.G, F.bid);
        pg8::EpiGlu E{gbuf, inp(F, I_BGLU), MIX, dup ? ssqd : ssqb};
        pg8::gemm_phase<pg8::EpiGlu, pg8::Order, true, true>(F.lds, g, S, E);
        __syncthreads();
        if constexpr (!dup) tr_items_dyn(F, inp(F, I_WOUT), inp(F, I_NOUTA), DM, DM, WoutT, cnt + 11, inp(F, I_NOUTB));
    } } }
    }
    SEAM(5);
    if (IN(6)) {
        if (DUP_PHASE == 6) { constexpr bool dup = true; (void)dup; { {
        { pg8::Gemm g{MIX, WoutT, DM, DM, 1024, 1024, 1024}; pg8::Order S; S.init(MP, DM, -1, F.G, F.bid);
          pg8::EpiOut E{ssqa, ssqb, inp(F, I_XP), inp(F, I_XS), args.out, XB, dup ? ssqd : ssq1};
          pg8::gemm_phase<pg8::EpiOut, pg8::Order, true, true>(F.lds, g, S, E); }
        { pg8::Gemm g{MIX, WoutT, DM, DM, 256, 256, 256}; pg8::SliceOrder S{F.bid, 8, F.G};
          pg8::EpiPart E{(float*)(ws + WS_KG), (float*)(ws + WS_A2), 8};
          pg8::gemm_phase<pg8::EpiPart, pg8::SliceOrder, true, true>(F.lds, g, S, E); }
        if constexpr (!dup) { if (hi - lo > 1) xcd_barrier(xbar);
          for (int r2 = F.bid; r2 < MS / 2; r2 += F.G) {
            const int row = MP + 2 * r2 + (F.wave >> 2), qd = F.wave & 3, pm = row >> 8, rl = row & 255;
            const float* Pb = (const float*)(ws + (pm == 32 ? WS_KG : WS_A2));
            const float ra = 1.f / sqrtf(ssqa[row] * (1.f / DLRU) + EPS), rb = 1.f / sqrtf(ssqb[row] * (1.f / DS5) + EPS);
            float sq = 0.f;
#pragma unroll
            for (int jj = 0; jj < 2; ++jj) { const int col = 512 * qd + 256 * jj + 4 * F.lane, pn = col >> 8, cl = col & 255;
                const float* pp = Pb + (size_t)(pn * 8) * 65536 + rl * 256 + cl;
                f32x4 sa = {0.f, 0.f, 0.f, 0.f}, sb2 = {0.f, 0.f, 0.f, 0.f};
#pragma unroll
                for (int sl = 0; sl < 4; ++sl) { sa += *(const f32x4*)(pp + (size_t)sl * 65536); sb2 += *(const f32x4*)(pp + (size_t)(sl + 4) * 65536); }
                const f32x4 v = *(const f32x4*)(inp(F, I_XS) + (size_t)(row - MP) * DM + col) + sa * ra + sb2 * rb;
                *(f32x4*)(args.out + (size_t)row * DM + col) = v;
                v2u pk; pk.x = pk2(v.x, v.y); pk.y = pk2(v.z, v.w); *(v2u*)(XB + (size_t)row * DM + col) = pk;
                sq += (v.x * v.x + v.y * v.y) + (v.z * v.z + v.w * v.w); }
            sq = wave_sum(sq);
            if (F.lane == 0) atomicAdd(ssq1 + row, sq);
          } }
    } } xcd_barrier(xbar); }
        { constexpr bool dup = false; (void)dup; { {
        { pg8::Gemm g{MIX, WoutT, DM, DM, 1024, 1024, 1024}; pg8::Order S; S.init(MP, DM, -1, F.G, F.bid);
          pg8::EpiOut E{ssqa, ssqb, inp(F, I_XP), inp(F, I_XS), args.out, XB, dup ? ssqd : ssq1};
          pg8::gemm_phase<pg8::EpiOut, pg8::Order, true, true>(F.lds, g, S, E); }
        { pg8::Gemm g{MIX, WoutT, DM, DM, 256, 256, 256}; pg8::SliceOrder S{F.bid, 8, F.G};
          pg8::EpiPart E{(float*)(ws + WS_KG), (float*)(ws + WS_A2), 8};
          pg8::gemm_phase<pg8::EpiPart, pg8::SliceOrder, true, true>(F.lds, g, S, E); }
        if constexpr (!dup) { if (hi - lo > 1) xcd_barrier(xbar);
          for (int r2 = F.bid; r2 < MS / 2; r2 += F.G) {
            const int row = MP + 2 * r2 + (F.wave >> 2), qd = F.wave & 3, pm = row >> 8, rl = row & 255;
            const float* Pb = (const float*)(ws + (pm == 32 ? WS_KG : WS_A2));
            const float ra = 1.f / sqrtf(ssqa[row] * (1.f / DLRU) + EPS), rb = 1.f / sqrtf(ssqb[row] * (1.f / DS5) + EPS);
            float sq = 0.f;
#pragma unroll
            for (int jj = 0; jj < 2; ++jj) { const int col = 512 * qd + 256 * jj + 4 * F.lane, pn = col >> 8, cl = col & 255;
                const float* pp = Pb + (size_t)(pn * 8) * 65536 + rl * 256 + cl;
                f32x4 sa = {0.f, 0.f, 0.f, 0.f}, sb2 = {0.f, 0.f, 0.f, 0.f};
#pragma unroll
                for (int sl = 0; sl < 4; ++sl) { sa += *(const f32x4*)(pp + (size_t)sl * 65536); sb2 += *(const f32x4*)(pp + (size_t)(sl + 4) * 65536); }
                const f32x4 v = *(const f32x4*)(inp(F, I_XS) + (size_t)(row - MP) * DM + col) + sa * ra + sb2 * rb;
                *(f32x4*)(args.out + (size_t)row * DM + col) = v;
                v2u pk; pk.x = pk2(v.x, v.y); pk.y = pk2(v.z, v.w); *(v2u*)(XB + (size_t)row * DM + col) = pk;
                sq += (v.x * v.x + v.y * v.y) + (v.z * v.z + v.w * v.w); }
            sq = wave_sum(sq);
            if (F.lane == 0) atomicAdd(ssq1 + row, sq);
          } }
    } } }
    }
    SEAM(6);
    if (IN(7)) {
        if (DUP_PHASE == 7) { constexpr bool dup = true; (void)dup; { {
        pg8::Gemm g{XB, WupT, DM, DM, DM, 0, 0}; pg8::Order S; S.init(MT, DFF, 1, F.G, F.bid);
        pg8::EpiUp E{ssq1, HB};
        pg8::gemm_phase<pg8::EpiUp, pg8::Order, true, true>(F.lds, g, S, E);
        __syncthreads();
        if constexpr (!dup) tr_items_dyn(F, inp(F, I_WDOWN), nullptr, DFF, DM, WdownT, cnt + 9);
    } } xcd_barrier(xbar); }
        { constexpr bool dup = false; (void)dup; { {
        pg8::Gemm g{XB, WupT, DM, DM, DM, 0, 0}; pg8::Order S; S.init(MT, DFF, 1, F.G, F.bid);
        pg8::EpiUp E{ssq1, HB};
        pg8::gemm_phase<pg8::EpiUp, pg8::Order, true, true>(F.lds, g, S, E);
        __syncthreads();
        if constexpr (!dup) tr_items_dyn(F, inp(F, I_WDOWN), nullptr, DFF, DM, WdownT, cnt + 9);
    } } }
    }
    SEAM(7);
    if (IN(8)) {
        if (DUP_PHASE == 8) { constexpr bool dup = true; (void)dup; { {
        { pg8::Gemm g{HB, WdownT, DFF, DFF, DFF, 0, 0}; pg8::Order S; S.init(MP, DM, 1, F.G, F.bid);
          pg8::EpiDown E{args.out, XB, dup ? 0.f : 1.f};
          pg8::gemm_phase<pg8::EpiDown, pg8::Order, true, true>(F.lds, g, S, E); }
        { pg8::Gemm g{HB, WdownT, DFF, DFF, 1024, 1024, 1024}; pg8::SliceOrder S{F.bid, 8, F.G};
          pg8::EpiPart E{(float*)(ws + WS_WUP), (float*)(ws + WS_WUP) + (size_t)64 * 65536, 8};
          pg8::gemm_phase<pg8::EpiPart, pg8::SliceOrder, true, true>(F.lds, g, S, E); }
    } } xcd_barrier(xbar); }
        { constexpr bool dup = false; (void)dup; { {
        { pg8::Gemm g{HB, WdownT, DFF, DFF, DFF, 0, 0}; pg8::Order S; S.init(MP, DM, 1, F.G, F.bid);
          pg8::EpiDown E{args.out, XB, dup ? 0.f : 1.f};
          pg8::gemm_phase<pg8::EpiDown, pg8::Order, true, true>(F.lds, g, S, E); }
        { pg8::Gemm g{HB, WdownT, DFF, DFF, 1024, 1024, 1024}; pg8::SliceOrder S{F.bid, 8, F.G};
          pg8::EpiPart E{(float*)(ws + WS_WUP), (float*)(ws + WS_WUP) + (size_t)64 * 65536, 8};
          pg8::gemm_phase<pg8::EpiPart, pg8::SliceOrder, true, true>(F.lds, g, S, E); }
    } } }
    }
    SEAM(8);
    if (IN(9)) {
        if (DUP_PHASE == 9) { constexpr bool dup = true; (void)dup; { {
        const float* gf = inp(F, I_NFINAL);
        for (int r2 = F.bid; r2 < MS / 2; r2 += F.G) {
            const int row = MP + 2 * r2 + (F.wave >> 2), qd = F.wave & 3, pm = row >> 8, rl = row & 255;
            const float* Pb = (const float*)(ws + WS_WUP) + (pm == 32 ? (size_t)0 : (size_t)64 * 65536);
            f32x4 v[2]; float sq = 0.f;
#pragma unroll
            for (int jj = 0; jj < 2; ++jj) { const int col = 512 * qd + 256 * jj + 4 * F.lane, pn = col >> 8, cl = col & 255;
                f32x4 a = *(const f32x4*)(args.out + (size_t)row * DM + col);
                const float* pp = Pb + (size_t)(pn * 8) * 65536 + rl * 256 + cl;
#pragma unroll
                for (int sl = 0; sl < 8; ++sl) a += *(const f32x4*)(pp + (size_t)sl * 65536);
                v[jj] = a; sq += (a.x * a.x + a.y * a.y) + (a.z * a.z + a.w * a.w); }
            sq = wave_sum(sq);
            LAS float* red = (LAS float*)(F.lds + MISC_OFF + 128);
            if (F.lane == 0) red[F.wave] = sq;
            __syncthreads();
            const int w0 = F.wave & 4; const float tot = (red[w0] + red[w0 + 1]) + (red[w0 + 2] + red[w0 + 3]);
            __syncthreads();
            const float rs = dup ? 1.f : 1.f / sqrtf(tot * (1.f / DM) + EPS);
#pragma unroll
            for (int jj = 0; jj < 2; ++jj) { const int col = 512 * qd + 256 * jj + 4 * F.lane; const f32x4 gr = dup ? (f32x4){1.f, 1.f, 1.f, 1.f} : *(const f32x4*)(gf + col);
                f32x4 o = v[jj] * rs * gr; if (dup) o = *(const f32x4*)(args.out + (size_t)row * DM + col);
                *(f32x4*)(args.out + (size_t)row * DM + col) = o; }
        }
        for (int m = F.bid * NWAVES + F.wave; m < MP; m += F.G * NWAVES) {
            const v4u* xb = (const v4u*)(args.out + (size_t)m * DM) + F.lane; float* xo = args.out + (size_t)m * DM;
            v4u w[4]; float sq = 0.f; f32x4 v[8];
#pragma unroll
            for (int j = 0; j < 4; ++j) w[j] = xb[64 * j];
#pragma unroll
            for (int j = 0; j < 4; ++j) { v[2 * j] = (f32x4){bflo(w[j].x), bfhi(w[j].x), bflo(w[j].y), bfhi(w[j].y)}; v[2 * j + 1] = (f32x4){bflo(w[j].z), bfhi(w[j].z), bflo(w[j].w), bfhi(w[j].w)};
                sq += (v[2 * j].x * v[2 * j].x + v[2 * j].y * v[2 * j].y) + (v[2 * j].z * v[2 * j].z + v[2 * j].w * v[2 * j].w) + (v[2 * j + 1].x * v[2 * j + 1].x + v[2 * j + 1].y * v[2 * j + 1].y) + (v[2 * j + 1].z * v[2 * j + 1].z + v[2 * j + 1].w * v[2 * j + 1].w); }
            sq = wave_sum(sq);
            const float rs = 1.f / sqrtf(sq * (1.f / DM) + EPS);
            asm volatile("s_waitcnt vmcnt(0)" ::: "memory");
#pragma unroll
            for (int j = 0; j < 4; ++j) { const int c0 = 8 * (F.lane + 64 * j); const f32x4 g0 = *(const f32x4*)(gf + c0), g1 = *(const f32x4*)(gf + c0 + 4);
                *(f32x4*)(xo + c0) = v[2 * j] * rs * g0; *(f32x4*)(xo + c0 + 4) = v[2 * j + 1] * rs * g1; }
        }
    } } xcd_barrier(xbar); }
        { constexpr bool dup = false; (void)dup; { {
        const float* gf = inp(F, I_NFINAL);
        for (int r2 = F.bid; r2 < MS / 2; r2 += F.G) {
            const int row = MP + 2 * r2 + (F.wave >> 2), qd = F.wave & 3, pm = row >> 8, rl = row & 255;
            const float* Pb = (const float*)(ws + WS_WUP) + (pm == 32 ? (size_t)0 : (size_t)64 * 65536);
            f32x4 v[2]; float sq = 0.f;
#pragma unroll
            for (int jj = 0; jj < 2; ++jj) { const int col = 512 * qd + 256 * jj + 4 * F.lane, pn = col >> 8, cl = col & 255;
                f32x4 a = *(const f32x4*)(args.out + (size_t)row * DM + col);
                const float* pp = Pb + (size_t)(pn * 8) * 65536 + rl * 256 + cl;
#pragma unroll
                for (int sl = 0; sl < 8; ++sl) a += *(const f32x4*)(pp + (size_t)sl * 65536);
                v[jj] = a; sq += (a.x * a.x + a.y * a.y) + (a.z * a.z + a.w * a.w); }
            sq = wave_sum(sq);
            LAS float* red = (LAS float*)(F.lds + MISC_OFF + 128);
            if (F.lane == 0) red[F.wave] = sq;
            __syncthreads();
            const int w0 = F.wave & 4; const float tot = (red[w0] + red[w0 + 1]) + (red[w0 + 2] + red[w0 + 3]);
            __syncthreads();
            const float rs = dup ? 1.f : 1.f / sqrtf(tot * (1.f / DM) + EPS);
#pragma unroll
            for (int jj = 0; jj < 2; ++jj) { const int col = 512 * qd + 256 * jj + 4 * F.lane; const f32x4 gr = dup ? (f32x4){1.f, 1.f, 1.f, 1.f} : *(const f32x4*)(gf + col);
                f32x4 o = v[jj] * rs * gr; if (dup) o = *(const f32x4*)(args.out + (size_t)row * DM + col);
                *(f32x4*)(args.out + (size_t)row * DM + col) = o; }
        }
        for (int m = F.bid * NWAVES + F.wave; m < MP; m += F.G * NWAVES) {
            const v4u* xb = (const v4u*)(args.out + (size_t)m * DM) + F.lane; float* xo = args.out + (size_t)m * DM;
            v4u w[4]; float sq = 0.f; f32x4 v[8];
#pragma unroll
            for (int j = 0; j < 4; ++j) w[j] = xb[64 * j];
#pragma unroll
            for (int j = 0; j < 4; ++j) { v[2 * j] = (f32x4){bflo(w[j].x), bfhi(w[j].x), bflo(w[j].y), bfhi(w[j].y)}; v[2 * j + 1] = (f32x4){bflo(w[j].z), bfhi(w[j].z), bflo(w[j].w), bfhi(w[j].w)};
                sq += (v[2 * j].x * v[2 * j].x + v[2 * j].y * v[2 * j].y) + (v[2 * j].z * v[2 * j].z + v[2 * j].w * v[2 * j].w) + (v[2 * j + 1].x * v[2 * j + 1].x + v[2 * j + 1].y * v[2 * j + 1].y) + (v[2 * j + 1].z * v[2 * j + 1].z + v[2 * j + 1].w * v[2 * j + 1].w); }
            sq = wave_sum(sq);
            const float rs = 1.f / sqrtf(sq * (1.f / DM) + EPS);
            asm volatile("s_waitcnt vmcnt(0)" ::: "memory");
#pragma unroll
            for (int j = 0; j < 4; ++j) { const int c0 = 8 * (F.lane + 64 * j); const f32x4 g0 = *(const f32x4*)(gf + c0), g1 = *(const f32x4*)(gf + c0 + 4);
                *(f32x4*)(xo + c0) = v[2 * j] * rs * g0; *(f32x4*)(xo + c0 + 4) = v[2 * j + 1] * rs * g1; }
        }
    } } }
    }
#undef IN
#undef SEAM
}

#ifndef MK_MULTI_LAUNCH
#define MK_MULTI_LAUNCH 0
#endif
extern "C" void kernel_launch(void* const* d_in, const int* in_sizes, int n_in, void* d_out, int out_size, void* d_ws, size_t ws_size, hipStream_t stream) {
    static int grid = 0;
    if (grid == 0) {
        if (n_in != 32 || (size_t)out_size != O_END || ws_size < WS_END) { fprintf(stderr, "kernel_launch: unexpected sizes n_in %d out %d ws %zu\n", n_in, out_size, ws_size); grid = -1; return; }
        int dev = 0, cus = 0, per_cu = 0;
        hipGetDevice(&dev); hipDeviceGetAttribute(&cus, hipDeviceAttributeMultiprocessorCount, dev);
        if (hipFuncSetAttribute((const void*)fwd_megakernel, hipFuncAttributeMaxDynamicSharedMemorySize, LDS_BYTES) != hipSuccess) { fprintf(stderr, "kernel_launch: hipFuncSetAttribute failed\n"); grid = -1; return; }
        if (hipOccupancyMaxActiveBlocksPerMultiprocessor(&per_cu, (const void*)fwd_megakernel, NTHR, LDS_BYTES) != hipSuccess || per_cu < 1) { fprintf(stderr, "kernel_launch: occupancy query says %d\n", per_cu); per_cu = 1; }
        (void)hipGetLastError();
        grid = cus * 1;
        fprintf(stderr, "kernel_launch: grid %d (cus %d, per_cu %d)\n", grid, cus, per_cu);
    }
    if (grid < 0) return;
    hipMemsetAsync((char*)d_ws + WS_CTL, 0, CTL_BYTES, stream);
    Args a{};
    for (int i = 0; i < 32; ++i) a.in[i] = (const float*)d_in[i];
    a.out = (float*)d_out; a.ws = (unsigned char*)d_ws;
#if MK_MULTI_LAUNCH
    for (int p = 0; p < NPHASE; ++p) { a.ph_lo = p; a.ph_hi = p + 1; hipLaunchKernelGGL(fwd_megakernel, dim3(grid), dim3(NTHR), LDS_BYTES, stream, a); }
#else
    a.ph_lo = 0; a.ph_hi = NPHASE;
    void* kargs[] = {&a};
    hipError_t e = hipLaunchCooperativeKernel((const void*)fwd_megakernel, dim3(grid), dim3(NTHR), kargs, LDS_BYTES, stream);
    if (e != hipSuccess) fprintf(stderr, "kernel_launch: cooperative launch failed: %s (grid %d)\n", hipGetErrorString(e), grid);
#endif
}
```

```cpp
#include <hip/hip_runtime.h>
#include <hip/hip_cooperative_groups.h>
#include <cstdio>
#include <cstdint>
namespace cg = cooperative_groups;

namespace pg8 {
#define PG8_LAS __attribute__((address_space(3)))
typedef unsigned short bf16_t;
typedef short bf16x8 __attribute__((ext_vector_type(8)));
typedef float f32x4 __attribute__((ext_vector_type(4)));
typedef unsigned u32x4 __attribute__((ext_vector_type(4)));
constexpr int BM = 256, BK = 64, HALF = 128, HTB = HALF * BK * 2  , STAGE_BYTES = 8 * HTB, NXCD = 8, WGM = 8;

__host__ __device__ __forceinline__ int lds_byte(int r, int c) { const int st = (r >> 4) * 2 + (c >> 5), rr = r & 15, cc = c & 31, ob = rr * 64 + cc * 2; return st * 1024 + (ob ^ (((ob >> 9) & 1) << 5)); }
__host__ __device__ __forceinline__ void stage_rc(int b, int& R, int& C) { const int st = b / 1024, sb = b % 1024, swz = sb ^ (((sb >> 9) & 1) << 5); R = (st >> 1) * 16 + swz / 64; C = (st & 1) * 32 + (swz % 64) / 2; }
__host__ __device__ __forceinline__ int perm32(int rho) { const int n = rho >> 4, i = rho & 15; return 8 * (i >> 2) + 4 * n + (i & 3); }

struct Unit { int pm, pn, z; };
struct Gemm { const bf16_t* A; const bf16_t* Bt; int lda, ldb, K; size_t sA, sB; };

struct Order {
    int nM, nN, nZ, G, c;
    __device__ void init(int M, int N, int Z, int G_, int c_) { nM = M / BM; nN = N / BM; nZ = Z; G = G_; c = c_; }
    __device__ bool next(int i, Unit& u) const {
        int zz = 0; if (nZ < 0) { zz = i & 1; i >>= 1; }
        const long L = (long)i * G + c; const int nwg = nM * nN; if (L >= (long)nwg * (nZ < 0 ? 1 : nZ)) return false;
        if (nZ > 1) { const int z = (int)(L / nwg), r = (int)(L % nwg); u.z = z; u.pm = r % nM; u.pn = r / nM; return true; }
        int wgid = (int)L; { const int q = nwg / NXCD, r = nwg % NXCD, xcd = wgid % NXCD, off = wgid / NXCD; wgid = (xcd < r ? xcd * (q + 1) : r * (q + 1) + (xcd - r) * q) + off; }
        const int nig = WGM * nN, gid = wgid / nig, fm = gid * WGM, gsz = (nM - fm) < WGM ? (nM - fm) : WGM;
        u.pm = fm + ((wgid % nig) % gsz); u.pn = (wgid % nig) / gsz; u.z = zz; return true;
    }
    __device__ __forceinline__ void a_ready(const Unit&) const {}
    __device__ __forceinline__ void done(const Unit&) const {}
};

__device__ __forceinline__ unsigned cvt_pk_bf16(float lo, float hi) { unsigned r; asm volatile("v_cvt_pk_bf16_f32 %0, %1, %2" : "=v"(r) : "v"(lo), "v"(hi)); return r; }

template <class Epi, class Sched, bool ALIGN_EPI = false, bool SP2 = false>
__device__ __forceinline__ void gemm_phase(PG8_LAS unsigned char* lds, const Gemm g, const Sched& S, const Epi& E) {
    const int tid = threadIdx.x, wid = __builtin_amdgcn_readfirstlane(tid >> 6), lane = tid & 63, wr = wid >> 2, wc = wid & 3, fr = lane & 15, fq = lane >> 4;
    const int K = g.K, nt = K / BK;
    unsigned voffA[2], voffB[2];
#pragma unroll
    for (int i = 0; i < 2; ++i) { int R, C; stage_rc(tid * 16 + i * 8192, R, C); const int Rb = Epi::PERM ? ((R & ~31) + perm32(R & 31)) : R;
        voffA[i] = (unsigned)(R * g.lda + C) * 2u; voffB[i] = (unsigned)(Rb * g.ldb + C) * 2u; }
    const size_t kstep = (size_t)(BK * 2);
    const size_t hstepA = (size_t)HALF * g.lda * 2, hstepB = (size_t)HALF * g.ldb * 2;
    const size_t tstepA = 2 * hstepA, tstepB = 2 * hstepB;
    const unsigned ldsw = (unsigned)wid * 1024u;
    const int aoff = lds_byte(wr * 64 + fr, fq * 8), boff = lds_byte(wc * 32 + fr, fq * 8);
#define PG8_SA(b, h) (((b) * 2 + (h)) * HTB)
#define PG8_SB(b, h) ((4 + (b) * 2 + (h)) * HTB)
#define PG8_STAGE(bufoff, gbase, voff) do { _Pragma("unroll") for (int _i = 0; _i < 2; ++_i) \
        __builtin_amdgcn_global_load_lds((const unsigned*)((const char*)(gbase) + (voff)[_i]), (PG8_LAS unsigned*)(lds + (bufoff) + ldsw + _i * 8192), 16, 0, 0); } while (0)
#define PG8_LDA(dst, b, h) do { _Pragma("unroll") for (int m = 0; m < 4; ++m) _Pragma("unroll") for (int k = 0; k < 2; ++k) dst[m][k] = *(const PG8_LAS bf16x8*)(lds + PG8_SA(b, h) + aoff + m * 2048 + k * 1024); } while (0)
#define PG8_LDB(dst, b, h) do { _Pragma("unroll") for (int n = 0; n < 2; ++n) _Pragma("unroll") for (int k = 0; k < 2; ++k) dst[n][k] = *(const PG8_LAS bf16x8*)(lds + PG8_SB(b, h) + boff + n * 2048 + k * 1024); } while (0)
#define PG8_MMA(ai, bj, At, Bt) do { __builtin_amdgcn_s_setprio(1); _Pragma("unroll") for (int m = 0; m < 4; ++m) _Pragma("unroll") for (int n = 0; n < 2; ++n) _Pragma("unroll") for (int k = 0; k < 2; ++k) \
        acc[ai][bj][m][n] = __builtin_amdgcn_mfma_f32_16x16x32_bf16(Bt[n][k], At[m][k], acc[ai][bj][m][n], 0, 0, 0); __builtin_amdgcn_s_setprio(0); } while (0)
#define PG8_WAIT_V(n) asm volatile("s_waitcnt vmcnt(" #n ")" ::: "memory")
#define PG8_WAIT_L(n) asm volatile("s_waitcnt lgkmcnt(" #n ")" ::: "memory")
#define PG8_BAR __builtin_amdgcn_s_barrier()
#define PG8_SCHED __builtin_amdgcn_sched_barrier(0)
    Unit cur, nxt; int ui = 0;
    if (!S.next(0, cur)) return;
    f32x4 acc[2][2][4][2];
#pragma unroll
    for (int a = 0; a < 2; ++a)
#pragma unroll
        for (int b = 0; b < 2; ++b)
#pragma unroll
            for (int m = 0; m < 4; ++m)
#pragma unroll
                for (int n = 0; n < 2; ++n) acc[a][b][m][n] = (f32x4){0.f, 0.f, 0.f, 0.f};
    bf16x8 At[4][2], B0[2][2], B1[2][2];
    const char* cA = (const char*)g.A + (size_t)cur.z * g.sA * 2 + (size_t)cur.pm * tstepA; const char* cB = (const char*)g.Bt + (size_t)cur.z * g.sB * 2 + (size_t)cur.pn * tstepB;
    S.a_ready(cur);
    if constexpr (SP2) {
        PG8_STAGE(PG8_SB(0, 0), cB, voffB); PG8_STAGE(PG8_SB(0, 1), cB + hstepB, voffB); PG8_STAGE(PG8_SA(0, 0), cA, voffA); PG8_STAGE(PG8_SA(0, 1), cA + hstepA, voffA);
        if (wr == 1) PG8_BAR;
        PG8_WAIT_V(2); PG8_BAR;
        PG8_STAGE(PG8_SB(1, 0), cB + kstep, voffB); PG8_STAGE(PG8_SA(1, 0), cA + kstep, voffA); PG8_STAGE(PG8_SB(1, 1), cB + hstepB + kstep, voffB);
        PG8_WAIT_V(6); PG8_BAR;
    } else {
        PG8_STAGE(PG8_SB(0, 0), cB, voffB); PG8_STAGE(PG8_SA(0, 0), cA, voffA); PG8_STAGE(PG8_SB(0, 1), cB + hstepB, voffB); PG8_STAGE(PG8_SA(0, 1), cA + hstepA, voffA);
        if (wr == 1) PG8_BAR;
        PG8_WAIT_V(4); PG8_BAR;
        PG8_STAGE(PG8_SB(1, 0), cB + kstep, voffB); PG8_STAGE(PG8_SA(1, 0), cA + kstep, voffA); PG8_STAGE(PG8_SB(1, 1), cB + hstepB + kstep, voffB);
        PG8_WAIT_V(6); PG8_BAR;
    }
    for (;;) {
        const bool has_next = S.next(ui + 1, nxt);
        const char* nA = has_next ? (const char*)g.A + (size_t)nxt.z * g.sA * 2 + (size_t)nxt.pm * tstepA : cA; const char* nB = has_next ? (const char*)g.Bt + (size_t)nxt.z * g.sB * 2 + (size_t)nxt.pn * tstepB : cB;
        for (int t = 0; t < nt; t += 2) {
            const bool last = (t == nt - 2);
            const char* a1 = cA + (size_t)(t + 1) * kstep;
            const char* a2 = last ? nA : cA + (size_t)(t + 2) * kstep; const char* b2 = last ? nB : cB + (size_t)(t + 2) * kstep;
            const char* a3 = a2 + kstep; const char* b3 = b2 + kstep;
            if (last && has_next) S.a_ready(nxt);
            if constexpr (SP2) {
            PG8_LDB(B0, 0, 0); PG8_LDB(B1, 0, 1); PG8_SCHED; PG8_LDA(At, 0, 0); PG8_STAGE(PG8_SA(1, 1), a1 + hstepA, voffA);
            PG8_WAIT_V(8); PG8_WAIT_L(0); PG8_BAR; PG8_MMA(0, 0, At, B0); PG8_MMA(0, 1, At, B1); PG8_BAR; PG8_SCHED;
            PG8_LDA(At, 0, 1); PG8_STAGE(PG8_SB(0, 0), b2, voffB); PG8_STAGE(PG8_SB(0, 1), b2 + hstepB, voffB); PG8_STAGE(PG8_SA(0, 0), a2, voffA);
            PG8_WAIT_V(8); PG8_WAIT_L(0); PG8_BAR; PG8_MMA(1, 0, At, B0); PG8_MMA(1, 1, At, B1); PG8_BAR; PG8_SCHED;
            PG8_LDB(B0, 1, 0); PG8_LDB(B1, 1, 1); PG8_SCHED; PG8_LDA(At, 1, 0); PG8_STAGE(PG8_SA(0, 1), a2 + hstepA, voffA);
            PG8_WAIT_V(8); PG8_WAIT_L(0); PG8_BAR; PG8_MMA(0, 0, At, B0); PG8_MMA(0, 1, At, B1); PG8_BAR; PG8_SCHED;
            PG8_LDA(At, 1, 1); PG8_STAGE(PG8_SB(1, 0), b3, voffB); PG8_STAGE(PG8_SB(1, 1), b3 + hstepB, voffB); PG8_STAGE(PG8_SA(1, 0), a3, voffA);
            PG8_WAIT_V(8); PG8_WAIT_L(0); PG8_BAR; PG8_MMA(1, 0, At, B0); PG8_MMA(1, 1, At, B1); PG8_BAR; PG8_SCHED;
            } else {
            PG8_LDB(B0, 0, 0); PG8_SCHED; PG8_LDA(At, 0, 0); PG8_STAGE(PG8_SA(1, 1), a1 + hstepA, voffA);
            PG8_WAIT_L(8); PG8_BAR; PG8_WAIT_L(0); PG8_MMA(0, 0, At, B0); PG8_BAR; PG8_SCHED;
            PG8_LDB(B1, 0, 1); PG8_STAGE(PG8_SB(0, 0), b2, voffB);
            PG8_BAR; PG8_WAIT_L(0); PG8_MMA(0, 1, At, B1); PG8_BAR;
            PG8_LDA(At, 0, 1); PG8_STAGE(PG8_SA(0, 0), a2, voffA);
            PG8_BAR; PG8_WAIT_L(0); PG8_MMA(1, 0, At, B0); PG8_BAR; PG8_SCHED;
            PG8_STAGE(PG8_SB(0, 1), b2 + hstepB, voffB);
            PG8_WAIT_V(6); PG8_BAR; PG8_MMA(1, 1, At, B1); PG8_BAR;
            PG8_LDB(B0, 1, 0); PG8_SCHED; PG8_LDA(At, 1, 0); PG8_STAGE(PG8_SA(0, 1), a2 + hstepA, voffA);
            PG8_WAIT_L(8); PG8_BAR; PG8_WAIT_L(0); PG8_MMA(0, 0, At, B0); PG8_BAR; PG8_SCHED;
            PG8_LDB(B1, 1, 1); PG8_STAGE(PG8_SB(1, 0), b3, voffB);
            PG8_BAR; PG8_WAIT_L(0); PG8_MMA(0, 1, At, B1); PG8_BAR;
            PG8_LDA(At, 1, 1); PG8_STAGE(PG8_SA(1, 0), a3, voffA);
            PG8_BAR; PG8_WAIT_L(0); PG8_MMA(1, 0, At, B0); PG8_BAR; PG8_SCHED;
            PG8_STAGE(PG8_SB(1, 1), b3 + hstepB, voffB);
            PG8_WAIT_V(6); PG8_BAR; PG8_MMA(1, 1, At, B1); PG8_BAR;
            }
        }
        if constexpr (ALIGN_EPI) { if (wr == 0) PG8_BAR; }
        if constexpr (!Epi::AFTER_DRAIN) { E(acc, cur, wr, wc, fr, fq); S.done(cur); }
        if (!has_next) break;
        if (!(Epi::TWO_PART && cur.z == 0)) {
#pragma unroll
        for (int a = 0; a < 2; ++a)
#pragma unroll
            for (int b = 0; b < 2; ++b)
#pragma unroll
                for (int m = 0; m < 4; ++m)
#pragma unroll
                    for (int n = 0; n < 2; ++n) acc[a][b][m][n] = (f32x4){0.f, 0.f, 0.f, 0.f};
        }
        cur = nxt; cA = nA; cB = nB; ++ui;
        if constexpr (ALIGN_EPI) { if (wr == 1) PG8_BAR; }
    }
    PG8_WAIT_V(0);
    if constexpr (!ALIGN_EPI) { if (wr == 0) PG8_BAR; }
    PG8_BAR;
    if constexpr (Epi::AFTER_DRAIN) { E.fused(acc, cur, wr, wc, fr, fq, lds, wid, lane); S.done(cur); }
#undef PG8_SA
#undef PG8_SB
#undef PG8_STAGE
#undef PG8_LDA
#undef PG8_LDB
#undef PG8_MMA
#undef PG8_WAIT_V
#undef PG8_WAIT_L
#undef PG8_BAR
#undef PG8_SCHED
}
}

constexpr int NWAVES = 8, NTHR = 512;
constexpr int DM = 2048, DLRU = 1024, DS5 = 1024, DFF = 8192, NZ = 3072;
constexpr int MP = 8192, MS = 512, MT = MP + MS;
constexpr int SEQ = 2048, NB = 4, NSEQ = 128;
constexpr int NG = 64, NPAIR = 32, LCH = 16, NCH = 128;
constexpr int A2_LD = 768, A2_ROWS = 512;
constexpr float EPS = 1e-6f;

constexpr size_t MiB = 1u << 20;
constexpr size_t WS_CTL = 0, CTL_BYTES = 1 * MiB;
constexpr size_t CTL_SSQA = 0, CTL_SSQB = 64 * 1024, CTL_SSQ1 = 128 * 1024, CTL_SSQ2 = 192 * 1024, CTL_CNT = 256 * 1024, CTL_BAR = 512 * 1024;
constexpr size_t WS_SMALL = 1 * MiB;
constexpr size_t SM_WGA = WS_SMALL, SM_WGX = SM_WGA + 131072;
constexpr size_t SM_AGG = SM_WGX + 131072;
constexpr size_t SM_RS0 = SM_AGG + 524288;
constexpr size_t SM_E1 = SM_RS0 + 65536, SM_E16 = SM_E1 + 32768;
constexpr size_t SM_BBAR = SM_E16 + 32768;
constexpr size_t SM_SP = SM_BBAR + 524288;
static_assert(SM_SP + 4096 <= 4 * MiB, "small region");
constexpr size_t WS_WUP = 4 * MiB, WS_WDOWN = 36 * MiB, WS_XB = 68 * MiB;
constexpr size_t WS_H = 102 * MiB;
constexpr size_t WS_WIN = 102 * MiB, WS_WGLU = 114 * MiB, WS_WOUT = 116 * MiB;
constexpr size_t WS_M1 = 124 * MiB;
constexpr size_t WS_KG = 132 * MiB;
constexpr size_t WS_A2 = 156 * MiB;
constexpr size_t WS_US = 180 * MiB;
constexpr size_t WS_S = 182 * MiB;
constexpr size_t WS_MIX = 198 * MiB;
constexpr size_t WS_END = 246 * MiB;
constexpr size_t WS_AGG = 238 * MiB;
constexpr size_t WS_HIN = 242 * MiB;
static_assert(WS_XB + (size_t)MT * DM * 2 <= WS_H && WS_H + (size_t)MT * DFF * 2 <= WS_AGG && WS_MIX + (size_t)MT * DM * 2 <= WS_AGG, "ws map");
constexpr size_t DO_XLRU = 0, DO_GLRU = (size_t)MT * DLRU * 4, DO_G = DO_GLRU + (size_t)MT * DLRU * 2;
constexpr size_t O_Y = 0, O_CONVP = (size_t)MT * DM, O_LRUP = O_CONVP + 4 * 3 * 1024, O_REP = O_LRUP + 4 * 1024, O_IMP = O_REP + 4 * 64 * 64,
                 O_CONVS = O_IMP + 4 * 64 * 64, O_LRUS = O_CONVS + 128 * 3 * 1024, O_RES = O_LRUS + 128 * 1024, O_IMS = O_RES + 128 * 64 * 64, O_END = O_IMS + 128 * 64 * 64;

constexpr int RING_BYTES = 131072, MISC_OFF = RING_BYTES, LDS_BYTES = 147456;

#define LAS __attribute__((address_space(3)))
typedef unsigned short bf16;
typedef unsigned v4u __attribute__((ext_vector_type(4)));
typedef unsigned v2u __attribute__((ext_vector_type(2)));
typedef float f32x4 __attribute__((ext_vector_type(4)));
typedef short bf16x8 __attribute__((ext_vector_type(8)));
#define LDS_WAIT() asm volatile("s_waitcnt lgkmcnt(0)" ::: "memory")

__device__ __forceinline__ unsigned f2bf(float f) { unsigned u = __builtin_bit_cast(unsigned, f); return (u + 0x7fffu + ((u >> 16) & 1u)) >> 16; }
__device__ __forceinline__ unsigned pk2(float lo, float hi) { return f2bf(lo) | (f2bf(hi) << 16); }
__device__ __forceinline__ float bf2f(unsigned b) { return __builtin_bit_cast(float, b << 16); }
__device__ __forceinline__ float bflo(unsigned w) { return __builtin_bit_cast(float, w << 16); }
__device__ __forceinline__ float bfhi(unsigned w) { return __builtin_bit_cast(float, w & 0xffff0000u); }
__device__ __forceinline__ float sigmoidf_(float x) { return __builtin_amdgcn_rcpf(1.f + __expf(-x)); }
__device__ __forceinline__ float gelu_tanh(float x) { const float u = 1.5957691216f * (x + 0.044715f * x * x * x); return x * __builtin_amdgcn_rcpf(1.f + __expf(-u)); }
__device__ __forceinline__ float wave_sum(float v) {
#pragma unroll
    for (int o = 1; o < 64; o <<= 1) v += __shfl_xor(v, o);
    return v;
}
__device__ __forceinline__ void sincos_d(double x, double& s, double& c) {
    const double q = rint(x * 0.63661977236758134308), r = (x - q * 1.57079632679489655800) - q * 6.12323399573676603587e-17, r2 = r * r;
    double sr = 1.0 - r2 / 210.0; sr = 1.0 - r2 / 156.0 * sr; sr = 1.0 - r2 / 110.0 * sr; sr = 1.0 - r2 / 72.0 * sr; sr = 1.0 - r2 / 42.0 * sr; sr = 1.0 - r2 / 20.0 * sr; sr = 1.0 - r2 / 6.0 * sr; sr *= r;
    double cr = 1.0 - r2 / 182.0; cr = 1.0 - r2 / 132.0 * cr; cr = 1.0 - r2 / 90.0 * cr; cr = 1.0 - r2 / 56.0 * cr; cr = 1.0 - r2 / 30.0 * cr; cr = 1.0 - r2 / 12.0 * cr; cr = 1.0 - r2 / 2.0 * cr;
    const int qi = ((int)q) & 3;
    s = (qi == 0) ? sr : (qi == 1) ? cr : (qi == 2) ? -sr : -cr;
    c = (qi == 0) ? cr : (qi == 1) ? -sr : (qi == 2) ? -cr : sr;
}

namespace pg8 {
#define EPI_ROWS_BEGIN const int row0 = u.pm * BM + wr * 64 + fr; _Pragma("unroll") for (int ai = 0; ai < 2; ++ai) _Pragma("unroll") for (int m = 0; m < 4; ++m) { const int row = row0 + ai * HALF + m * 16;
#define EPI_ROWS_END }
__device__ __forceinline__ float fq_sum(float v) { v += __shfl_xor(v, 16); v += __shfl_xor(v, 32); return v; }
__device__ __forceinline__ float sq8(const f32x4& a, const f32x4& b) { return (a[0] * a[0] + a[1] * a[1]) + (a[2] * a[2] + a[3] * a[3]) + (b[0] * b[0] + b[1] * b[1]) + (b[2] * b[2] + b[3] * b[3]); }
__device__ __forceinline__ u32x4 pack8(const f32x4& a, const f32x4& b) { u32x4 w; w.x = cvt_pk_bf16(a[0], a[1]); w.y = cvt_pk_bf16(a[2], a[3]); w.z = cvt_pk_bf16(b[0], b[1]); w.w = cvt_pk_bf16(b[2], b[3]); return w; }

struct EpiZ {
    static constexpr bool PERM = true, AFTER_DRAIN = false, TWO_PART = false;
    const float* rs0; float* xlru; bf16_t* glru; bf16_t* A2; bf16_t* us;
    __device__ __forceinline__ void operator()(const f32x4 (&acc)[2][2][4][2], const Unit& u, int wr, int wc, int fr, int fq) const {
        const int colt = u.pn * BM + wc * 32 + 8 * fq;
        EPI_ROWS_BEGIN
            const float s = rs0[row];
#pragma unroll
            for (int bj = 0; bj < 2; ++bj) { const int col = colt + bj * HALF; const f32x4 v0 = acc[ai][bj][m][0] * s, v1 = acc[ai][bj][m][1] * s;
                if (u.pn < 4) { float* p = xlru + (size_t)row * DLRU + col; *(f32x4*)p = v0; *(f32x4*)(p + 4) = v1; }
                else if (u.pn < 8) { *(u32x4*)(glru + (size_t)row * DLRU + (col - 1024)) = pack8(v0, v1); }
                else { const int c = col - 2048;
                    if (u.pm < 32) *(u32x4*)(A2 + ((size_t)(c >> 5) * A2_ROWS + (row >> 4)) * A2_LD + (row & 15) * 32 + (c & 31)) = pack8(v0, v1);
                    else *(u32x4*)(us + (size_t)(row - MP) * DS5 + c) = pack8(v0, v1); } }
        EPI_ROWS_END
    }
};
struct EpiS {
    static constexpr bool PERM = true, AFTER_DRAIN = false, TWO_PART = false;
    float* S;
    __device__ __forceinline__ void operator()(const f32x4 (&acc)[2][2][4][2], const Unit& u, int wr, int wc, int fr, int fq) const {
        const int colt = u.pn * BM + wc * 32 + 8 * fq;
        EPI_ROWS_BEGIN
#pragma unroll
            for (int bj = 0; bj < 2; ++bj) { float* p = S + ((size_t)u.z * A2_ROWS + row) * 256 + colt + bj * HALF; *(f32x4*)p = acc[ai][bj][m][0]; *(f32x4*)(p + 4) = acc[ai][bj][m][1]; }
        EPI_ROWS_END
    }
};
struct EpiY {
    static constexpr bool PERM = true, AFTER_DRAIN = false, TWO_PART = false;
    bf16_t* gbuf;
    __device__ __forceinline__ void operator()(const f32x4 (&acc)[2][2][4][2], const Unit& u, int wr, int wc, int fr, int fq) const {
        EPI_ROWS_BEGIN
#pragma unroll
            for (int bj = 0; bj < 2; ++bj) { const int j = 8 * u.pn + 4 * bj + wc; f32x4 v0 = acc[ai][bj][m][0], v1 = acc[ai][bj][m][1];
#pragma unroll
                for (int e = 0; e < 4; ++e) { v0[e] = gelu_tanh(v0[e]); v1[e] = gelu_tanh(v1[e]); }
                *(u32x4*)(gbuf + (size_t)(row * 16 + j) * DS5 + u.z * 32 + 8 * fq) = pack8(v0, v1); }
        EPI_ROWS_END
    }
};
struct EpiGlu {
    static constexpr bool PERM = true, AFTER_DRAIN = false, TWO_PART = false;
    const bf16_t* gbuf; const float* bglu; bf16_t* mix; float* ssqb;
    __device__ __forceinline__ void operator()(const f32x4 (&acc)[2][2][4][2], const Unit& u, int wr, int wc, int fr, int fq) const {
        const int colt = u.pn * BM + wc * 32 + 8 * fq;
        EPI_ROWS_BEGIN
            float sum = 0.f;
#pragma unroll
            for (int bj = 0; bj < 2; ++bj) { const int col = colt + bj * HALF; const u32x4 gw = *(const u32x4*)(gbuf + (size_t)row * DS5 + col);
                const f32x4 b0 = *(const f32x4*)(bglu + col), b1 = *(const f32x4*)(bglu + col + 4);
                f32x4 v0 = acc[ai][bj][m][0] + b0, v1 = acc[ai][bj][m][1] + b1;
                v0[0] = bflo(gw.x) * sigmoidf_(v0[0]); v0[1] = bfhi(gw.x) * sigmoidf_(v0[1]); v0[2] = bflo(gw.y) * sigmoidf_(v0[2]); v0[3] = bfhi(gw.y) * sigmoidf_(v0[3]);
                v1[0] = bflo(gw.z) * sigmoidf_(v1[0]); v1[1] = bfhi(gw.z) * sigmoidf_(v1[1]); v1[2] = bflo(gw.w) * sigmoidf_(v1[2]); v1[3] = bfhi(gw.w) * sigmoidf_(v1[3]);
                sum += sq8(v0, v1);
                *(u32x4*)(mix + (size_t)row * DM + 1024 + col) = pack8(v0, v1); }
            sum = fq_sum(sum); if (fq == 0) atomicAdd(ssqb + row, sum);
        EPI_ROWS_END
    }
};
struct EpiOut {
    static constexpr bool PERM = true, AFTER_DRAIN = false, TWO_PART = true;
    const float* ssqa; const float* ssqb; const float* xp; const float* xs; float* x1; bf16_t* x1b; float* ssq1;
    __device__ __forceinline__ void operator()(f32x4 (&acc)[2][2][4][2], const Unit& u, int wr, int wc, int fr, int fq) const {
        const int colt = u.pn * BM + wc * 32 + 8 * fq;
        if (u.z == 0) {
            EPI_ROWS_BEGIN
                const float ra = ssqa[row] * (1.f / DLRU) + EPS, rb = ssqb[row] * (1.f / DS5) + EPS, ratio = sqrtf(rb / ra);
#pragma unroll
                for (int bj = 0; bj < 2; ++bj) { acc[ai][bj][m][0] = acc[ai][bj][m][0] * ratio; acc[ai][bj][m][1] = acc[ai][bj][m][1] * ratio; }
            EPI_ROWS_END
        } else {
            EPI_ROWS_BEGIN
                const float rb = 1.f / sqrtf(ssqb[row] * (1.f / DS5) + EPS);
                const float* xr = (row < MP) ? xp + (size_t)row * DM : xs + (size_t)(row - MP) * DM;
                float sum = 0.f;
#pragma unroll
                for (int bj = 0; bj < 2; ++bj) { const int col = colt + bj * HALF;
                    const f32x4 v0 = *(const f32x4*)(xr + col) + acc[ai][bj][m][0] * rb, v1 = *(const f32x4*)(xr + col + 4) + acc[ai][bj][m][1] * rb;
                    *(u32x4*)(x1b + (size_t)row * DM + col) = pack8(v0, v1);
                    sum += sq8(v0, v1); }
                sum = fq_sum(sum); if (fq == 0) atomicAdd(ssq1 + row, sum);
            EPI_ROWS_END
        }
    }
};
struct EpiUp {
    static constexpr bool PERM = true, AFTER_DRAIN = false, TWO_PART = false;
    const float* ssq1; bf16_t* h;
    __device__ __forceinline__ void operator()(const f32x4 (&acc)[2][2][4][2], const Unit& u, int wr, int wc, int fr, int fq) const {
        const int colt = u.pn * BM + wc * 32 + 8 * fq;
        EPI_ROWS_BEGIN
            const float rs = 1.f / sqrtf(ssq1[row] * (1.f / DM) + EPS);
#pragma unroll
            for (int bj = 0; bj < 2; ++bj) { f32x4 v0 = acc[ai][bj][m][0] * rs, v1 = acc[ai][bj][m][1] * rs;
#pragma unroll
                for (int e = 0; e < 4; ++e) { const float a = fmaxf(v0[e], 0.f), b = fmaxf(v1[e], 0.f); v0[e] = a * a; v1[e] = b * b; }
                *(u32x4*)(h + (size_t)row * DFF + colt + bj * HALF) = pack8(v0, v1); }
        EPI_ROWS_END
    }
};
struct EpiDown {
    static constexpr bool PERM = true, AFTER_DRAIN = false, TWO_PART = false;
    float* x; const bf16_t* x1b; float mul;
    __device__ __forceinline__ void operator()(const f32x4 (&acc)[2][2][4][2], const Unit& u, int wr, int wc, int fr, int fq) const {
        const int colt = u.pn * BM + wc * 32 + 8 * fq;
        EPI_ROWS_BEGIN
#pragma unroll
            for (int bj = 0; bj < 2; ++bj) { float* p = x + (size_t)row * DM + colt + bj * HALF; const u32x4 w = *(const u32x4*)(x1b + (size_t)row * DM + colt + bj * HALF);
                const f32x4 v0 = (f32x4){bflo(w.x), bfhi(w.x), bflo(w.y), bfhi(w.y)} + acc[ai][bj][m][0] * mul, v1 = (f32x4){bflo(w.z), bfhi(w.z), bflo(w.w), bfhi(w.w)} + acc[ai][bj][m][1] * mul;
                (void)p; *(u32x4*)((bf16_t*)(x + (size_t)row * DM) + colt + bj * HALF) = pack8(v0, v1); }
        EPI_ROWS_END
    }
};
struct EpiPart {
    static constexpr bool PERM = true, AFTER_DRAIN = false, TWO_PART = false;
    float* P0; float* P1; int nsl;
    __device__ __forceinline__ void operator()(const f32x4 (&acc)[2][2][4][2], const Unit& u, int wr, int wc, int fr, int fq) const {
        const int t = ((u.pm - 32) * 8 + u.pn) * nsl + u.z, half = 8 * nsl;
        float* base = (t < half ? P0 + (size_t)t * 65536 : P1 + (size_t)(t - half) * 65536) + wc * 32 + 8 * fq;
        const int row0 = wr * 64 + fr;
#pragma unroll
        for (int ai = 0; ai < 2; ++ai)
#pragma unroll
            for (int m = 0; m < 4; ++m) { const int row = row0 + ai * HALF + m * 16;
#pragma unroll
                for (int bj = 0; bj < 2; ++bj) { float* p = base + row * 256 + bj * HALF; *(f32x4*)p = acc[ai][bj][m][0]; *(f32x4*)(p + 4) = acc[ai][bj][m][1]; } }
    }
};
struct EpiPartB {
    static constexpr bool PERM = true, AFTER_DRAIN = false, TWO_PART = false;
    bf16_t* P0; bf16_t* P1; int nsl;
    __device__ __forceinline__ void operator()(const f32x4 (&acc)[2][2][4][2], const Unit& u, int wr, int wc, int fr, int fq) const {
        const int t = ((u.pm - 32) * 8 + u.pn) * nsl + u.z, half = 8 * nsl;
        bf16_t* base = (t < half ? P0 + (size_t)t * 65536 : P1 + (size_t)(t - half) * 65536) + wc * 32 + 8 * fq;
        const int row0 = wr * 64 + fr;
#pragma unroll
        for (int ai = 0; ai < 2; ++ai)
#pragma unroll
            for (int m = 0; m < 4; ++m) { const int row = row0 + ai * HALF + m * 16;
#pragma unroll
                for (int bj = 0; bj < 2; ++bj) *(u32x4*)(base + row * 256 + bj * HALF) = pack8(acc[ai][bj][m][0], acc[ai][bj][m][1]); }
    }
};
struct SliceOrder {
    int c, nsl, G;
    __device__ bool next(int i, Unit& u) const { const int L = i * G + c; if (L >= 16 * nsl) return false; const int j = L / nsl; u.pm = 32 + (j >> 3); u.pn = j & 7; u.z = L - j * nsl; return true; }
    __device__ __forceinline__ void a_ready(const Unit&) const {}
    __device__ __forceinline__ void done(const Unit&) const {}
};
}

#define XB_TMO      128
#define XB_XCNT(j)  (256  + 64 * (j))
#define XB_XSUB(j)  (1280 + 64 * (j))
#define XB_XGEN(j)  (2304 + 64 * (j))
#define XB_TOP      3328
#define XB_TOPGEN   3392
#define XCD_BAR_WORDS 3456
#define XB_SPIN_CAP (1u << 18)

__device__ __forceinline__ unsigned xb_ld(unsigned* p)              { return __hip_atomic_load(p, __ATOMIC_RELAXED, __HIP_MEMORY_SCOPE_AGENT); }
__device__ __forceinline__ unsigned xb_add(unsigned* p, unsigned v) { return __hip_atomic_fetch_add(p, v, __ATOMIC_RELAXED, __HIP_MEMORY_SCOPE_AGENT); }
__device__ __forceinline__ unsigned xb_xcc_id() { return (unsigned)__builtin_amdgcn_s_getreg((3 << 11) | 20) & 0xFu; }
#define XB_SPIN(cond, bar) do { unsigned _sp = 0; while (cond) { __builtin_amdgcn_s_sleep(1); \
    if ((++_sp & 255u) == 0u) { if (xb_ld(&(bar)[XB_TMO])) break; if (_sp > XB_SPIN_CAP) { atomicAdd(&(bar)[XB_TMO], 1u); break; } } } } while (0)

struct XcdBarrier {
    unsigned* bar; unsigned x;
    volatile LAS unsigned* st;
};

__device__ __forceinline__ XcdBarrier xcd_barrier_post(unsigned* bar, volatile LAS unsigned* st) {
    XcdBarrier b; b.bar = bar; b.x = xb_xcc_id(); b.st = st;
    if (threadIdx.x == 0) (void)xb_add(&bar[XB_XCNT(b.x)], 1u);
    return b;
}
__device__ __forceinline__ void xcd_barrier_complete(unsigned* bar, unsigned x, unsigned& nloc, unsigned& nx) {
    const unsigned G = gridDim.x * gridDim.y * gridDim.z;
    unsigned sum, cnt, mine, sp = 0u;
    for (;;) {
        sum = 0u; cnt = 0u; mine = 0u;
#pragma unroll
        for (unsigned j = 0; j < 16; ++j) { const unsigned c = xb_ld(&bar[XB_XCNT(j)]); sum += c; cnt += (c > 0u) ? 1u : 0u; mine = (j == x) ? c : mine; }
        if (sum == G) break;
        __builtin_amdgcn_s_sleep(1);
        if ((++sp & 255u) == 0u) { if (xb_ld(&bar[XB_TMO])) break; if (sp > XB_SPIN_CAP) { atomicAdd(&bar[XB_TMO], 1u); break; } }
    }
    nloc = mine > 0u ? mine : 1u; nx = cnt > 0u ? cnt : 1u;
}

__device__ __forceinline__ void xcd_barrier(const XcdBarrier& b) {
    asm volatile("s_waitcnt vmcnt(0)" ::: "memory");
    __syncthreads();
    if (threadIdx.x == 0) {
        unsigned* bar = b.bar;
        __builtin_amdgcn_s_waitcnt(0);
        unsigned nloc = b.st[0], nx = b.st[1];
        if (nloc == 0u) { xcd_barrier_complete(bar, b.x, nloc, nx); b.st[0] = nloc; b.st[1] = nx; }
        const unsigned old = xb_add(&bar[XB_XSUB(b.x)], 1u);
        const unsigned gen = old / nloc;
        if (old + 1u == (gen + 1u) * nloc) {
            __builtin_amdgcn_fence(__ATOMIC_RELEASE, "agent");
            asm volatile("s_waitcnt vmcnt(0)" ::: "memory");
            const unsigned og = xb_add(&bar[XB_TOP], 1u);
            const unsigned tg = og / nx;
            if (og + 1u == (tg + 1u) * nx) xb_add(&bar[XB_TOPGEN], 1u);
            else XB_SPIN(xb_ld(&bar[XB_TOPGEN]) == tg, bar);
            __builtin_amdgcn_fence(__ATOMIC_ACQUIRE, "agent");
            xb_add(&bar[XB_XGEN(b.x)], 1u);
            asm volatile("s_waitcnt vmcnt(0)" ::: "memory");
        } else {
            XB_SPIN(xb_ld(&bar[XB_XGEN(b.x)]) == gen, bar);
            __builtin_amdgcn_fence(__ATOMIC_ACQUIRE, "agent");
            asm volatile("s_waitcnt vmcnt(0)" ::: "memory");
        }
    }
    __syncthreads();
}


struct Args { const float* in[32]; float* out; unsigned char* ws; int ph_lo, ph_hi; };
struct Frame {
    LAS unsigned char* lds;
    int tid, lane, wave, G, bid;
    float* out; unsigned char* ws;
};
constexpr int PTR_OFF = MISC_OFF + 256;
__device__ __forceinline__ const float* inp(const Frame& F, int i) {
    const LAS unsigned* T = (const LAS unsigned*)(F.lds + PTR_OFF);
    const unsigned lo = __builtin_amdgcn_readfirstlane(T[2 * i]), hi = __builtin_amdgcn_readfirstlane(T[2 * i + 1]);
    return (const float*)(((unsigned long long)hi << 32) | lo);
}
enum { I_XP = 0, I_XS, I_SCONV, I_SLRU, I_SRE, I_SIM, I_NMIX, I_WIN, I_CONVW, I_CONVB, I_WGA, I_BGA, I_WGX, I_BGX, I_LAMBDA, I_ARE, I_AIM, I_LOGSTEP, I_BRE, I_BIM, I_CRE, I_CIM,
       I_D, I_WGLU, I_BGLU, I_NOUTA, I_NOUTB, I_WOUT, I_NMLP, I_WUP, I_WDOWN, I_NFINAL };

__device__ __forceinline__ void tr_item(const float* __restrict__ W, const float* __restrict__ sc, int K, int N, bf16* __restrict__ WT, int item, int wave, int lane) {
    const int nblk = N >> 8, kb = item / nblk, nb = item - kb * nblk, k0 = kb * 64 + wave * 8, n0 = nb * 256 + 4 * lane;
    f32x4 v[8];
#pragma unroll
    for (int j = 0; j < 8; ++j) v[j] = __builtin_nontemporal_load((const f32x4*)(W + (size_t)(k0 + j) * N + n0));
    if (sc) {
#pragma unroll
        for (int j = 0; j < 8; ++j) v[j] = v[j] * sc[k0 + j];
    }
#pragma unroll
    for (int e = 0; e < 4; ++e) { v4u o; o.x = pk2(v[0][e], v[1][e]); o.y = pk2(v[2][e], v[3][e]); o.z = pk2(v[4][e], v[5][e]); o.w = pk2(v[6][e], v[7][e]);
        *(v4u*)(WT + (size_t)(n0 + e) * K + k0) = o; }
}
__device__ __forceinline__ void tr_items_dyn(Frame& F, const float* W, const float* sc, int K, int N, bf16* WT, unsigned* counter, const float* sc_hi = nullptr) {
    LAS int* slot = (LAS int*)(F.lds + MISC_OFF + 64);
    const int nitems = (K >> 6) * (N >> 8);
    for (;;) {
        if (F.tid == 0) *slot = (int)atomicAdd(counter, 1u);
        __syncthreads();
        const int it = *slot;
        __syncthreads();
        if (it >= nitems) break;
        tr_item(W, (sc_hi && (it / (N >> 8)) >= 16) ? sc_hi - 1024 : sc, K, N, WT, it, F.wave, F.lane);
    }
}
__device__ __forceinline__ void p0_x_row(const float* xrow, bf16* orow, float* rs, int lane) {
    const f32x4* xr = (const f32x4*)xrow + lane; f32x4 v[8]; float s = 0.f;
#pragma unroll
    for (int j = 0; j < 8; ++j) { v[j] = xr[64 * j]; s += (v[j].x * v[j].x + v[j].y * v[j].y) + (v[j].z * v[j].z + v[j].w * v[j].w); }
    s = wave_sum(s);
    if (lane == 0) *rs = 1.f / sqrtf(s * (1.f / DM) + EPS);
    v2u* o8 = (v2u*)orow + lane;
#pragma unroll
    for (int j = 0; j < 8; ++j) { v2u w; w.x = pk2(v[j].x, v[j].y); w.y = pk2(v[j].z, v[j].w); o8[64 * j] = w; }
}
__device__ __forceinline__ void p0_x_row(const float* xrow, bf16* orow, float* rs, int lane);
__device__ __forceinline__ void p0_s5_group(Frame& F, int g, int part, bool xrows) {
    const float* are = inp(F, I_ARE) + g * 64; const float* aim = inp(F, I_AIM) + g * 64;
    const float* bre = inp(F, I_BRE) + g * 1024; const float* bim = inp(F, I_BIM) + g * 1024;
    const float* cre = inp(F, I_CRE) + g * 1024; const float* cim = inp(F, I_CIM) + g * 1024;
    const float* dd = inp(F, I_D) + g * 16;
    LAS float* Ere = (LAS float*)F.lds;
    LAS float* Eim = Ere + 17 * 64;
    LAS float* Bre = Eim + 17 * 64;
    LAS float* Bim = Bre + 1024;
    LAS float* Cre = Bim + 1024;
    LAS float* Cim = Cre + 1024;
    LAS float* Kt = Cim + 1024;
    const int tid = F.tid;
    const double dt = exp((double)inp(F, I_LOGSTEP)[g]);
    if (tid < 64) {
        const int p = tid; const double lr = (double)are[p], li = (double)aim[p];
        double s1, c1; sincos_d(li * dt, s1, c1); const double mg = exp(lr * dt); const double e1r = mg * c1, e1i = mg * s1;
        double er = 1.0, ei = 0.0;
        for (int k = 0; k <= 16; ++k) { Ere[k * 64 + p] = (float)er; Eim[k * 64 + p] = (float)ei; const double nr = er * e1r - ei * e1i, ni = er * e1i + ei * e1r; er = nr; ei = ni; }
        const double nr_ = e1r - 1.0, ni_ = e1i, den = lr * lr + li * li; const double fr_ = (nr_ * lr + ni_ * li) / den, fi_ = (ni_ * lr - nr_ * li) / den;
        if (part == 0) { float* e1 = (float*)(F.ws + SM_E1) + (g * 64 + p) * 2; e1[0] = (float)e1r; e1[1] = (float)e1i;
        float* e16 = (float*)(F.ws + SM_E16) + (g * 64 + p) * 2; e16[0] = Ere[16 * 64 + p]; e16[1] = Eim[16 * 64 + p]; }
        float* bb = (float*)(F.ws + SM_BBAR) + (size_t)(g * 64 + p) * 32;
        for (int c = 0; c < 16; ++c) { const double br = (double)bre[p * 16 + c], bi = (double)bim[p * 16 + c]; const float xr = (float)(fr_ * br - fi_ * bi), xi = (float)(fr_ * bi + fi_ * br);
            Bre[p * 16 + c] = xr; Bim[p * 16 + c] = xi; if (part == 0) { bb[2 * c] = xr; bb[2 * c + 1] = xi; } }
    }
    for (int i = tid; i < 1024; i += NTHR) { Cre[i] = cre[i]; Cim[i] = cim[i]; }
    if (xrows && F.wave > 0) {
        bf16* XB = (bf16*)(F.ws + WS_XB); float* rs0 = (float*)(F.ws + SM_RS0);
        for (int m = F.bid * 7 + (F.wave - 1); m < MT; m += F.G * 7) { const float* xr = (m < MP) ? inp(F, I_XP) + (size_t)m * DM : inp(F, I_XS) + (size_t)(m - MP) * DM; p0_x_row(xr, XB + (size_t)m * DM, rs0 + m, F.lane); }
    }
    __syncthreads();
    for (int e = tid; e < 1024; e += NTHR) { const int d = e >> 6, co = 4 * part + ((e >> 4) & 3), ci = e & 15; float acc = 0.f;
        for (int p = 0; p < 64; ++p) { const float cr = Cre[co * 64 + p], ci_ = Cim[co * 64 + p], er = Ere[d * 64 + p], ei = Eim[d * 64 + p], br = Bre[p * 16 + ci], bi = Bim[p * 16 + ci];
            const float wr_ = cr * er - ci_ * ei, wi_ = cr * ei + ci_ * er; acc += wr_ * br - wi_ * bi; }
        if (d == 0 && co == ci) acc += dd[co];
        Kt[e] = acc; }
    __syncthreads();
    const int z = g >> 1, gl = g & 1;
    bf16* KG = (bf16*)(F.ws + WS_KG) + (size_t)z * 512 * 768;
    for (int it = tid; it < 64 * 96; it += NTHR) { const int rr = it / 96, kc = it % 96; const int j = rr >> 2, col = rr & 3, co = 4 * part + col, n = j * 32 + gl * 16 + co, k0 = kc * 8; float v[8];
#pragma unroll
        for (int e = 0; e < 8; ++e) { const int k = k0 + e; float x = 0.f;
            if (k < 512) { const int i = k >> 5, glk = (k >> 4) & 1, ci = k & 15; if (glk == gl && j >= i) x = Kt[((j - i) * 4 + col) * 16 + ci]; }
            else { const int kk = k - 512, glk = kk >> 7, q = kk & 127, p = q & 63; if (glk == gl) { const float cr = Cre[co * 64 + p], ci_ = Cim[co * 64 + p], er = Ere[(j + 1) * 64 + p], ei = Eim[(j + 1) * 64 + p];
                    x = (q < 64) ? (cr * er - ci_ * ei) : -(cr * ei + ci_ * er); } }
            v[e] = x; }
        v4u o; o.x = pk2(v[0], v[1]); o.y = pk2(v[2], v[3]); o.z = pk2(v[4], v[5]); o.w = pk2(v[6], v[7]);
        *(v4u*)(KG + (size_t)n * 768 + k0) = o; }
    bf16* M1 = (bf16*)(F.ws + WS_M1) + (size_t)z * 256 * 512;
    for (int it = tid; it < 32 * 64; it += NTHR) { const int q = 32 * part + (it >> 6), kc = it & 63, n = gl * 128 + q, p = q & 63, k0 = kc * 8; float v[8];
#pragma unroll
        for (int e = 0; e < 8; ++e) { const int k = k0 + e, i = k >> 5, glk = (k >> 4) & 1, ch = k & 15; float x = 0.f;
            if (glk == gl) { const float er = Ere[(15 - i) * 64 + p], ei = Eim[(15 - i) * 64 + p], br = Bre[p * 16 + ch], bi = Bim[p * 16 + ch]; x = (q < 64) ? (er * br - ei * bi) : (er * bi + ei * br); }
            v[e] = x; }
        v4u o; o.x = pk2(v[0], v[1]); o.y = pk2(v[2], v[3]); o.z = pk2(v[4], v[5]); o.w = pk2(v[6], v[7]);
        *(v4u*)(M1 + (size_t)n * 512 + k0) = o; }
    __syncthreads();
}

#ifndef P0_MASK
#define P0_MASK 7
#endif
__device__ __forceinline__ void p0_prologue(Frame& F, int mask) {
    bf16* WinT = (bf16*)(F.ws + WS_WIN);
    const bool xfused = (F.G == 256) && ((mask & 5) == 5);
    if (mask & 1) for (int it = F.bid; it < 256; it += F.G) p0_s5_group(F, it >> 2, it & 3, xfused);
    constexpr int I_1 = (DM / 64) * (NZ / 256);
    if (mask & 2) for (int it = F.bid; it < I_1; it += F.G) tr_item(inp(F, I_WIN), inp(F, I_NMIX), DM, NZ, WinT, it, F.wave, F.lane);
    const int gw = F.bid * NWAVES + F.wave, NGW = F.G * NWAVES;
    bf16* XB = (bf16*)(F.ws + WS_XB); float* rs0 = (float*)(F.ws + SM_RS0);
    if ((mask & 4) && !xfused) for (int m = gw; m < MT; m += NGW) { const float* xr = (m < MP) ? inp(F, I_XP) + (size_t)m * DM : inp(F, I_XS) + (size_t)(m - MP) * DM; p0_x_row(xr, XB + (size_t)m * DM, rs0 + m, F.lane); }
    bf16* WGA = (bf16*)(F.ws + SM_WGA); bf16* WGX = (bf16*)(F.ws + SM_WGX);
    for (int e = F.bid * NTHR + F.tid; e < DLRU; e += F.G * NTHR) ((float*)(F.ws + SM_SP))[e] = log1pf(__expf(-inp(F, I_LAMBDA)[e]));
    for (int e = F.bid * NTHR + F.tid; e < 65536; e += F.G * NTHR) { const int h = e >> 12, j = (e >> 6) & 63, i = e & 63; WGA[e] = (bf16)f2bf(inp(F, I_WGA)[(h * 64 + i) * 64 + j]); WGX[e] = (bf16)f2bf(inp(F, I_WGX)[(h * 64 + i) * 64 + j]); }
}

__device__ __forceinline__ void s5_sample_item(Frame& F, int item) {
    const int g = item >> 5, sq0 = (item & 31) * 4, lane = F.lane, p = lane;
    LAS float* hs = (LAS float*)(F.lds + F.wave * 2048);
    const float* e1 = (const float*)(F.ws + SM_E1) + (g * 64 + p) * 2; const float ar = e1[0], ai = e1[1];
    const float* bb = (const float*)(F.ws + SM_BBAR) + (size_t)(g * 64 + p) * 32;
    float br[16], bi[16];
#pragma unroll
    for (int c = 0; c < 16; ++c) { br[c] = bb[2 * c]; bi[c] = bb[2 * c + 1]; }
    const int cc = lane & 15, part = lane >> 4;
    float cr[16], ci[16];
#pragma unroll
    for (int j = 0; j < 16; ++j) { cr[j] = inp(F, I_CRE)[(g * 16 + cc) * 64 + part * 16 + j]; ci[j] = inp(F, I_CIM)[(g * 16 + cc) * 64 + part * 16 + j]; }
    const float dv = inp(F, I_D)[g * 16 + cc];
    const bf16* us = (const bf16*)(F.ws + WS_US); bf16* gbuf = (bf16*)((unsigned char*)F.out + DO_G);
    float bur[16], bui[16], ucc[16];
#pragma unroll
    for (int t = 0; t < 16; ++t) { const int tok = sq0 * 4 + t;
        const v4u u0 = *(const v4u*)(us + (size_t)tok * DS5 + g * 16), u1 = *(const v4u*)(us + (size_t)tok * DS5 + g * 16 + 8);
        float uf[16]; uf[0] = bflo(u0.x); uf[1] = bfhi(u0.x); uf[2] = bflo(u0.y); uf[3] = bfhi(u0.y); uf[4] = bflo(u0.z); uf[5] = bfhi(u0.z); uf[6] = bflo(u0.w); uf[7] = bfhi(u0.w);
        uf[8] = bflo(u1.x); uf[9] = bfhi(u1.x); uf[10] = bflo(u1.y); uf[11] = bfhi(u1.y); uf[12] = bflo(u1.z); uf[13] = bfhi(u1.z); uf[14] = bflo(u1.w); uf[15] = bfhi(u1.w);
        float a = 0.f, b = 0.f;
#pragma unroll
        for (int c = 0; c < 16; ++c) { a += br[c] * uf[c]; b += bi[c] * uf[c]; }
        bur[t] = a; bui[t] = b; ucc[t] = bf2f(us[(size_t)tok * DS5 + g * 16 + cc]); }
    float hr[4], hi[4];
#pragma unroll
    for (int q = 0; q < 4; ++q) { hr[q] = inp(F, I_SRE)[((sq0 + q) * 64 + g) * 64 + p]; hi[q] = inp(F, I_SIM)[((sq0 + q) * 64 + g) * 64 + p]; }
#pragma unroll
    for (int s = 0; s < 4; ++s) {
#pragma unroll
        for (int q = 0; q < 4; ++q) { const int t = q * 4 + s; const float nr = ar * hr[q] - ai * hi[q] + bur[t], ni = ar * hi[q] + ai * hr[q] + bui[t]; hr[q] = nr; hi[q] = ni;
            hs[q * 128 + p] = nr; hs[q * 128 + 64 + p] = ni; }
        LDS_WAIT();
#pragma unroll
        for (int q = 0; q < 4; ++q) { float y = 0.f;
#pragma unroll
            for (int j = 0; j < 16; ++j) y += cr[j] * hs[q * 128 + part * 16 + j] - ci[j] * hs[q * 128 + 64 + part * 16 + j];
            y += __shfl_xor(y, 16); y += __shfl_xor(y, 32);
            y += dv * ucc[q * 4 + s];
            if (lane < 16) gbuf[(size_t)(MP + sq0 * 4 + q * 4 + s) * DS5 + g * 16 + cc] = (bf16)f2bf(gelu_tanh(y)); }
        LDS_WAIT();
    }
#pragma unroll
    for (int q = 0; q < 4; ++q) { F.out[O_RES + (size_t)((sq0 + q) * 64 + g) * 64 + p] = hr[q]; F.out[O_IMS + (size_t)((sq0 + q) * 64 + g) * 64 + p] = hi[q]; }
}

constexpr int LW_XS = 0, LW_XC = 4864, LW_XF = 7168, LW_AB = 11264, LW_BYTES = 16384;
struct LruPre { f32x4 xs[5]; float hin; };
__device__ __forceinline__ void lruw_load(Frame& F, int hd, int idx, int pass, LruPre& R) {
    const int lane = F.lane; const bool sample = idx >= 512;
    const int gc = idx, b = gc >> 7, c = gc & 127, tok0 = sample ? MP + 16 * (idx - 512) : 16 * gc, cgl = hd * 64 + lane;
    const float* xlru = (const float*)((unsigned char*)F.out + DO_XLRU);
#pragma unroll
    for (int k = 0; k < 5; ++k) { const int i = lane + 64 * k, r = i >> 4, q = i & 15, t = c * 16 - 3 + r; f32x4 v = {0.f, 0.f, 0.f, 0.f};
        if (!sample && i < 19 * 16 && t >= 0) v = *(const f32x4*)(xlru + (size_t)(b * SEQ + t) * DLRU + hd * 64 + 4 * q);
        R.xs[k] = v; }
    R.hin = 0.f;
    if (pass == 2) {
        if (!sample) R.hin = ((const float*)(F.ws + WS_HIN))[(size_t)gc * DLRU + cgl];
    }
}
#ifndef LRU_MODE
#define LRU_MODE 0
#endif
__device__ __forceinline__ void lruw_tile(Frame& F, int hd, int idx, int pass, float* ssqa_p, const LruPre& R, int mode = 0) {
    const int lane = F.lane;
    const bool sample = idx >= 512;
    const int gc = idx, b = gc >> 7, c = gc & 127, sb = idx - 512;
    const int tok0 = sample ? MP + 16 * sb : 16 * gc, cgl = hd * 64 + lane;
    const float* xlru = (const float*)((unsigned char*)F.out + DO_XLRU);
    bf16* mix = (bf16*)(F.ws + WS_MIX);
    LAS unsigned char* wl = F.lds + F.wave * LW_BYTES;
    LAS float* XS = (LAS float*)(wl + LW_XS); LAS bf16* XC = (LAS bf16*)(wl + LW_XC); LAS float* XF = (LAS float*)(wl + LW_XF); LAS float* AB = (LAS float*)(wl + LW_AB);
    const float* cw = inp(F, I_CONVW); const float* cb = inp(F, I_CONVB);
    const int fr = lane & 15, fq = lane >> 4;
    const bf16* WGA = (const bf16*)(F.ws + SM_WGA) + hd * 4096; const bf16* WGX = (const bf16*)(F.ws + SM_WGX) + hd * 4096;
    float vbga[4], vbgx[4], vsp[4];
#pragma unroll
    for (int nt = 0; nt < 4; ++nt) { const int ch = nt * 16 + fr; vbga[nt] = inp(F, I_BGA)[hd * 64 + ch]; vbgx[nt] = inp(F, I_BGX)[hd * 64 + ch]; vsp[nt] = ((const float*)(F.ws + SM_SP))[hd * 64 + ch]; }
    const int qc = lane & 15;
    f32x4 cwv[4], cbv = *(const f32x4*)(cb + hd * 64 + 4 * qc);
#pragma unroll
    for (int kk = 0; kk < 4; ++kk) cwv[kk] = *(const f32x4*)(cw + kk * DLRU + hd * 64 + 4 * qc);
    float h = R.hin, h0v[4], gvv[16];
#pragma unroll
    for (int q = 0; q < 4; ++q) h0v[q] = (pass == 2 && sample) ? inp(F, I_SLRU)[(size_t)(sb * 4 + q) * DLRU + cgl] : 0.f;
    if (pass == 2) { const bf16* glru = (const bf16*)((unsigned char*)F.out + DO_GLRU);
#pragma unroll
        for (int s = 0; s < 16; ++s) gvv[s] = bf2f(glru[(size_t)(tok0 + s) * DLRU + cgl]); }
    if (!sample) {
#pragma unroll
        for (int k = 0; k < 5; ++k) { const int i = lane + 64 * k; if (i < 19 * 16) { const int r = i >> 4, q = i & 15; *(LAS f32x4*)(XS + r * 64 + 4 * q) = R.xs[k]; } }
        LDS_WAIT();
#pragma unroll
        for (int k = 0; k < 4; ++k) { const int i = lane + 64 * k, t = i >> 4, q = i & 15;
            f32x4 a = cbv;
#pragma unroll
            for (int kk = 0; kk < 4; ++kk) a += cwv[kk] * *(LAS f32x4*)(XS + (t + kk) * 64 + 4 * q);
            *(LAS f32x4*)(XF + t * 64 + 4 * q) = a; v2u pk; pk.x = pk2(a.x, a.y); pk.y = pk2(a.z, a.w); *(LAS v2u*)(XC + t * 72 + 4 * q) = pk; }
    } else {
        const float* sconv = inp(F, I_SCONV);
#pragma unroll
        for (int k = 0; k < 4; ++k) { const int i = lane + 64 * k, t = i >> 4, q = i & 15, ch = hd * 64 + 4 * q, sq = sb * 4 + (t >> 2), s = t & 3;
            f32x4 a = cbv;
#pragma unroll
            for (int kk = 0; kk < 4; ++kk) { const int j = s + kk; const f32x4 xv = (j < 3) ? *(const f32x4*)(sconv + (size_t)(sq * 3 + j) * DLRU + ch) : *(const f32x4*)(xlru + (size_t)(MP + sq * 4 + j - 3) * DLRU + ch);
                a += cwv[kk] * xv; }
            *(LAS f32x4*)(XF + t * 64 + 4 * q) = a; v2u pk; pk.x = pk2(a.x, a.y); pk.y = pk2(a.z, a.w); *(LAS v2u*)(XC + t * 72 + 4 * q) = pk; }
    }
    bf16x8 wba0[4], wba1[4], wbx0[4], wbx1[4];
#pragma unroll
    for (int nt = 0; nt < 4; ++nt) { const int ch = nt * 16 + fr;
        wba0[nt] = *(const bf16x8*)(WGA + ch * 64 + fq * 8); wba1[nt] = *(const bf16x8*)(WGA + ch * 64 + 32 + fq * 8);
        wbx0[nt] = *(const bf16x8*)(WGX + ch * 64 + fq * 8); wbx1[nt] = *(const bf16x8*)(WGX + ch * 64 + 32 + fq * 8); }
    LDS_WAIT();
    {
        const bf16x8 a0 = *(LAS bf16x8*)(XC + fr * 72 + fq * 8), a1 = *(LAS bf16x8*)(XC + fr * 72 + 32 + fq * 8);
#pragma unroll
        for (int nt = 0; nt < 4; ++nt) {
            const int ch = nt * 16 + fr;
            f32x4 ga = {0.f, 0.f, 0.f, 0.f}, gx = {0.f, 0.f, 0.f, 0.f};
            ga = __builtin_amdgcn_mfma_f32_16x16x32_bf16(a0, wba0[nt], ga, 0, 0, 0); ga = __builtin_amdgcn_mfma_f32_16x16x32_bf16(a1, wba1[nt], ga, 0, 0, 0);
            gx = __builtin_amdgcn_mfma_f32_16x16x32_bf16(a0, wbx0[nt], gx, 0, 0, 0); gx = __builtin_amdgcn_mfma_f32_16x16x32_bf16(a1, wbx1[nt], gx, 0, 0, 0);
            const float bga = vbga[nt], bgx = vbgx[nt], sp = vsp[nt];
#pragma unroll
            for (int r = 0; r < 4; ++r) { const int t = fq * 4 + r; const float xc = XF[t * 64 + ch];
                const float rg = sigmoidf_(ga[r] + bga), ig = sigmoidf_(gx[r] + bgx), la = -8.f * rg * sp, av = __expf(la), x2 = 2.f * la;
                const float m1 = -x2 * (1.f + x2 * (0.5f + x2 * (0.16666667f + x2 * (0.041666668f + x2 * (0.0083333338f + x2 * 0.0013888889f)))));
                const float mult = __builtin_amdgcn_sqrtf((x2 > -0.25f) ? m1 : 1.f - __expf(x2));
                (void)av; XS[t * 64 + ch] = la; XF[t * 64 + ch] = mult * ig * xc; }
        }
    }
    LDS_WAIT();
    {
        bf16* LA = (bf16*)(F.ws + WS_XB); bf16* LB = LA + (size_t)MT * DLRU;
        float Ap = 1.f; unsigned lw[8], bw[8];
#pragma unroll
        for (int s = 0; s < 16; ++s) { const unsigned lab = f2bf(XS[s * 64 + lane]), bb = f2bf(XF[s * 64 + lane]);
            if (s & 1) { lw[s >> 1] |= lab << 16; bw[s >> 1] |= bb << 16; } else { lw[s >> 1] = lab; bw[s >> 1] = bb; }
            const float av = __expf(bf2f(lab)); h = av * h + bf2f(bb); Ap *= av; }
        { const size_t o = ((size_t)(idx * 16 + hd) * 64 + lane) * 16;
          *(v4u*)(LA + o) = (v4u){lw[0], lw[1], lw[2], lw[3]}; *(v4u*)(LA + o + 8) = (v4u){lw[4], lw[5], lw[6], lw[7]};
          *(v4u*)(LB + o) = (v4u){bw[0], bw[1], bw[2], bw[3]}; *(v4u*)(LB + o + 8) = (v4u){bw[4], bw[5], bw[6], bw[7]}; }
        if (!sample) { float* o = (float*)(F.ws + WS_AGG) + ((size_t)gc * DLRU + cgl) * 2; *(v2u*)o = (v2u){__builtin_bit_cast(unsigned, Ap), __builtin_bit_cast(unsigned, h)}; }
        LDS_WAIT();
    }
}
struct Lru2Pre { v4u la0, la1, lb0, lb1; float g[16]; float hin; };
__device__ __forceinline__ void lruw2_load(Frame& F, int hd, int idx, Lru2Pre& R) {
    const int lane = F.lane; const bool sample = idx >= 512;
    const int tok0 = sample ? MP + 16 * (idx - 512) : 16 * idx, cgl = hd * 64 + lane;
    const bf16* glru = (const bf16*)((unsigned char*)F.out + DO_GLRU);
    const bf16* LA = (const bf16*)(F.ws + WS_XB); const bf16* LB = LA + (size_t)MT * DLRU;
    const size_t o = ((size_t)(idx * 16 + hd) * 64 + lane) * 16;
    R.la0 = *(const v4u*)(LA + o); R.la1 = *(const v4u*)(LA + o + 8); R.lb0 = *(const v4u*)(LB + o); R.lb1 = *(const v4u*)(LB + o + 8);
#pragma unroll
    for (int s = 0; s < 16; ++s) R.g[s] = bf2f(glru[(size_t)(tok0 + s) * DLRU + cgl]);
    R.hin = sample ? 0.f : ((const float*)(F.ws + WS_HIN))[(size_t)idx * DLRU + cgl];
}
__device__ __forceinline__ void lruw2_tile(Frame& F, int hd, int idx, float* ssqa_p, const Lru2Pre& R) {
    const int lane = F.lane;
    const bool sample = idx >= 512;
    const int gc = idx, b = gc >> 7, c = gc & 127, sb = idx - 512;
    const int tok0 = sample ? MP + 16 * sb : 16 * gc, cgl = hd * 64 + lane;
    const float* xlru = (const float*)((unsigned char*)F.out + DO_XLRU);
    bf16* mix = (bf16*)(F.ws + WS_MIX);
    float lav[16], bvv[16], h0v[4];
    { const unsigned lw[8] = {R.la0.x, R.la0.y, R.la0.z, R.la0.w, R.la1.x, R.la1.y, R.la1.z, R.la1.w}, bw[8] = {R.lb0.x, R.lb0.y, R.lb0.z, R.lb0.w, R.lb1.x, R.lb1.y, R.lb1.z, R.lb1.w};
#pragma unroll
      for (int k = 0; k < 8; ++k) { lav[2 * k] = bflo(lw[k]); lav[2 * k + 1] = bfhi(lw[k]); bvv[2 * k] = bflo(bw[k]); bvv[2 * k + 1] = bfhi(bw[k]); } }
    float h = R.hin;
#pragma unroll
    for (int q = 0; q < 4; ++q) h0v[q] = sample ? inp(F, I_SLRU)[(size_t)(sb * 4 + q) * DLRU + cgl] : 0.f;
    float sq[16];
#pragma unroll
    for (int s = 0; s < 16; ++s) {
        if (sample && (s & 3) == 0) h = h0v[s >> 2];
        h = __expf(lav[s]) * h + bvv[s];
        const float o = h * gelu_tanh(R.g[s]);
        mix[(size_t)(tok0 + s) * DM + cgl] = (bf16)f2bf(o); sq[s] = o * o;
        if (sample && (s & 3) == 3) F.out[O_LRUS + (size_t)(sb * 4 + (s >> 2)) * DLRU + cgl] = h;
    }
    if (!sample && c == 127) { F.out[O_LRUP + (size_t)b * DLRU + cgl] = h;
#pragma unroll
        for (int j = 0; j < 3; ++j) F.out[O_CONVP + (size_t)(b * 3 + j) * DLRU + cgl] = xlru[(size_t)(b * SEQ + 2045 + j) * DLRU + cgl]; }
    if (sample) {
#pragma unroll
        for (int e = 0; e < 12; ++e) { const int sqn = sb * 4 + e / 3, j = e % 3; F.out[O_CONVS + (size_t)(sqn * 3 + j) * DLRU + cgl] = xlru[(size_t)(MP + sqn * 4 + 1 + j) * DLRU + cgl]; }
    }
    const bool b5 = lane & 32, b4 = lane & 16, b3 = lane & 8, b2 = lane & 4;
    float r8[8], r4[4], r2[2], r1;
#pragma unroll
    for (int k = 0; k < 8; ++k) { const float mine = b5 ? sq[8 + k] : sq[k], send = b5 ? sq[k] : sq[8 + k]; r8[k] = mine + __shfl_xor(send, 32); }
#pragma unroll
    for (int k = 0; k < 4; ++k) { const float mine = b4 ? r8[4 + k] : r8[k], send = b4 ? r8[k] : r8[4 + k]; r4[k] = mine + __shfl_xor(send, 16); }
#pragma unroll
    for (int k = 0; k < 2; ++k) { const float mine = b3 ? r4[2 + k] : r4[k], send = b3 ? r4[k] : r4[2 + k]; r2[k] = mine + __shfl_xor(send, 8); }
    { const float mine = b2 ? r2[1] : r2[0], send = b2 ? r2[0] : r2[1]; r1 = mine + __shfl_xor(send, 4); }
    r1 += __shfl_xor(r1, 1); r1 += __shfl_xor(r1, 2);
    if ((lane & 3) == 0) atomicAdd(ssqa_p + tok0 + ((lane >> 5) & 1) * 8 + ((lane >> 4) & 1) * 4 + ((lane >> 3) & 1) * 2 + ((lane >> 2) & 1), r1);
}
__device__ __forceinline__ void lruw_tiles(Frame& F, int pass, int nper, unsigned* counters, float* ssqa_p, int mode = 0) {
    const int hd = F.bid & 15; unsigned* cp = counters + 16 * hd;
    unsigned v0 = 0u, v1 = 0u; if (F.lane == 0) { v0 = atomicAdd(cp, 1u); v1 = atomicAdd(cp, 1u); }
    int t = (int)__builtin_amdgcn_readfirstlane(v0), nx = (int)__builtin_amdgcn_readfirstlane(v1);
    if (pass == 2) {
        Lru2Pre Q; if (t < nper) lruw2_load(F, hd, t, Q);
        while (t < nper) {
            unsigned v2 = 0u; if (F.lane == 0) v2 = atomicAdd(cp, 1u);
            Lru2Pre Qn; if (nx < nper) lruw2_load(F, hd, nx, Qn);
            lruw2_tile(F, hd, t, ssqa_p, Q);
            t = nx; Q = Qn; nx = (int)__builtin_amdgcn_readfirstlane(v2);
        }
        return;
    }
    LruPre R; if (t < nper) lruw_load(F, hd, t, pass, R);
    while (t < nper) {
        unsigned v2 = 0u; if (F.lane == 0) v2 = atomicAdd(cp, 1u);
        LruPre Rn; if (nx < nper) lruw_load(F, hd, nx, pass, Rn);
        lruw_tile(F, hd, t, pass, ssqa_p, R, mode);
        t = nx; R = Rn; nx = (int)__builtin_amdgcn_readfirstlane(v2);
    }
}

constexpr int NPHASE = 10;
#ifndef LRU_N4
#define LRU_N4 256
#endif
#ifndef DUP_PHASE
#define DUP_PHASE (-1)
#endif

__global__ void __launch_bounds__(NTHR, 2) fwd_megakernel(Args args) {
    extern __shared__ __attribute__((aligned(16))) unsigned char lds_raw[];
    cg::grid_group grid = cg::this_grid();
    Frame F; F.lds = (LAS unsigned char*)lds_raw; F.tid = threadIdx.x; F.lane = F.tid & 63; F.wave = __builtin_amdgcn_readfirstlane(F.tid >> 6); F.G = gridDim.x; F.bid = blockIdx.x;
    F.out = args.out; F.ws = args.ws;
    if (F.tid == 0) {
#pragma unroll
        for (int i = 0; i < 32; ++i) { const unsigned long long pv = (unsigned long long)args.in[i]; ((LAS unsigned*)(F.lds + PTR_OFF))[2 * i] = (unsigned)pv; ((LAS unsigned*)(F.lds + PTR_OFF))[2 * i + 1] = (unsigned)(pv >> 32); }
    }
    const int lo = args.ph_lo, hi = args.ph_hi;
    volatile LAS unsigned* MISC = (volatile LAS unsigned*)(F.lds + MISC_OFF);
    if (F.tid < 32) MISC[F.tid] = 0u;
    __syncthreads();
    if (lo > hi) grid.sync();
    XcdBarrier xbar = xcd_barrier_post((unsigned*)(args.ws + WS_CTL + CTL_BAR), MISC + 8);
#define IN(k) (lo <= (k) && (k) < hi)
#define SEAM(k) do { if (IN(k) && IN((k) + 1)) { xcd_barrier(xbar); } } while (0)
    unsigned char* ws = args.ws;
    bf16* WinT = (bf16*)(ws + WS_WIN); bf16* WgluT = (bf16*)(ws + WS_WGLU); bf16* WoutT = (bf16*)(ws + WS_WOUT); bf16* WupT = (bf16*)(ws + WS_WUP); bf16* WdownT = (bf16*)(ws + WS_WDOWN);
    bf16* XB = (bf16*)(ws + WS_XB); bf16* HB = (bf16*)(ws + WS_H); bf16* A2 = (bf16*)(ws + WS_A2); bf16* US = (bf16*)(ws + WS_US); bf16* MIX = (bf16*)(ws + WS_MIX);
    bf16* M1 = (bf16*)(ws + WS_M1); bf16* KG = (bf16*)(ws + WS_KG); float* SB = (float*)(ws + WS_S);
    float* ssqa = (float*)(ws + WS_CTL + CTL_SSQA); float* ssqb = (float*)(ws + WS_CTL + CTL_SSQB); float* ssq1 = (float*)(ws + WS_CTL + CTL_SSQ1); float* ssq2 = (float*)(ws + WS_CTL + CTL_SSQ2);
    unsigned* cnt = (unsigned*)(ws + WS_CTL + CTL_CNT); float* ssqd = (float*)(ws + WS_CTL + 320 * 1024);
    float* xlru = (float*)((unsigned char*)args.out + DO_XLRU); bf16* glru = (bf16*)((unsigned char*)args.out + DO_GLRU); bf16* gbuf = (bf16*)((unsigned char*)args.out + DO_G);

    if (IN(0)) {
        if (DUP_PHASE == 0) { constexpr bool dup = true; (void)dup; { p0_prologue(F, P0_MASK); } xcd_barrier(xbar); }
        { constexpr bool dup = false; (void)dup; { p0_prologue(F, 7); } }
    }
    SEAM(0);
    if (IN(1)) {
        if (DUP_PHASE == 1) { constexpr bool dup = true; (void)dup; { {
        pg8::Gemm g{XB, WinT, DM, DM, DM, 0, 0}; pg8::Order S; S.init(MT, NZ, 1, F.G, F.bid);
        pg8::EpiZ E{(const float*)(ws + SM_RS0), xlru, glru, A2, US};
        pg8::gemm_phase<pg8::EpiZ, pg8::Order, true, true>(F.lds, g, S, E);
        __syncthreads();
        if constexpr (!dup) { tr_items_dyn(F, inp(F, I_WGLU), nullptr, DS5, DS5, WgluT, cnt + 10);
          tr_items_dyn(F, inp(F, I_WUP), inp(F, I_NMLP), DM, DFF, WupT, cnt + 8); }
    } } xcd_barrier(xbar); }
        { constexpr bool dup = false; (void)dup; { {
        pg8::Gemm g{XB, WinT, DM, DM, DM, 0, 0}; pg8::Order S; S.init(MT, NZ, 1, F.G, F.bid);
        pg8::EpiZ E{(const float*)(ws + SM_RS0), xlru, glru, A2, US};
        pg8::gemm_phase<pg8::EpiZ, pg8::Order, true, true>(F.lds, g, S, E);
        __syncthreads();
        if constexpr (!dup) { tr_items_dyn(F, inp(F, I_WGLU), nullptr, DS5, DS5, WgluT, cnt + 10);
          tr_items_dyn(F, inp(F, I_WUP), inp(F, I_NMLP), DM, DFF, WupT, cnt + 8); }
    } } }
    }
    SEAM(1);
    if (IN(2)) {
        if (DUP_PHASE == 2) { constexpr bool dup = true; (void)dup; { {
        { pg8::Gemm g{A2, M1, A2_LD, 512, 512, (size_t)A2_ROWS * A2_LD, (size_t)256 * 512}; pg8::Order S; S.init(A2_ROWS, 256, NPAIR, F.G, F.bid);
          pg8::EpiS E{SB};
          pg8::gemm_phase<pg8::EpiS, pg8::Order, true, true>(F.lds, g, S, E); }
#ifdef SMP_REP
        if constexpr (!dup) { xcd_barrier(xbar); for (int it = F.bid * NWAVES + F.wave; it < 2048; it += F.G * NWAVES) s5_sample_item(F, it); xcd_barrier(xbar); }
#endif
        __syncthreads();
        lruw_tiles(F, 1, 544, cnt + (dup ? 1024 : 512), ssqa); __syncthreads();
    } } xcd_barrier(xbar); }
        { constexpr bool dup = false; (void)dup; { {
        { pg8::Gemm g{A2, M1, A2_LD, 512, 512, (size_t)A2_ROWS * A2_LD, (size_t)256 * 512}; pg8::Order S; S.init(A2_ROWS, 256, NPAIR, F.G, F.bid);
          pg8::EpiS E{SB};
          pg8::gemm_phase<pg8::EpiS, pg8::Order, true, true>(F.lds, g, S, E); }
#ifdef SMP_REP
        if constexpr (!dup) { xcd_barrier(xbar); for (int it = F.bid * NWAVES + F.wave; it < 2048; it += F.G * NWAVES) s5_sample_item(F, it); xcd_barrier(xbar); }
#endif
        __syncthreads();
        lruw_tiles(F, 1, 544, cnt + (dup ? 1024 : 512), ssqa); __syncthreads();
    } } }
    }
    SEAM(2);
    if (IN(3)) {
        if (DUP_PHASE == 3) { constexpr bool dup = true; (void)dup; { {
        for (int e = F.bid * 64 + F.tid; F.tid < 64 && e < NPAIR * NB * 128; e += F.G * 64) {
            const int z = e >> 9, b = (e >> 7) & 3, q = e & 127, gl = q >> 6, p = q & 63, g = z * 2 + gl;
            const float* e16 = (const float*)(ws + SM_E16) + (g * 64 + p) * 2; const float ar = e16[0], ai = e16[1];
            float hr = 0.f, hi = 0.f;
            const float* __restrict__ Sp = SB + ((size_t)z * A2_ROWS + b * NCH) * 256 + gl * 128 + p;
            bf16* __restrict__ Hp = A2 + ((size_t)z * A2_ROWS + b * NCH) * A2_LD + 512 + gl * 128 + p;
            for (int c0 = 0; c0 < NCH; c0 += 32) {
                float sr[32], si[32];
#pragma unroll
                for (int j = 0; j < 32; ++j) { sr[j] = Sp[(size_t)(c0 + j) * 256]; si[j] = Sp[(size_t)(c0 + j) * 256 + 64]; }
#pragma unroll
                for (int j = 0; j < 32; ++j) { Hp[(size_t)(c0 + j) * A2_LD] = (bf16)f2bf(hr); Hp[(size_t)(c0 + j) * A2_LD + 64] = (bf16)f2bf(hi);
                    const float nr = ar * hr - ai * hi + sr[j], ni = ar * hi + ai * hr + si[j]; hr = nr; hi = ni; }
            }
            args.out[O_REP + (size_t)(b * 64 + g) * 64 + p] = hr; args.out[O_IMP + (size_t)(b * 64 + g) * 64 + p] = hi;
        }
        for (int e = F.bid * 64 + (F.tid - 64); F.tid >= 64 && F.tid < 128 && e < NB * DLRU; e += F.G * 64) {
            const int b = e >> 10, chn = e & 1023;
            const float* __restrict__ ag = (const float*)(ws + WS_AGG) + ((size_t)(b * 128) * DLRU + chn) * 2; float* __restrict__ hn = (float*)(ws + WS_HIN) + (size_t)(b * 128) * DLRU + chn;
            float h = 0.f;
            for (int c0 = 0; c0 < 128; c0 += 32) {
                float aa[32], hh[32];
#pragma unroll
                for (int j = 0; j < 32; ++j) { aa[j] = ag[(size_t)(c0 + j) * DLRU * 2]; hh[j] = ag[(size_t)(c0 + j) * DLRU * 2 + 1]; }
#pragma unroll
                for (int j = 0; j < 32; ++j) { hn[(size_t)(c0 + j) * DLRU] = h; h = aa[j] * h + hh[j]; }
            }
        }
    } } xcd_barrier(xbar); }
        { constexpr bool dup = false; (void)dup; { {
        for (int e = F.bid * 64 + F.tid; F.tid < 64 && e < NPAIR * NB * 128; e += F.G * 64) {
            const int z = e >> 9, b = (e >> 7) & 3, q = e & 127, gl = q >> 6, p = q & 63, g = z * 2 + gl;
            const float* e16 = (const float*)(ws + SM_E16) + (g * 64 + p) * 2; const float ar = e16[0], ai = e16[1];
            float hr = 0.f, hi = 0.f;
            const float* __restrict__ Sp = SB + ((size_t)z * A2_ROWS + b * NCH) * 256 + gl * 128 + p;
            bf16* __restrict__ Hp = A2 + ((size_t)z * A2_ROWS + b * NCH) * A2_LD + 512 + gl * 128 + p;
            for (int c0 = 0; c0 < NCH; c0 += 32) {
                float sr[32], si[32];
#pragma unroll
                for (int j = 0; j < 32; ++j) { sr[j] = Sp[(size_t)(c0 + j) * 256]; si[j] = Sp[(size_t)(c0 + j) * 256 + 64]; }
#pragma unroll
                for (int j = 0; j < 32; ++j) { Hp[(size_t)(c0 + j) * A2_LD] = (bf16)f2bf(hr); Hp[(size_t)(c0 + j) * A2_LD + 64] = (bf16)f2bf(hi);
                    const float nr = ar * hr - ai * hi + sr[j], ni = ar * hi + ai * hr + si[j]; hr = nr; hi = ni; }
            }
            args.out[O_REP + (size_t)(b * 64 + g) * 64 + p] = hr; args.out[O_IMP + (size_t)(b * 64 + g) * 64 + p] = hi;
        }
        for (int e = F.bid * 64 + (F.tid - 64); F.tid >= 64 && F.tid < 128 && e < NB * DLRU; e += F.G * 64) {
            const int b = e >> 10, chn = e & 1023;
            const float* __restrict__ ag = (const float*)(ws + WS_AGG) + ((size_t)(b * 128) * DLRU + chn) * 2; float* __restrict__ hn = (float*)(ws + WS_HIN) + (size_t)(b * 128) * DLRU + chn;
            float h = 0.f;
            for (int c0 = 0; c0 < 128; c0 += 32) {
                float aa[32], hh[32];
#pragma unroll
                for (int j = 0; j < 32; ++j) { aa[j] = ag[(size_t)(c0 + j) * DLRU * 2]; hh[j] = ag[(size_t)(c0 + j) * DLRU * 2 + 1]; }
#pragma unroll
                for (int j = 0; j < 32; ++j) { hn[(size_t)(c0 + j) * DLRU] = h; h = aa[j] * h + hh[j]; }
            }
        }
    } } }
    }
    SEAM(3);
    if (IN(4)) {
        if (DUP_PHASE == 4) { constexpr bool dup = true; (void)dup; { {
        if constexpr (!dup) { pg8::Gemm g{A2, KG, A2_LD, 768, 768, (size_t)A2_ROWS * A2_LD, (size_t)512 * 768}; pg8::Order S; S.init(A2_ROWS, 512, NPAIR, F.G, F.bid);
          pg8::EpiY E{gbuf};
          pg8::gemm_phase<pg8::EpiY, pg8::Order, true, true>(F.lds, g, S, E); }
        __syncthreads();
        if constexpr (!dup) { const int nyu = NPAIR * 4, nidle = F.G > nyu ? F.G - nyu : F.G, rank = F.G > nyu ? F.bid - nyu : F.bid;
          if (rank >= 0) for (int it = rank * NWAVES + F.wave; it < 2048; it += nidle * NWAVES) s5_sample_item(F, it);
          __syncthreads(); }
#ifdef YG_REP
        if constexpr (!dup) { xcd_barrier(xbar); pg8::Gemm g{A2, KG, A2_LD, 768, 768, (size_t)A2_ROWS * A2_LD, (size_t)512 * 768}; pg8::Order S; S.init(A2_ROWS, 512, NPAIR, F.G, F.bid);
          pg8::EpiY E{gbuf};
          pg8::gemm_phase<pg8::EpiY, pg8::Order, true, true>(F.lds, g, S, E); xcd_barrier(xbar); }
#endif
        __syncthreads();
#ifdef LRU2_REP
#pragma nounroll
        for (int rep = 0; rep < LRU2_REP; ++rep) { lruw_tiles(F, 2, 544, cnt + 2048 + 256 * rep, ssqd, LRU_MODE); xcd_barrier(xbar); }
#endif
        lruw_tiles(F, 2, 544, cnt + (dup ? 1536 : 1280), dup ? ssqd : ssqa); __syncthreads();
    } } xcd_barrier(xbar); }
        { constexpr bool dup = false; (void)dup; { {
        if constexpr (!dup) { pg8::Gemm g{A2, KG, A2_LD, 768, 768, (size_t)A2_ROWS * A2_LD, (size_t)512 * 768}; pg8::Order S; S.init(A2_ROWS, 512, NPAIR, F.G, F.bid);
          pg8::EpiY E{gbuf};
          pg8::gemm_phase<pg8::EpiY, pg8::Order, true, true>(F.lds, g, S, E); }
        __syncthreads();
        if constexpr (!dup) { const int nyu = NPAIR * 4, nidle = F.G > nyu ? F.G - nyu : F.G, rank = F.G > nyu ? F.bid - nyu : F.bid;
          if (rank >= 0) for (int it = rank * NWAVES + F.wave; it < 2048; it += nidle * NWAVES) s5_sample_item(F, it);
          __syncthreads(); }
#ifdef YG_REP
        if constexpr (!dup) { xcd_barrier(xbar); pg8::Gemm g{A2, KG, A2_LD, 768, 768, (size_t)A2_ROWS * A2_LD, (size_t)512 * 768}; pg8::Order S; S.init(A2_ROWS, 512, NPAIR, F.G, F.bid);
          pg8::EpiY E{gbuf};
          pg8::gemm_phase<pg8::EpiY, pg8::Order, true, true>(F.lds, g, S, E); xcd_barrier(xbar); }
#endif
        __syncthreads();
#ifdef LRU2_REP
#pragma nounroll
        for (int rep = 0; rep < LRU2_REP; ++rep) { lruw_tiles(F, 2, 544, cnt + 2048 + 256 * rep, ssqd, LRU_MODE); xcd_barrier(xbar); }
#endif
        lruw_tiles(F, 2, 544, cnt + (dup ? 1536 : 1280), dup ? ssqd : ssqa); __syncthreads();
    } } }
    }
    SEAM(4);
    if (IN(5)) {
        if (DUP_PHASE == 5) { constexpr bool dup = true; (void)dup; { {
        pg8::Gemm g{gbuf, WgluT, DS5, DS5, DS5, 0, 0}; pg8::Order S; S.init(MT, DS5, 1, F.G, F.bid);
        pg8::EpiGlu E{gbuf, inp(F, I_BGLU), MIX, dup ? ssqd : ssqb};
        pg8::gemm_phase<pg8::EpiGlu, pg8::Order, true, true>(F.lds, g, S, E);
        __syncthreads();
        if constexpr (!dup) tr_items_dyn(F, inp(F, I_WOUT), inp(F, I_NOUTA), DM, DM, WoutT, cnt + 11, inp(F, I_NOUTB));
    } } xcd_barrier(xbar); }
        { constexpr bool dup = false; (void)dup; { {
        pg8::Gemm g{gbuf, WgluT, DS5, DS5, DS5, 0, 0}; pg8::Order S; S.init(MT, DS5, 1, F.G, F.bid);
        pg8::EpiGlu E{gbuf, inp(F, I_BGLU), MIX, dup ? ssqd : ssqb};
        pg8::gemm_phase<pg8::EpiGlu, pg8::Order, true, true>(F.lds, g, S, E);
        __syncthreads();
        if constexpr (!dup) tr_items_dyn(F, inp(F, I_WOUT), inp(F, I_NOUTA), DM, DM, WoutT, cnt + 11, inp(F, I_NOUTB));
    } } }
    }
    SEAM(5);
    if (IN(6)) {
        if (DUP_PHASE == 6) { constexpr bool dup = true; (void)dup; { {
        { pg8::Gemm g{MIX, WoutT, DM, DM, 1024, 1024, 1024}; pg8::Order S; S.init(MP, DM, -1, F.G, F.bid);
          pg8::EpiOut E{ssqa, ssqb, inp(F, I_XP), inp(F, I_XS), args.out, XB, dup ? ssqd : ssq1};
          pg8::gemm_phase<pg8::EpiOut, pg8::Order, true, true>(F.lds, g, S, E); }
        { pg8::Gemm g{MIX, WoutT, DM, DM, 256, 256, 256}; pg8::SliceOrder S{F.bid, 8, F.G};
          pg8::EpiPart E{(float*)(ws + WS_KG), (float*)(ws + WS_A2), 8};
          pg8::gemm_phase<pg8::EpiPart, pg8::SliceOrder, true, true>(F.lds, g, S, E); }
        if constexpr (!dup) { if (hi - lo > 1) xcd_barrier(xbar);
          for (int r2 = F.bid; r2 < MS / 2; r2 += F.G) {
            const int row = MP + 2 * r2 + (F.wave >> 2), qd = F.wave & 3, pm = row >> 8, rl = row & 255;
            const float* Pb = (const float*)(ws + (pm == 32 ? WS_KG : WS_A2));
            const float ra = 1.f / sqrtf(ssqa[row] * (1.f / DLRU) + EPS), rb = 1.f / sqrtf(ssqb[row] * (1.f / DS5) + EPS);
            float sq = 0.f;
#pragma unroll
            for (int jj = 0; jj < 2; ++jj) { const int col = 512 * qd + 256 * jj + 4 * F.lane, pn = col >> 8, cl = col & 255;
                const float* pp = Pb + (size_t)(pn * 8) * 65536 + rl * 256 + cl;
                f32x4 sa = {0.f, 0.f, 0.f, 0.f}, sb2 = {0.f, 0.f, 0.f, 0.f};
#pragma unroll
                for (int sl = 0; sl < 4; ++sl) { sa += *(const f32x4*)(pp + (size_t)sl * 65536); sb2 += *(const f32x4*)(pp + (size_t)(sl + 4) * 65536); }
                const f32x4 v = *(const f32x4*)(inp(F, I_XS) + (size_t)(row - MP) * DM + col) + sa * ra + sb2 * rb;
                *(f32x4*)(args.out + (size_t)row * DM + col) = v;
                v2u pk; pk.x = pk2(v.x, v.y); pk.y = pk2(v.z, v.w); *(v2u*)(XB + (size_t)row * DM + col) = pk;
                sq += (v.x * v.x + v.y * v.y) + (v.z * v.z + v.w * v.w); }
            sq = wave_sum(sq);
            if (F.lane == 0) atomicAdd(ssq1 + row, sq);
          } }
    } } xcd_barrier(xbar); }
        { constexpr bool dup = false; (void)dup; { {
        { pg8::Gemm g{MIX, WoutT, DM, DM, 1024, 1024, 1024}; pg8::Order S; S.init(MP, DM, -1, F.G, F.bid);
          pg8::EpiOut E{ssqa, ssqb, inp(F, I_XP), inp(F, I_XS), args.out, XB, dup ? ssqd : ssq1};
          pg8::gemm_phase<pg8::EpiOut, pg8::Order, true, true>(F.lds, g, S, E); }
        { pg8::Gemm g{MIX, WoutT, DM, DM, 256, 256, 256}; pg8::SliceOrder S{F.bid, 8, F.G};
          pg8::EpiPart E{(float*)(ws + WS_KG), (float*)(ws + WS_A2), 8};
          pg8::gemm_phase<pg8::EpiPart, pg8::SliceOrder, true, true>(F.lds, g, S, E); }
        if constexpr (!dup) { if (hi - lo > 1) xcd_barrier(xbar);
          for (int r2 = F.bid; r2 < MS / 2; r2 += F.G) {
            const int row = MP + 2 * r2 + (F.wave >> 2), qd = F.wave & 3, pm = row >> 8, rl = row & 255;
            const float* Pb = (const float*)(ws + (pm == 32 ? WS_KG : WS_A2));
            const float ra = 1.f / sqrtf(ssqa[row] * (1.f / DLRU) + EPS), rb = 1.f / sqrtf(ssqb[row] * (1.f / DS5) + EPS);
            float sq = 0.f;
#pragma unroll
            for (int jj = 0; jj < 2; ++jj) { const int col = 512 * qd + 256 * jj + 4 * F.lane, pn = col >> 8, cl = col & 255;
                const float* pp = Pb + (size_t)(pn * 8) * 65536 + rl * 256 + cl;
                f32x4 sa = {0.f, 0.f, 0.f, 0.f}, sb2 = {0.f, 0.f, 0.f, 0.f};
#pragma unroll
                for (int sl = 0; sl < 4; ++sl) { sa += *(const f32x4*)(pp + (size_t)sl * 65536); sb2 += *(const f32x4*)(pp + (size_t)(sl + 4) * 65536); }
                const f32x4 v = *(const f32x4*)(inp(F, I_XS) + (size_t)(row - MP) * DM + col) + sa * ra + sb2 * rb;
                *(f32x4*)(args.out + (size_t)row * DM + col) = v;
                v2u pk; pk.x = pk2(v.x, v.y); pk.y = pk2(v.z, v.w); *(v2u*)(XB + (size_t)row * DM + col) = pk;
                sq += (v.x * v.x + v.y * v.y) + (v.z * v.z + v.w * v.w); }
            sq = wave_sum(sq);
            if (F.lane == 0) atomicAdd(ssq1 + row, sq);
          } }
    } } }
    }
    SEAM(6);
    if (IN(7)) {
        if (DUP_PHASE == 7) { constexpr bool dup = true; (void)dup; { {
        pg8::Gemm g{XB, WupT, DM, DM, DM, 0, 0}; pg8::Order S; S.init(MT, DFF, 1, F.G, F.bid);
        pg8::EpiUp E{ssq1, HB};
        pg8::gemm_phase<pg8::EpiUp, pg8::Order, true, true>(F.lds, g, S, E);
        __syncthreads();
        if constexpr (!dup) tr_items_dyn(F, inp(F, I_WDOWN), nullptr, DFF, DM, WdownT, cnt + 9);
    } } xcd_barrier(xbar); }
        { constexpr bool dup = false; (void)dup; { {
        pg8::Gemm g{XB, WupT, DM, DM, DM, 0, 0}; pg8::Order S; S.init(MT, DFF, 1, F.G, F.bid);
        pg8::EpiUp E{ssq1, HB};
        pg8::gemm_phase<pg8::EpiUp, pg8::Order, true, true>(F.lds, g, S, E);
        __syncthreads();
        if constexpr (!dup) tr_items_dyn(F, inp(F, I_WDOWN), nullptr, DFF, DM, WdownT, cnt + 9);
    } } }
    }
    SEAM(7);
    if (IN(8)) {
        if (DUP_PHASE == 8) { constexpr bool dup = true; (void)dup; { {
        { pg8::Gemm g{HB, WdownT, DFF, DFF, DFF, 0, 0}; pg8::Order S; S.init(MP, DM, 1, F.G, F.bid);
          pg8::EpiDown E{args.out, XB, dup ? 0.f : 1.f};
          pg8::gemm_phase<pg8::EpiDown, pg8::Order, true, true>(F.lds, g, S, E); }
        { pg8::Gemm g{HB, WdownT, DFF, DFF, 1024, 1024, 1024}; pg8::SliceOrder S{F.bid, 8, F.G};
          pg8::EpiPart E{(float*)(ws + WS_WUP), (float*)(ws + WS_WUP) + (size_t)64 * 65536, 8};
          pg8::gemm_phase<pg8::EpiPart, pg8::SliceOrder, true, true>(F.lds, g, S, E); }
    } } xcd_barrier(xbar); }
        { constexpr bool dup = false; (void)dup; { {
        { pg8::Gemm g{HB, WdownT, DFF, DFF, DFF, 0, 0}; pg8::Order S; S.init(MP, DM, 1, F.G, F.bid);
          pg8::EpiDown E{args.out, XB, dup ? 0.f : 1.f};
          pg8::gemm_phase<pg8::EpiDown, pg8::Order, true, true>(F.lds, g, S, E); }
        { pg8::Gemm g{HB, WdownT, DFF, DFF, 1024, 1024, 1024}; pg8::SliceOrder S{F.bid, 8, F.G};
          pg8::EpiPart E{(float*)(ws + WS_WUP), (float*)(ws + WS_WUP) + (size_t)64 * 65536, 8};
          pg8::gemm_phase<pg8::EpiPart, pg8::SliceOrder, true, true>(F.lds, g, S, E); }
    } } }
    }
    SEAM(8);
    if (IN(9)) {
        if (DUP_PHASE == 9) { constexpr bool dup = true; (void)dup; { {
        const float* gf = inp(F, I_NFINAL);
        for (int r2 = F.bid; r2 < MS / 2; r2 += F.G) {
            const int row = MP + 2 * r2 + (F.wave >> 2), qd = F.wave & 3, pm = row >> 8, rl = row & 255;
            const float* Pb = (const float*)(ws + WS_WUP) + (pm == 32 ? (size_t)0 : (size_t)64 * 65536);
            f32x4 v[2]; float sq = 0.f;
#pragma unroll
            for (int jj = 0; jj < 2; ++jj) { const int col = 512 * qd + 256 * jj + 4 * F.lane, pn = col >> 8, cl = col & 255;
                f32x4 a = *(const f32x4*)(args.out + (size_t)row * DM + col);
                const float* pp = Pb + (size_t)(pn * 8) * 65536 + rl * 256 + cl;
#pragma unroll
                for (int sl = 0; sl < 8; ++sl) a += *(const f32x4*)(pp + (size_t)sl * 65536);
                v[jj] = a; sq += (a.x * a.x + a.y * a.y) + (a.z * a.z + a.w * a.w); }
            sq = wave_sum(sq);
            LAS float* red = (LAS float*)(F.lds + MISC_OFF + 128);
            if (F.lane == 0) red[F.wave] = sq;
            __syncthreads();
            const int w0 = F.wave & 4; const float tot = (red[w0] + red[w0 + 1]) + (red[w0 + 2] + red[w0 + 3]);
            __syncthreads();
            const float rs = dup ? 1.f : 1.f / sqrtf(tot * (1.f / DM) + EPS);
#pragma unroll
            for (int jj = 0; jj < 2; ++jj) { const int col = 512 * qd + 256 * jj + 4 * F.lane; const f32x4 gr = dup ? (f32x4){1.f, 1.f, 1.f, 1.f} : *(const f32x4*)(gf + col);
                f32x4 o = v[jj] * rs * gr; if (dup) o = *(const f32x4*)(args.out + (size_t)row * DM + col);
                *(f32x4*)(args.out + (size_t)row * DM + col) = o; }
        }
        for (int m = F.bid * NWAVES + F.wave; m < MP; m += F.G * NWAVES) {
            const v4u* xb = (const v4u*)(args.out + (size_t)m * DM) + F.lane; float* xo = args.out + (size_t)m * DM;
            v4u w[4]; float sq = 0.f; f32x4 v[8];
#pragma unroll
            for (int j = 0; j < 4; ++j) w[j] = xb[64 * j];
#pragma unroll
            for (int j = 0; j < 4; ++j) { v[2 * j] = (f32x4){bflo(w[j].x), bfhi(w[j].x), bflo(w[j].y), bfhi(w[j].y)}; v[2 * j + 1] = (f32x4){bflo(w[j].z), bfhi(w[j].z), bflo(w[j].w), bfhi(w[j].w)};
                sq += (v[2 * j].x * v[2 * j].x + v[2 * j].y * v[2 * j].y) + (v[2 * j].z * v[2 * j].z + v[2 * j].w * v[2 * j].w) + (v[2 * j + 1].x * v[2 * j + 1].x + v[2 * j + 1].y * v[2 * j + 1].y) + (v[2 * j + 1].z * v[2 * j + 1].z + v[2 * j + 1].w * v[2 * j + 1].w); }
            sq = wave_sum(sq);
            const float rs = 1.f / sqrtf(sq * (1.f / DM) + EPS);
            asm volatile("s_waitcnt vmcnt(0)" ::: "memory");
#pragma unroll
            for (int j = 0; j < 4; ++j) { const int c0 = 8 * (F.lane + 64 * j); const f32x4 g0 = *(const f32x4*)(gf + c0), g1 = *(const f32x4*)(gf + c0 + 4);
                *(f32x4*)(xo + c0) = v[2 * j] * rs * g0; *(f32x4*)(xo + c0 + 4) = v[2 * j + 1] * rs * g1; }
        }
    } } xcd_barrier(xbar); }
        { constexpr bool dup = false; (void)dup; { {
        const float* gf = inp(F, I_NFINAL);
        for (int r2 = F.bid; r2 < MS / 2; r2 += F.G) {
            const int row = MP + 2 * r2 + (F.wave >> 2), qd = F.wave & 3, pm = row >> 8, rl = row & 255;
            const float* Pb = (const float*)(ws + WS_WUP) + (pm == 32 ? (size_t)0 : (size_t)64 * 65536);
            f32x4 v[2]; float sq = 0.f;
#pragma unroll
            for (int jj = 0; jj < 2; ++jj) { const int col = 512 * qd + 256 * jj + 4 * F.lane, pn = col >> 8, cl = col & 255;
                f32x4 a = *(const f32x4*)(args.out + (size_t)row * DM + col);
                const float* pp = Pb + (size_t)(pn * 8) * 65536 + rl * 256 + cl;
#pragma unroll
                for (int sl = 0; sl < 8; ++sl) a += *(const f32x4*)(pp + (size_t)sl * 65536);
                v[jj] = a; sq += (a.x * a.x + a.y * a.y) + (a.z * a.z + a.w * a.w); }
            sq = wave_sum(sq);
            LAS float* red = (LAS float*)(F.lds + MISC_OFF + 128);
            if (F.lane == 0) red[F.wave] = sq;
            __syncthreads();
            const int w0 = F.wave & 4; const float tot = (red[w0] + red[w0 + 1]) + (red[w0 + 2] + red[w0 + 3]);
            __syncthreads();
            const float rs = dup ? 1.f : 1.f / sqrtf(tot * (1.f / DM) + EPS);
#pragma unroll
            for (int jj = 0; jj < 2; ++jj) { const int col = 512 * qd + 256 * jj + 4 * F.lane; const f32x4 gr = dup ? (f32x4){1.f, 1.f, 1.f, 1.f} : *(const f32x4*)(gf + col);
                f32x4 o = v[jj] * rs * gr; if (dup) o = *(const f32x4*)(args.out + (size_t)row * DM + col);
                *(f32x4*)(args.out + (size_t)row * DM + col) = o; }
        }
        for (int m = F.bid * NWAVES + F.wave; m < MP; m += F.G * NWAVES) {
            const v4u* xb = (const v4u*)(args.out + (size_t)m * DM) + F.lane; float* xo = args.out + (size_t)m * DM;
            v4u w[4]; float sq = 0.f; f32x4 v[8];
#pragma unroll
            for (int j = 0; j < 4; ++j) w[j] = xb[64 * j];
#pragma unroll
            for (int j = 0; j < 4; ++j) { v[2 * j] = (f32x4){bflo(w[j].x), bfhi(w[j].x), bflo(w[j].y), bfhi(w[j].y)}; v[2 * j + 1] = (f32x4){bflo(w[j].z), bfhi(w[j].z), bflo(w[j].w), bfhi(w[j].w)};
                sq += (v[2 * j].x * v[2 * j].x + v[2 * j].y * v[2 * j].y) + (v[2 * j].z * v[2 * j].z + v[2 * j].w * v[2 * j].w) + (v[2 * j + 1].x * v[2 * j + 1].x + v[2 * j + 1].y * v[2 * j + 1].y) + (v[2 * j + 1].z * v[2 * j + 1].z + v[2 * j + 1].w * v[2 * j + 1].w); }
            sq = wave_sum(sq);
            const float rs = 1.f / sqrtf(sq * (1.f / DM) + EPS);
            asm volatile("s_waitcnt vmcnt(0)" ::: "memory");
#pragma unroll
            for (int j = 0; j < 4; ++j) { const int c0 = 8 * (F.lane + 64 * j); const f32x4 g0 = *(const f32x4*)(gf + c0), g1 = *(const f32x4*)(gf + c0 + 4);
                *(f32x4*)(xo + c0) = v[2 * j] * rs * g0; *(f32x4*)(xo + c0 + 4) = v[2 * j + 1] * rs * g1; }
        }
    } } }
    }
#undef IN
#undef SEAM
}

#ifndef MK_MULTI_LAUNCH
#define MK_MULTI_LAUNCH 0
#endif
extern "C" void kernel_launch(void* const* d_in, const int* in_sizes, int n_in, void* d_out, int out_size, void* d_ws, size_t ws_size, hipStream_t stream) {
    static int grid = 0;
    if (grid == 0) {
        if (n_in != 32 || (size_t)out_size != O_END || ws_size < WS_END) { fprintf(stderr, "kernel_launch: unexpected sizes n_in %d out %d ws %zu\n", n_in, out_size, ws_size); grid = -1; return; }
        int dev = 0, cus = 0, per_cu = 0;
        hipGetDevice(&dev); hipDeviceGetAttribute(&cus, hipDeviceAttributeMultiprocessorCount, dev);
        if (hipFuncSetAttribute((const void*)fwd_megakernel, hipFuncAttributeMaxDynamicSharedMemorySize, LDS_BYTES) != hipSuccess) { fprintf(stderr, "kernel_launch: hipFuncSetAttribute failed\n"); grid = -1; return; }
        if (hipOccupancyMaxActiveBlocksPerMultiprocessor(&per_cu, (const void*)fwd_megakernel, NTHR, LDS_BYTES) != hipSuccess || per_cu < 1) { fprintf(stderr, "kernel_launch: occupancy query says %d\n", per_cu); per_cu = 1; }
        (void)hipGetLastError();
        grid = cus * 1;
        fprintf(stderr, "kernel_launch: grid %d (cus %d, per_cu %d)\n", grid, cus, per_cu);
    }
    if (grid < 0) return;
    hipMemsetAsync((char*)d_ws + WS_CTL, 0, CTL_BYTES, stream);
    Args a{};
    for (int i = 0; i < 32; ++i) a.in[i] = (const float*)d_in[i];
    a.out = (float*)d_out; a.ws = (unsigned char*)d_ws;
#if MK_MULTI_LAUNCH
    for (int p = 0; p < NPHASE; ++p) { a.ph_lo = p; a.ph_hi = p + 1; hipLaunchKernelGGL(fwd_megakernel, dim3(grid), dim3(NTHR), LDS_BYTES, stream, a); }
#else
    a.ph_lo = 0; a.ph_hi = NPHASE;
    void* kargs[] = {&a};
    hipError_t e = hipLaunchCooperativeKernel((const void*)fwd_megakernel, dim3(grid), dim3(NTHR), kargs, LDS_BYTES, stream);
    if (e != hipSuccess) fprintf(stderr, "kernel_launch: cooperative launch failed: %s (grid %d)\n", hipGetErrorString(e), grid);
#endif
}
```

```cpp
#include <hip/hip_runtime.h>
#include <hip/hip_cooperative_groups.h>
#include <cstdio>
#include <cstdint>
namespace cg = cooperative_groups;

namespace pg8 {
#define PG8_LAS __attribute__((address_space(3)))
typedef unsigned short bf16_t;
typedef short bf16x8 __attribute__((ext_vector_type(8)));
typedef float f32x4 __attribute__((ext_vector_type(4)));
typedef unsigned u32x4 __attribute__((ext_vector_type(4)));
constexpr int BM = 256, BK = 64, HALF = 128, HTB = HALF * BK * 2  , STAGE_BYTES = 8 * HTB, NXCD = 8, WGM = 8;

__host__ __device__ __forceinline__ int lds_byte(int r, int c) { const int st = (r >> 4) * 2 + (c >> 5), rr = r & 15, cc = c & 31, ob = rr * 64 + cc * 2; return st * 1024 + (ob ^ (((ob >> 9) & 1) << 5)); }
__host__ __device__ __forceinline__ void stage_rc(int b, int& R, int& C) { const int st = b / 1024, sb = b % 1024, swz = sb ^ (((sb >> 9) & 1) << 5); R = (st >> 1) * 16 + swz / 64; C = (st & 1) * 32 + (swz % 64) / 2; }
__host__ __device__ __forceinline__ int perm32(int rho) { const int n = rho >> 4, i = rho & 15; return 8 * (i >> 2) + 4 * n + (i & 3); }

struct Unit { int pm, pn, z; };
struct Gemm { const bf16_t* A; const bf16_t* Bt; int lda, ldb, K; size_t sA, sB; };

struct Order {
    int nM, nN, nZ, G, c;
    __device__ void init(int M, int N, int Z, int G_, int c_) { nM = M / BM; nN = N / BM; nZ = Z; G = G_; c = c_; }
    __device__ bool next(int i, Unit& u) const {
        int zz = 0; if (nZ < 0) { zz = i & 1; i >>= 1; }
        const long L = (long)i * G + c; const int nwg = nM * nN; if (L >= (long)nwg * (nZ < 0 ? 1 : nZ)) return false;
        if (nZ > 1) { const int z = (int)(L / nwg), r = (int)(L % nwg); u.z = z; u.pm = r % nM; u.pn = r / nM; return true; }
        int wgid = (int)L; { const int q = nwg / NXCD, r = nwg % NXCD, xcd = wgid % NXCD, off = wgid / NXCD; wgid = (xcd < r ? xcd * (q + 1) : r * (q + 1) + (xcd - r) * q) + off; }
        const int nig = WGM * nN, gid = wgid / nig, fm = gid * WGM, gsz = (nM - fm) < WGM ? (nM - fm) : WGM;
        u.pm = fm + ((wgid % nig) % gsz); u.pn = (wgid % nig) / gsz; u.z = zz; return true;
    }
    __device__ __forceinline__ void a_ready(const Unit&) const {}
    __device__ __forceinline__ void done(const Unit&) const {}
};

__device__ __forceinline__ unsigned cvt_pk_bf16(float lo, float hi) { unsigned r; asm volatile("v_cvt_pk_bf16_f32 %0, %1, %2" : "=v"(r) : "v"(lo), "v"(hi)); return r; }

template <class Epi, class Sched, bool ALIGN_EPI = false, bool SP2 = false>
__device__ __forceinline__ void gemm_phase(PG8_LAS unsigned char* lds, const Gemm g, const Sched& S, const Epi& E) {
    const int tid = threadIdx.x, wid = __builtin_amdgcn_readfirstlane(tid >> 6), lane = tid & 63, wr = wid >> 2, wc = wid & 3, fr = lane & 15, fq = lane >> 4;
    const int K = g.K, nt = K / BK;
    unsigned voffA[2], voffB[2];
#pragma unroll
    for (int i = 0; i < 2; ++i) { int R, C; stage_rc(tid * 16 + i * 8192, R, C); const int Rb = Epi::PERM ? ((R & ~31) + perm32(R & 31)) : R;
        voffA[i] = (unsigned)(R * g.lda + C) * 2u; voffB[i] = (unsigned)(Rb * g.ldb + C) * 2u; }
    const size_t kstep = (size_t)(BK * 2);
    const size_t hstepA = (size_t)HALF * g.lda * 2, hstepB = (size_t)HALF * g.ldb * 2;
    const size_t tstepA = 2 * hstepA, tstepB = 2 * hstepB;
    const unsigned ldsw = (unsigned)wid * 1024u;
    const int aoff = lds_byte(wr * 64 + fr, fq * 8), boff = lds_byte(wc * 32 + fr, fq * 8);
#define PG8_SA(b, h) (((b) * 2 + (h)) * HTB)
#define PG8_SB(b, h) ((4 + (b) * 2 + (h)) * HTB)
#define PG8_STAGE(bufoff, gbase, voff) do { _Pragma("unroll") for (int _i = 0; _i < 2; ++_i) \
        __builtin_amdgcn_global_load_lds((const unsigned*)((const char*)(gbase) + (voff)[_i]), (PG8_LAS unsigned*)(lds + (bufoff) + ldsw + _i * 8192), 16, 0, 0); } while (0)
#define PG8_LDA(dst, b, h) do { _Pragma("unroll") for (int m = 0; m < 4; ++m) _Pragma("unroll") for (int k = 0; k < 2; ++k) dst[m][k] = *(const PG8_LAS bf16x8*)(lds + PG8_SA(b, h) + aoff + m * 2048 + k * 1024); } while (0)
#define PG8_LDB(dst, b, h) do { _Pragma("unroll") for (int n = 0; n < 2; ++n) _Pragma("unroll") for (int k = 0; k < 2; ++k) dst[n][k] = *(const PG8_LAS bf16x8*)(lds + PG8_SB(b, h) + boff + n * 2048 + k * 1024); } while (0)
#define PG8_MMA(ai, bj, At, Bt) do { __builtin_amdgcn_s_setprio(1); _Pragma("unroll") for (int m = 0; m < 4; ++m) _Pragma("unroll") for (int n = 0; n < 2; ++n) _Pragma("unroll") for (int k = 0; k < 2; ++k) \
        acc[ai][bj][m][n] = __builtin_amdgcn_mfma_f32_16x16x32_bf16(Bt[n][k], At[m][k], acc[ai][bj][m][n], 0, 0, 0); __builtin_amdgcn_s_setprio(0); } while (0)
#define PG8_WAIT_V(n) asm volatile("s_waitcnt vmcnt(" #n ")" ::: "memory")
#define PG8_WAIT_L(n) asm volatile("s_waitcnt lgkmcnt(" #n ")" ::: "memory")
#define PG8_BAR __builtin_amdgcn_s_barrier()
#define PG8_SCHED __builtin_amdgcn_sched_barrier(0)
    Unit cur, nxt; int ui = 0;
    if (!S.next(0, cur)) return;
    f32x4 acc[2][2][4][2];
#pragma unroll
    for (int a = 0; a < 2; ++a)
#pragma unroll
        for (int b = 0; b < 2; ++b)
#pragma unroll
            for (int m = 0; m < 4; ++m)
#pragma unroll
                for (int n = 0; n < 2; ++n) acc[a][b][m][n] = (f32x4){0.f, 0.f, 0.f, 0.f};
    bf16x8 At[4][2], B0[2][2], B1[2][2];
    const char* cA = (const char*)g.A + (size_t)cur.z * g.sA * 2 + (size_t)cur.pm * tstepA; const char* cB = (const char*)g.Bt + (size_t)cur.z * g.sB * 2 + (size_t)cur.pn * tstepB;
    S.a_ready(cur);
    if constexpr (SP2) {
        PG8_STAGE(PG8_SB(0, 0), cB, voffB); PG8_STAGE(PG8_SB(0, 1), cB + hstepB, voffB); PG8_STAGE(PG8_SA(0, 0), cA, voffA); PG8_STAGE(PG8_SA(0, 1), cA + hstepA, voffA);
        if (wr == 1) PG8_BAR;
        PG8_WAIT_V(2); PG8_BAR;
        PG8_STAGE(PG8_SB(1, 0), cB + kstep, voffB); PG8_STAGE(PG8_SA(1, 0), cA + kstep, voffA); PG8_STAGE(PG8_SB(1, 1), cB + hstepB + kstep, voffB);
        PG8_WAIT_V(6); PG8_BAR;
    } else {
        PG8_STAGE(PG8_SB(0, 0), cB, voffB); PG8_STAGE(PG8_SA(0, 0), cA, voffA); PG8_STAGE(PG8_SB(0, 1), cB + hstepB, voffB); PG8_STAGE(PG8_SA(0, 1), cA + hstepA, voffA);
        if (wr == 1) PG8_BAR;
        PG8_WAIT_V(4); PG8_BAR;
        PG8_STAGE(PG8_SB(1, 0), cB + kstep, voffB); PG8_STAGE(PG8_SA(1, 0), cA + kstep, voffA); PG8_STAGE(PG8_SB(1, 1), cB + hstepB + kstep, voffB);
        PG8_WAIT_V(6); PG8_BAR;
    }
    for (;;) {
        const bool has_next = S.next(ui + 1, nxt);
        const char* nA = has_next ? (const char*)g.A + (size_t)nxt.z * g.sA * 2 + (size_t)nxt.pm * tstepA : cA; const char* nB = has_next ? (const char*)g.Bt + (size_t)nxt.z * g.sB * 2 + (size_t)nxt.pn * tstepB : cB;
        for (int t = 0; t < nt; t += 2) {
            const bool last = (t == nt - 2);
            const char* a1 = cA + (size_t)(t + 1) * kstep;
            const char* a2 = last ? nA : cA + (size_t)(t + 2) * kstep; const char* b2 = last ? nB : cB + (size_t)(t + 2) * kstep;
            const char* a3 = a2 + kstep; const char* b3 = b2 + kstep;
            if (last && has_next) S.a_ready(nxt);
            if constexpr (SP2) {
            PG8_LDB(B0, 0, 0); PG8_LDB(B1, 0, 1); PG8_SCHED; PG8_LDA(At, 0, 0); PG8_STAGE(PG8_SA(1, 1), a1 + hstepA, voffA);
            PG8_WAIT_V(8); PG8_WAIT_L(0); PG8_BAR; PG8_MMA(0, 0, At, B0); PG8_MMA(0, 1, At, B1); PG8_BAR; PG8_SCHED;
            PG8_LDA(At, 0, 1); PG8_STAGE(PG8_SB(0, 0), b2, voffB); PG8_STAGE(PG8_SB(0, 1), b2 + hstepB, voffB); PG8_STAGE(PG8_SA(0, 0), a2, voffA);
            PG8_WAIT_V(8); PG8_WAIT_L(0); PG8_BAR; PG8_MMA(1, 0, At, B0); PG8_MMA(1, 1, At, B1); PG8_BAR; PG8_SCHED;
            PG8_LDB(B0, 1, 0); PG8_LDB(B1, 1, 1); PG8_SCHED; PG8_LDA(At, 1, 0); PG8_STAGE(PG8_SA(0, 1), a2 + hstepA, voffA);
            PG8_WAIT_V(8); PG8_WAIT_L(0); PG8_BAR; PG8_MMA(0, 0, At, B0); PG8_MMA(0, 1, At, B1); PG8_BAR; PG8_SCHED;
            PG8_LDA(At, 1, 1); PG8_STAGE(PG8_SB(1, 0), b3, voffB); PG8_STAGE(PG8_SB(1, 1), b3 + hstepB, voffB); PG8_STAGE(PG8_SA(1, 0), a3, voffA);
            PG8_WAIT_V(8); PG8_WAIT_L(0); PG8_BAR; PG8_MMA(1, 0, At, B0); PG8_MMA(1, 1, At, B1); PG8_BAR; PG8_SCHED;
            } else {
            PG8_LDB(B0, 0, 0); PG8_SCHED; PG8_LDA(At, 0, 0); PG8_STAGE(PG8_SA(1, 1), a1 + hstepA, voffA);
            PG8_WAIT_L(8); PG8_BAR; PG8_WAIT_L(0); PG8_MMA(0, 0, At, B0); PG8_BAR; PG8_SCHED;
            PG8_LDB(B1, 0, 1); PG8_STAGE(PG8_SB(0, 0), b2, voffB);
            PG8_BAR; PG8_WAIT_L(0); PG8_MMA(0, 1, At, B1); PG8_BAR;
            PG8_LDA(At, 0, 1); PG8_STAGE(PG8_SA(0, 0), a2, voffA);
            PG8_BAR; PG8_WAIT_L(0); PG8_MMA(1, 0, At, B0); PG8_BAR; PG8_SCHED;
            PG8_STAGE(PG8_SB(0, 1), b2 + hstepB, voffB);
            PG8_WAIT_V(6); PG8_BAR; PG8_MMA(1, 1, At, B1); PG8_BAR;
            PG8_LDB(B0, 1, 0); PG8_SCHED; PG8_LDA(At, 1, 0); PG8_STAGE(PG8_SA(0, 1), a2 + hstepA, voffA);
            PG8_WAIT_L(8); PG8_BAR; PG8_WAIT_L(0); PG8_MMA(0, 0, At, B0); PG8_BAR; PG8_SCHED;
            PG8_LDB(B1, 1, 1); PG8_STAGE(PG8_SB(1, 0), b3, voffB);
            PG8_BAR; PG8_WAIT_L(0); PG8_MMA(0, 1, At, B1); PG8_BAR;
            PG8_LDA(At, 1, 1); PG8_STAGE(PG8_SA(1, 0), a3, voffA);
            PG8_BAR; PG8_WAIT_L(0); PG8_MMA(1, 0, At, B0); PG8_BAR; PG8_SCHED;
            PG8_STAGE(PG8_SB(1, 1), b3 + hstepB, voffB);
            PG8_WAIT_V(6); PG8_BAR; PG8_MMA(1, 1, At, B1); PG8_BAR;
            }
        }
        if constexpr (ALIGN_EPI) { if (wr == 0) PG8_BAR; }
        if constexpr (!Epi::AFTER_DRAIN) { E(acc, cur, wr, wc, fr, fq); S.done(cur); }
        if (!has_next) break;
        if (!(Epi::TWO_PART && cur.z == 0)) {
#pragma unroll
        for (int a = 0; a < 2; ++a)
#pragma unroll
            for (int b = 0; b < 2; ++b)
#pragma unroll
                for (int m = 0; m < 4; ++m)
#pragma unroll
                    for (int n = 0; n < 2; ++n) acc[a][b][m][n] = (f32x4){0.f, 0.f, 0.f, 0.f};
        }
        cur = nxt; cA = nA; cB = nB; ++ui;
        if constexpr (ALIGN_EPI) { if (wr == 1) PG8_BAR; }
    }
    PG8_WAIT_V(0);
    if constexpr (!ALIGN_EPI) { if (wr == 0) PG8_BAR; }
    PG8_BAR;
    if constexpr (Epi::AFTER_DRAIN) { E.fused(acc, cur, wr, wc, fr, fq, lds, wid, lane); S.done(cur); }
#undef PG8_SA
#undef PG8_SB
#undef PG8_STAGE
#undef PG8_LDA
#undef PG8_LDB
#undef PG8_MMA
#undef PG8_WAIT_V
#undef PG8_WAIT_L
#undef PG8_BAR
#undef PG8_SCHED
}
}

constexpr int NWAVES = 8, NTHR = 512;
constexpr int DM = 2048, DLRU = 1024, DS5 = 1024, DFF = 8192, NZ = 3072;
constexpr int MP = 8192, MS = 512, MT = MP + MS;
constexpr int SEQ = 2048, NB = 4, NSEQ = 128;
constexpr int NG = 64, NPAIR = 32, LCH = 16, NCH = 128;
constexpr int A2_LD = 768, A2_ROWS = 512;
constexpr float EPS = 1e-6f;

constexpr size_t MiB = 1u << 20;
constexpr size_t WS_CTL = 0, CTL_BYTES = 1 * MiB;
constexpr size_t CTL_SSQA = 0, CTL_SSQB = 64 * 1024, CTL_SSQ1 = 128 * 1024, CTL_SSQ2 = 192 * 1024, CTL_CNT = 256 * 1024, CTL_BAR = 512 * 1024;
constexpr size_t WS_SMALL = 1 * MiB;
constexpr size_t SM_WGA = WS_SMALL, SM_WGX = SM_WGA + 131072;
constexpr size_t SM_AGG = SM_WGX + 131072;
constexpr size_t SM_RS0 = SM_AGG + 524288;
constexpr size_t SM_E1 = SM_RS0 + 65536, SM_E16 = SM_E1 + 32768;
constexpr size_t SM_BBAR = SM_E16 + 32768;
constexpr size_t SM_SP = SM_BBAR + 524288;
static_assert(SM_SP + 4096 <= 4 * MiB, "small region");
constexpr size_t WS_WUP = 4 * MiB, WS_WDOWN = 36 * MiB, WS_XB = 68 * MiB;
constexpr size_t WS_H = 102 * MiB;
constexpr size_t WS_WIN = 102 * MiB, WS_WGLU = 114 * MiB, WS_WOUT = 116 * MiB;
constexpr size_t WS_M1 = 124 * MiB;
constexpr size_t WS_KG = 132 * MiB;
constexpr size_t WS_A2 = 156 * MiB;
constexpr size_t WS_US = 180 * MiB;
constexpr size_t WS_S = 182 * MiB;
constexpr size_t WS_MIX = 198 * MiB;
constexpr size_t WS_END = 246 * MiB;
constexpr size_t WS_AGG = 238 * MiB;
constexpr size_t WS_HIN = 242 * MiB;
static_assert(WS_XB + (size_t)MT * DM * 2 <= WS_H && WS_H + (size_t)MT * DFF * 2 <= WS_AGG && WS_MIX + (size_t)MT * DM * 2 <= WS_AGG, "ws map");
constexpr size_t DO_XLRU = 0, DO_GLRU = (size_t)MT * DLRU * 4, DO_G = DO_GLRU + (size_t)MT * DLRU * 2;
constexpr size_t O_Y = 0, O_CONVP = (size_t)MT * DM, O_LRUP = O_CONVP + 4 * 3 * 1024, O_REP = O_LRUP + 4 * 1024, O_IMP = O_REP + 4 * 64 * 64,
                 O_CONVS = O_IMP + 4 * 64 * 64, O_LRUS = O_CONVS + 128 * 3 * 1024, O_RES = O_LRUS + 128 * 1024, O_IMS = O_RES + 128 * 64 * 64, O_END = O_IMS + 128 * 64 * 64;

constexpr int RING_BYTES = 131072, MISC_OFF = RING_BYTES, LDS_BYTES = 147456;

#define LAS __attribute__((address_space(3)))
typedef unsigned short bf16;
typedef unsigned v4u __attribute__((ext_vector_type(4)));
typedef unsigned v2u __attribute__((ext_vector_type(2)));
typedef float f32x4 __attribute__((ext_vector_type(4)));
typedef short bf16x8 __attribute__((ext_vector_type(8)));
#define LDS_WAIT() asm volatile("s_waitcnt lgkmcnt(0)" ::: "memory")

__device__ __forceinline__ unsigned f2bf(float f) { unsigned u = __builtin_bit_cast(unsigned, f); return (u + 0x7fffu + ((u >> 16) & 1u)) >> 16; }
__device__ __forceinline__ unsigned pk2(float lo, float hi) { return f2bf(lo) | (f2bf(hi) << 16); }
__device__ __forceinline__ float bf2f(unsigned b) { return __builtin_bit_cast(float, b << 16); }
__device__ __forceinline__ float bflo(unsigned w) { return __builtin_bit_cast(float, w << 16); }
__device__ __forceinline__ float bfhi(unsigned w) { return __builtin_bit_cast(float, w & 0xffff0000u); }
__device__ __forceinline__ float sigmoidf_(float x) { return __builtin_amdgcn_rcpf(1.f + __expf(-x)); }
__device__ __forceinline__ float gelu_tanh(float x) { const float u = 1.5957691216f * (x + 0.044715f * x * x * x); return x * __builtin_amdgcn_rcpf(1.f + __expf(-u)); }
__device__ __forceinline__ float wave_sum(float v) {
#pragma unroll
    for (int o = 1; o < 64; o <<= 1) v += __shfl_xor(v, o);
    return v;
}
__device__ __forceinline__ void sincos_d(double x, double& s, double& c) {
    const double q = rint(x * 0.63661977236758134308), r = (x - q * 1.57079632679489655800) - q * 6.12323399573676603587e-17, r2 = r * r;
    double sr = 1.0 - r2 / 210.0; sr = 1.0 - r2 / 156.0 * sr; sr = 1.0 - r2 / 110.0 * sr; sr = 1.0 - r2 / 72.0 * sr; sr = 1.0 - r2 / 42.0 * sr; sr = 1.0 - r2 / 20.0 * sr; sr = 1.0 - r2 / 6.0 * sr; sr *= r;
    double cr = 1.0 - r2 / 182.0; cr = 1.0 - r2 / 132.0 * cr; cr = 1.0 - r2 / 90.0 * cr; cr = 1.0 - r2 / 56.0 * cr; cr = 1.0 - r2 / 30.0 * cr; cr = 1.0 - r2 / 12.0 * cr; cr = 1.0 - r2 / 2.0 * cr;
    const int qi = ((int)q) & 3;
    s = (qi == 0) ? sr : (qi == 1) ? cr : (qi == 2) ? -sr : -cr;
    c = (qi == 0) ? cr : (qi == 1) ? -sr : (qi == 2) ? -cr : sr;
}

namespace pg8 {
#define EPI_ROWS_BEGIN const int row0 = u.pm * BM + wr * 64 + fr; _Pragma("unroll") for (int ai = 0; ai < 2; ++ai) _Pragma("unroll") for (int m = 0; m < 4; ++m) { const int row = row0 + ai * HALF + m * 16;
#define EPI_ROWS_END }
__device__ __forceinline__ float fq_sum(float v) { v += __shfl_xor(v, 16); v += __shfl_xor(v, 32); return v; }
__device__ __forceinline__ float sq8(const f32x4& a, const f32x4& b) { return (a[0] * a[0] + a[1] * a[1]) + (a[2] * a[2] + a[3] * a[3]) + (b[0] * b[0] + b[1] * b[1]) + (b[2] * b[2] + b[3] * b[3]); }
__device__ __forceinline__ u32x4 pack8(const f32x4& a, const f32x4& b) { u32x4 w; w.x = cvt_pk_bf16(a[0], a[1]); w.y = cvt_pk_bf16(a[2], a[3]); w.z = cvt_pk_bf16(b[0], b[1]); w.w = cvt_pk_bf16(b[2], b[3]); return w; }

struct EpiZ {
    static constexpr bool PERM = true, AFTER_DRAIN = false, TWO_PART = false;
    const float* rs0; float* xlru; bf16_t* glru; bf16_t* A2; bf16_t* us;
    __device__ __forceinline__ void operator()(const f32x4 (&acc)[2][2][4][2], const Unit& u, int wr, int wc, int fr, int fq) const {
        const int colt = u.pn * BM + wc * 32 + 8 * fq;
        EPI_ROWS_BEGIN
            const float s = rs0[row];
#pragma unroll
            for (int bj = 0; bj < 2; ++bj) { const int col = colt + bj * HALF; const f32x4 v0 = acc[ai][bj][m][0] * s, v1 = acc[ai][bj][m][1] * s;
                if (u.pn < 4) { float* p = xlru + (size_t)row * DLRU + col; *(f32x4*)p = v0; *(f32x4*)(p + 4) = v1; }
                else if (u.pn < 8) { *(u32x4*)(glru + (size_t)row * DLRU + (col - 1024)) = pack8(v0, v1); }
                else { const int c = col - 2048;
                    if (u.pm < 32) *(u32x4*)(A2 + ((size_t)(c >> 5) * A2_ROWS + (row >> 4)) * A2_LD + (row & 15) * 32 + (c & 31)) = pack8(v0, v1);
                    else *(u32x4*)(us + (size_t)(row - MP) * DS5 + c) = pack8(v0, v1); } }
        EPI_ROWS_END
    }
};
struct EpiS {
    static constexpr bool PERM = true, AFTER_DRAIN = false, TWO_PART = false;
    float* S;
    __device__ __forceinline__ void operator()(const f32x4 (&acc)[2][2][4][2], const Unit& u, int wr, int wc, int fr, int fq) const {
        const int colt = u.pn * BM + wc * 32 + 8 * fq;
        EPI_ROWS_BEGIN
#pragma unroll
            for (int bj = 0; bj < 2; ++bj) { float* p = S + ((size_t)u.z * A2_ROWS + row) * 256 + colt + bj * HALF; *(f32x4*)p = acc[ai][bj][m][0]; *(f32x4*)(p + 4) = acc[ai][bj][m][1]; }
        EPI_ROWS_END
    }
};
struct EpiY {
    static constexpr bool PERM = true, AFTER_DRAIN = false, TWO_PART = false;
    bf16_t* gbuf;
    __device__ __forceinline__ void operator()(const f32x4 (&acc)[2][2][4][2], const Unit& u, int wr, int wc, int fr, int fq) const {
        EPI_ROWS_BEGIN
#pragma unroll
            for (int bj = 0; bj < 2; ++bj) { const int j = 8 * u.pn + 4 * bj + wc; f32x4 v0 = acc[ai][bj][m][0], v1 = acc[ai][bj][m][1];
#pragma unroll
                for (int e = 0; e < 4; ++e) { v0[e] = gelu_tanh(v0[e]); v1[e] = gelu_tanh(v1[e]); }
                *(u32x4*)(gbuf + (size_t)(row * 16 + j) * DS5 + u.z * 32 + 8 * fq) = pack8(v0, v1); }
        EPI_ROWS_END
    }
};
struct EpiGlu {
    static constexpr bool PERM = true, AFTER_DRAIN = false, TWO_PART = false;
    const bf16_t* gbuf; const float* bglu; bf16_t* mix; float* ssqb;
    __device__ __forceinline__ void operator()(const f32x4 (&acc)[2][2][4][2], const Unit& u, int wr, int wc, int fr, int fq) const {
        const int colt = u.pn * BM + wc * 32 + 8 * fq;
        EPI_ROWS_BEGIN
            float sum = 0.f;
#pragma unroll
            for (int bj = 0; bj < 2; ++bj) { const int col = colt + bj * HALF; const u32x4 gw = *(const u32x4*)(gbuf + (size_t)row * DS5 + col);
                const f32x4 b0 = *(const f32x4*)(bglu + col), b1 = *(const f32x4*)(bglu + col + 4);
                f32x4 v0 = acc[ai][bj][m][0] + b0, v1 = acc[ai][bj][m][1] + b1;
                v0[0] = bflo(gw.x) * sigmoidf_(v0[0]); v0[1] = bfhi(gw.x) * sigmoidf_(v0[1]); v0[2] = bflo(gw.y) * sigmoidf_(v0[2]); v0[3] = bfhi(gw.y) * sigmoidf_(v0[3]);
                v1[0] = bflo(gw.z) * sigmoidf_(v1[0]); v1[1] = bfhi(gw.z) * sigmoidf_(v1[1]); v1[2] = bflo(gw.w) * sigmoidf_(v1[2]); v1[3] = bfhi(gw.w) * sigmoidf_(v1[3]);
                sum += sq8(v0, v1);
                *(u32x4*)(mix + (size_t)row * DM + 1024 + col) = pack8(v0, v1); }
            sum = fq_sum(sum); if (fq == 0) atomicAdd(ssqb + row, sum);
        EPI_ROWS_END
    }
};
struct EpiOut {
    static constexpr bool PERM = true, AFTER_DRAIN = false, TWO_PART = true;
    const float* ssqa; const float* ssqb; const float* xp; const float* xs; float* x1; bf16_t* x1b; float* ssq1;
    __device__ __forceinline__ void operator()(f32x4 (&acc)[2][2][4][2], const Unit& u, int wr, int wc, int fr, int fq) const {
        const int colt = u.pn * BM + wc * 32 + 8 * fq;
        if (u.z == 0) {
            EPI_ROWS_BEGIN
                const float ra = ssqa[row] * (1.f / DLRU) + EPS, rb = ssqb[row] * (1.f / DS5) + EPS, ratio = sqrtf(rb / ra);
#pragma unroll
                for (int bj = 0; bj < 2; ++bj) { acc[ai][bj][m][0] = acc[ai][bj][m][0] * ratio; acc[ai][bj][m][1] = acc[ai][bj][m][1] * ratio; }
            EPI_ROWS_END
        } else {
            EPI_ROWS_BEGIN
                const float rb = 1.f / sqrtf(ssqb[row] * (1.f / DS5) + EPS);
                const float* xr = (row < MP) ? xp + (size_t)row * DM : xs + (size_t)(row - MP) * DM;
                float sum = 0.f;
#pragma unroll
                for (int bj = 0; bj < 2; ++bj) { const int col = colt + bj * HALF;
                    const f32x4 v0 = *(const f32x4*)(xr + col) + acc[ai][bj][m][0] * rb, v1 = *(const f32x4*)(xr + col + 4) + acc[ai][bj][m][1] * rb;
                    *(u32x4*)(x1b + (size_t)row * DM + col) = pack8(v0, v1);
                    sum += sq8(v0, v1); }
                sum = fq_sum(sum); if (fq == 0) atomicAdd(ssq1 + row, sum);
            EPI_ROWS_END
        }
    }
};
struct EpiUp {
    static constexpr bool PERM = true, AFTER_DRAIN = false, TWO_PART = false;
    const float* ssq1; bf16_t* h;
    __device__ __forceinline__ void operator()(const f32x4 (&acc)[2][2][4][2], const Unit& u, int wr, int wc, int fr, int fq) const {
        const int colt = u.pn * BM + wc * 32 + 8 * fq;
        EPI_ROWS_BEGIN
            const float rs = 1.f / sqrtf(ssq1[row] * (1.f / DM) + EPS);
#pragma unroll
            for (int bj = 0; bj < 2; ++bj) { f32x4 v0 = acc[ai][bj][m][0] * rs, v1 = acc[ai][bj][m][1] * rs;
#pragma unroll
                for (int e = 0; e < 4; ++e) { const float a = fmaxf(v0[e], 0.f), b = fmaxf(v1[e], 0.f); v0[e] = a * a; v1[e] = b * b; }
                *(u32x4*)(h + (size_t)row * DFF + colt + bj * HALF) = pack8(v0, v1); }
        EPI_ROWS_END
    }
};
struct EpiDown {
    static constexpr bool PERM = true, AFTER_DRAIN = false, TWO_PART = false;
    float* x; const bf16_t* x1b; float mul;
    __device__ __forceinline__ void operator()(const f32x4 (&acc)[2][2][4][2], const Unit& u, int wr, int wc, int fr, int fq) const {
        const int colt = u.pn * BM + wc * 32 + 8 * fq;
        EPI_ROWS_BEGIN
#pragma unroll
            for (int bj = 0; bj < 2; ++bj) { float* p = x + (size_t)row * DM + colt + bj * HALF; const u32x4 w = *(const u32x4*)(x1b + (size_t)row * DM + colt + bj * HALF);
                const f32x4 v0 = (f32x4){bflo(w.x), bfhi(w.x), bflo(w.y), bfhi(w.y)} + acc[ai][bj][m][0] * mul, v1 = (f32x4){bflo(w.z), bfhi(w.z), bflo(w.w), bfhi(w.w)} + acc[ai][bj][m][1] * mul;
                (void)p; *(u32x4*)((bf16_t*)(x + (size_t)row * DM) + colt + bj * HALF) = pack8(v0, v1); }
        EPI_ROWS_END
    }
};
struct EpiPart {
    static constexpr bool PERM = true, AFTER_DRAIN = false, TWO_PART = false;
    float* P0; float* P1; int nsl;
    __device__ __forceinline__ void operator()(const f32x4 (&acc)[2][2][4][2], const Unit& u, int wr, int wc, int fr, int fq) const {
        const int t = ((u.pm - 32) * 8 + u.pn) * nsl + u.z, half = 8 * nsl;
        float* base = (t < half ? P0 + (size_t)t * 65536 : P1 + (size_t)(t - half) * 65536) + wc * 32 + 8 * fq;
        const int row0 = wr * 64 + fr;
#pragma unroll
        for (int ai = 0; ai < 2; ++ai)
#pragma unroll
            for (int m = 0; m < 4; ++m) { const int row = row0 + ai * HALF + m * 16;
#pragma unroll
                for (int bj = 0; bj < 2; ++bj) { float* p = base + row * 256 + bj * HALF; *(f32x4*)p = acc[ai][bj][m][0]; *(f32x4*)(p + 4) = acc[ai][bj][m][1]; } }
    }
};
struct EpiPartB {
    static constexpr bool PERM = true, AFTER_DRAIN = false, TWO_PART = false;
    bf16_t* P0; bf16_t* P1; int nsl;
    __device__ __forceinline__ void operator()(const f32x4 (&acc)[2][2][4][2], const Unit& u, int wr, int wc, int fr, int fq) const {
        const int t = ((u.pm - 32) * 8 + u.pn) * nsl + u.z, half = 8 * nsl;
        bf16_t* base = (t < half ? P0 + (size_t)t * 65536 : P1 + (size_t)(t - half) * 65536) + wc * 32 + 8 * fq;
        const int row0 = wr * 64 + fr;
#pragma unroll
        for (int ai = 0; ai < 2; ++ai)
#pragma unroll
            for (int m = 0; m < 4; ++m) { const int row = row0 + ai * HALF + m * 16;
#pragma unroll
                for (int bj = 0; bj < 2; ++bj) *(u32x4*)(base + row * 256 + bj * HALF) = pack8(acc[ai][bj][m][0], acc[ai][bj][m][1]); }
    }
};
struct SliceOrder {
    int c, nsl, G;
    __device__ bool next(int i, Unit& u) const { const int L = i * G + c; if (L >= 16 * nsl) return false; const int j = L / nsl; u.pm = 32 + (j >> 3); u.pn = j & 7; u.z = L - j * nsl; return true; }
    __device__ __forceinline__ void a_ready(const Unit&) const {}
    __device__ __forceinline__ void done(const Unit&) const {}
};
}

#define XB_TMO      128
#define XB_XCNT(j)  (256  + 64 * (j))
#define XB_XSUB(j)  (1280 + 64 * (j))
#define XB_XGEN(j)  (2304 + 64 * (j))
#define XB_TOP      3328
#define XB_TOPGEN   3392
#define XCD_BAR_WORDS 3456
#define XB_SPIN_CAP (1u << 18)

__device__ __forceinline__ unsigned xb_ld(unsigned* p)              { return __hip_atomic_load(p, __ATOMIC_RELAXED, __HIP_MEMORY_SCOPE_AGENT); }
__device__ __forceinline__ unsigned xb_add(unsigned* p, unsigned v) { return __hip_atomic_fetch_add(p, v, __ATOMIC_RELAXED, __HIP_MEMORY_SCOPE_AGENT); }
__device__ __forceinline__ unsigned xb_xcc_id() { return (unsigned)__builtin_amdgcn_s_getreg((3 << 11) | 20) & 0xFu; }
#define XB_SPIN(cond, bar) do { unsigned _sp = 0; while (cond) { __builtin_amdgcn_s_sleep(1); \
    if ((++_sp & 255u) == 0u) { if (xb_ld(&(bar)[XB_TMO])) break; if (_sp > XB_SPIN_CAP) { atomicAdd(&(bar)[XB_TMO], 1u); break; } } } } while (0)

struct XcdBarrier {
    unsigned* bar; unsigned x;
    volatile LAS unsigned* st;
};

__device__ __forceinline__ XcdBarrier xcd_barrier_post(unsigned* bar, volatile LAS unsigned* st) {
    XcdBarrier b; b.bar = bar; b.x = xb_xcc_id(); b.st = st;
    if (threadIdx.x == 0) (void)xb_add(&bar[XB_XCNT(b.x)], 1u);
    return b;
}
__device__ __forceinline__ void xcd_barrier_complete(unsigned* bar, unsigned x, unsigned& nloc, unsigned& nx) {
    const unsigned G = gridDim.x * gridDim.y * gridDim.z;
    unsigned sum, cnt, mine, sp = 0u;
    for (;;) {
        sum = 0u; cnt = 0u; mine = 0u;
#pragma unroll
        for (unsigned j = 0; j < 16; ++j) { const unsigned c = xb_ld(&bar[XB_XCNT(j)]); sum += c; cnt += (c > 0u) ? 1u : 0u; mine = (j == x) ? c : mine; }
        if (sum == G) break;
        __builtin_amdgcn_s_sleep(1);
        if ((++sp & 255u) == 0u) { if (xb_ld(&bar[XB_TMO])) break; if (sp > XB_SPIN_CAP) { atomicAdd(&bar[XB_TMO], 1u); break; } }
    }
    nloc = mine > 0u ? mine : 1u; nx = cnt > 0u ? cnt : 1u;
}

__device__ __forceinline__ void xcd_barrier(const XcdBarrier& b) {
    asm volatile("s_waitcnt vmcnt(0)" ::: "memory");
    __syncthreads();
    if (threadIdx.x == 0) {
        unsigned* bar = b.bar;
        __builtin_amdgcn_s_waitcnt(0);
        unsigned nloc = b.st[0], nx = b.st[1];
        if (nloc == 0u) { xcd_barrier_complete(bar, b.x, nloc, nx); b.st[0] = nloc; b.st[1] = nx; }
        const unsigned old = xb_add(&bar[XB_XSUB(b.x)], 1u);
        const unsigned gen = old / nloc;
        if (old + 1u == (gen + 1u) * nloc) {
            __builtin_amdgcn_fence(__ATOMIC_RELEASE, "agent");
            asm volatile("s_waitcnt vmcnt(0)" ::: "memory");
            const unsigned og = xb_add(&bar[XB_TOP], 1u);
            const unsigned tg = og / nx;
            if (og + 1u == (tg + 1u) * nx) xb_add(&bar[XB_TOPGEN], 1u);
            else XB_SPIN(xb_ld(&bar[XB_TOPGEN]) == tg, bar);
            __builtin_amdgcn_fence(__ATOMIC_ACQUIRE, "agent");
            xb_add(&bar[XB_XGEN(b.x)], 1u);
            asm volatile("s_waitcnt vmcnt(0)" ::: "memory");
        } else {
            XB_SPIN(xb_ld(&bar[XB_XGEN(b.x)]) == gen, bar);
            __builtin_amdgcn_fence(__ATOMIC_ACQUIRE, "agent");
            asm volatile("s_waitcnt vmcnt(0)" ::: "memory");
        }
    }
    __syncthreads();
}


struct Args { const float* in[32]; float* out; unsigned char* ws; int ph_lo, ph_hi; };
struct Frame {
    LAS unsigned char* lds;
    int tid, lane, wave, G, bid;
    float* out; unsigned char* ws;
};
constexpr int PTR_OFF = MISC_OFF + 256;
__device__ __forceinline__ const float* inp(const Frame& F, int i) {
    const LAS unsigned* T = (const LAS unsigned*)(F.lds + PTR_OFF);
    const unsigned lo = __builtin_amdgcn_readfirstlane(T[2 * i]), hi = __builtin_amdgcn_readfirstlane(T[2 * i + 1]);
    return (const float*)(((unsigned long long)hi << 32) | lo);
}
enum { I_XP = 0, I_XS, I_SCONV, I_SLRU, I_SRE, I_SIM, I_NMIX, I_WIN, I_CONVW, I_CONVB, I_WGA, I_BGA, I_WGX, I_BGX, I_LAMBDA, I_ARE, I_AIM, I_LOGSTEP, I_BRE, I_BIM, I_CRE, I_CIM,
       I_D, I_WGLU, I_BGLU, I_NOUTA, I_NOUTB, I_WOUT, I_NMLP, I_WUP, I_WDOWN, I_NFINAL };

__device__ __forceinline__ void tr_item(const float* __restrict__ W, const float* __restrict__ sc, int K, int N, bf16* __restrict__ WT, int item, int wave, int lane) {
    const int nblk = N >> 8, kb = item / nblk, nb = item - kb * nblk, k0 = kb * 64 + wave * 8, n0 = nb * 256 + 4 * lane;
    f32x4 v[8];
#pragma unroll
    for (int j = 0; j < 8; ++j) v[j] = __builtin_nontemporal_load((const f32x4*)(W + (size_t)(k0 + j) * N + n0));
    if (sc) {
#pragma unroll
        for (int j = 0; j < 8; ++j) v[j] = v[j] * sc[k0 + j];
    }
#pragma unroll
    for (int e = 0; e < 4; ++e) { v4u o; o.x = pk2(v[0][e], v[1][e]); o.y = pk2(v[2][e], v[3][e]); o.z = pk2(v[4][e], v[5][e]); o.w = pk2(v[6][e], v[7][e]);
        *(v4u*)(WT + (size_t)(n0 + e) * K + k0) = o; }
}
__device__ __forceinline__ void tr_items_dyn(Frame& F, const float* W, const float* sc, int K, int N, bf16* WT, unsigned* counter, const float* sc_hi = nullptr) {
    LAS int* slot = (LAS int*)(F.lds + MISC_OFF + 64);
    const int nitems = (K >> 6) * (N >> 8);
    for (;;) {
        if (F.tid == 0) *slot = (int)atomicAdd(counter, 1u);
        __syncthreads();
        const int it = *slot;
        __syncthreads();
        if (it >= nitems) break;
        tr_item(W, (sc_hi && (it / (N >> 8)) >= 16) ? sc_hi - 1024 : sc, K, N, WT, it, F.wave, F.lane);
    }
}
__device__ __forceinline__ void p0_x_row(const float* xrow, bf16* orow, float* rs, int lane) {
    const f32x4* xr = (const f32x4*)xrow + lane; f32x4 v[8]; float s = 0.f;
#pragma unroll
    for (int j = 0; j < 8; ++j) { v[j] = __builtin_nontemporal_load(xr + 64 * j); s += (v[j].x * v[j].x + v[j].y * v[j].y) + (v[j].z * v[j].z + v[j].w * v[j].w); }
    s = wave_sum(s);
    if (lane == 0) *rs = 1.f / sqrtf(s * (1.f / DM) + EPS);
    v2u* o8 = (v2u*)orow + lane;
#pragma unroll
    for (int j = 0; j < 8; ++j) { v2u w; w.x = pk2(v[j].x, v[j].y); w.y = pk2(v[j].z, v[j].w); o8[64 * j] = w; }
}
__device__ __forceinline__ void p0_x_row(const float* xrow, bf16* orow, float* rs, int lane);
__device__ __forceinline__ void p0_s5_group(Frame& F, int g, int part, bool xrows) {
    const float* are = inp(F, I_ARE) + g * 64; const float* aim = inp(F, I_AIM) + g * 64;
    const float* bre = inp(F, I_BRE) + g * 1024; const float* bim = inp(F, I_BIM) + g * 1024;
    const float* cre = inp(F, I_CRE) + g * 1024; const float* cim = inp(F, I_CIM) + g * 1024;
    const float* dd = inp(F, I_D) + g * 16;
    LAS float* Ere = (LAS float*)F.lds;
    LAS float* Eim = Ere + 17 * 64;
    LAS float* Bre = Eim + 17 * 64;
    LAS float* Bim = Bre + 1024;
    LAS float* Cre = Bim + 1024;
    LAS float* Cim = Cre + 1024;
    LAS float* Kt = Cim + 1024;
    const int tid = F.tid;
    const double dt = exp((double)inp(F, I_LOGSTEP)[g]);
    if (tid < 64) {
        const int p = tid; const double lr = (double)are[p], li = (double)aim[p];
        double s1, c1; sincos_d(li * dt, s1, c1); const double mg = exp(lr * dt); const double e1r = mg * c1, e1i = mg * s1;
        double er = 1.0, ei = 0.0;
        for (int k = 0; k <= 16; ++k) { Ere[k * 64 + p] = (float)er; Eim[k * 64 + p] = (float)ei; const double nr = er * e1r - ei * e1i, ni = er * e1i + ei * e1r; er = nr; ei = ni; }
        const double nr_ = e1r - 1.0, ni_ = e1i, den = lr * lr + li * li; const double fr_ = (nr_ * lr + ni_ * li) / den, fi_ = (ni_ * lr - nr_ * li) / den;
        if (part == 0) { float* e1 = (float*)(F.ws + SM_E1) + (g * 64 + p) * 2; e1[0] = (float)e1r; e1[1] = (float)e1i;
        float* e16 = (float*)(F.ws + SM_E16) + (g * 64 + p) * 2; e16[0] = Ere[16 * 64 + p]; e16[1] = Eim[16 * 64 + p]; }
        float* bb = (float*)(F.ws + SM_BBAR) + (size_t)(g * 64 + p) * 32;
        for (int c = 0; c < 16; ++c) { const double br = (double)bre[p * 16 + c], bi = (double)bim[p * 16 + c]; const float xr = (float)(fr_ * br - fi_ * bi), xi = (float)(fr_ * bi + fi_ * br);
            Bre[p * 16 + c] = xr; Bim[p * 16 + c] = xi; if (part == 0) { bb[2 * c] = xr; bb[2 * c + 1] = xi; } }
    }
    for (int i = tid; i < 1024; i += NTHR) { Cre[i] = cre[i]; Cim[i] = cim[i]; }
    if (xrows && F.wave > 0) {
        bf16* XB = (bf16*)(F.ws + WS_XB); float* rs0 = (float*)(F.ws + SM_RS0);
        for (int m = F.bid * 7 + (F.wave - 1); m < MT; m += F.G * 7) { const float* xr = (m < MP) ? inp(F, I_XP) + (size_t)m * DM : inp(F, I_XS) + (size_t)(m - MP) * DM; p0_x_row(xr, XB + (size_t)m * DM, rs0 + m, F.lane); }
    }
    __syncthreads();
    for (int e = tid; e < 1024; e += NTHR) { const int d = e >> 6, co = 4 * part + ((e >> 4) & 3), ci = e & 15; float acc = 0.f;
        for (int p = 0; p < 64; ++p) { const float cr = Cre[co * 64 + p], ci_ = Cim[co * 64 + p], er = Ere[d * 64 + p], ei = Eim[d * 64 + p], br = Bre[p * 16 + ci], bi = Bim[p * 16 + ci];
            const float wr_ = cr * er - ci_ * ei, wi_ = cr * ei + ci_ * er; acc += wr_ * br - wi_ * bi; }
        if (d == 0 && co == ci) acc += dd[co];
        Kt[e] = acc; }
    __syncthreads();
    const int z = g >> 1, gl = g & 1;
    bf16* KG = (bf16*)(F.ws + WS_KG) + (size_t)z * 512 * 768;
    for (int it = tid; it < 64 * 96; it += NTHR) { const int rr = it / 96, kc = it % 96; const int j = rr >> 2, col = rr & 3, co = 4 * part + col, n = j * 32 + gl * 16 + co, k0 = kc * 8; float v[8];
#pragma unroll
        for (int e = 0; e < 8; ++e) { const int k = k0 + e; float x = 0.f;
            if (k < 512) { const int i = k >> 5, glk = (k >> 4) & 1, ci = k & 15; if (glk == gl && j >= i) x = Kt[((j - i) * 4 + col) * 16 + ci]; }
            else { const int kk = k - 512, glk = kk >> 7, q = kk & 127, p = q & 63; if (glk == gl) { const float cr = Cre[co * 64 + p], ci_ = Cim[co * 64 + p], er = Ere[(j + 1) * 64 + p], ei = Eim[(j + 1) * 64 + p];
                    x = (q < 64) ? (cr * er - ci_ * ei) : -(cr * ei + ci_ * er); } }
            v[e] = x; }
        v4u o; o.x = pk2(v[0], v[1]); o.y = pk2(v[2], v[3]); o.z = pk2(v[4], v[5]); o.w = pk2(v[6], v[7]);
        *(v4u*)(KG + (size_t)n * 768 + k0) = o; }
    bf16* M1 = (bf16*)(F.ws + WS_M1) + (size_t)z * 256 * 512;
    for (int it = tid; it < 32 * 64; it += NTHR) { const int q = 32 * part + (it >> 6), kc = it & 63, n = gl * 128 + q, p = q & 63, k0 = kc * 8; float v[8];
#pragma unroll
        for (int e = 0; e < 8; ++e) { const int k = k0 + e, i = k >> 5, glk = (k >> 4) & 1, ch = k & 15; float x = 0.f;
            if (glk == gl) { const float er = Ere[(15 - i) * 64 + p], ei = Eim[(15 - i) * 64 + p], br = Bre[p * 16 + ch], bi = Bim[p * 16 + ch]; x = (q < 64) ? (er * br - ei * bi) : (er * bi + ei * br); }
            v[e] = x; }
        v4u o; o.x = pk2(v[0], v[1]); o.y = pk2(v[2], v[3]); o.z = pk2(v[4], v[5]); o.w = pk2(v[6], v[7]);
        *(v4u*)(M1 + (size_t)n * 512 + k0) = o; }
    __syncthreads();
}

#ifndef P0_MASK
#define P0_MASK 7
#endif
__device__ __forceinline__ void p0_prologue(Frame& F, int mask) {
    bf16* WinT = (bf16*)(F.ws + WS_WIN);
    const bool xfused = (F.G == 256) && ((mask & 5) == 5);
    if (mask & 1) for (int it = F.bid; it < 256; it += F.G) p0_s5_group(F, it >> 2, it & 3, xfused);
    constexpr int I_1 = (DM / 64) * (NZ / 256);
    if (mask & 2) for (int it = F.bid; it < I_1; it += F.G) tr_item(inp(F, I_WIN), inp(F, I_NMIX), DM, NZ, WinT, it, F.wave, F.lane);
    const int gw = F.bid * NWAVES + F.wave, NGW = F.G * NWAVES;
    bf16* XB = (bf16*)(F.ws + WS_XB); float* rs0 = (float*)(F.ws + SM_RS0);
    if ((mask & 4) && !xfused) for (int m = gw; m < MT; m += NGW) { const float* xr = (m < MP) ? inp(F, I_XP) + (size_t)m * DM : inp(F, I_XS) + (size_t)(m - MP) * DM; p0_x_row(xr, XB + (size_t)m * DM, rs0 + m, F.lane); }
    bf16* WGA = (bf16*)(F.ws + SM_WGA); bf16* WGX = (bf16*)(F.ws + SM_WGX);
    for (int e = F.bid * NTHR + F.tid; e < DLRU; e += F.G * NTHR) ((float*)(F.ws + SM_SP))[e] = log1pf(__expf(-inp(F, I_LAMBDA)[e]));
    for (int e = F.bid * NTHR + F.tid; e < 65536; e += F.G * NTHR) { const int h = e >> 12, j = (e >> 6) & 63, i = e & 63; WGA[e] = (bf16)f2bf(inp(F, I_WGA)[(h * 64 + i) * 64 + j]); WGX[e] = (bf16)f2bf(inp(F, I_WGX)[(h * 64 + i) * 64 + j]); }
}

__device__ __forceinline__ void s5_sample_item(Frame& F, int item) {
    const int g = item >> 5, sq0 = (item & 31) * 4, lane = F.lane, p = lane;
    LAS float* hs = (LAS float*)(F.lds + F.wave * 2048);
    const float* e1 = (const float*)(F.ws + SM_E1) + (g * 64 + p) * 2; const float ar = e1[0], ai = e1[1];
    const float* bb = (const float*)(F.ws + SM_BBAR) + (size_t)(g * 64 + p) * 32;
    float br[16], bi[16];
#pragma unroll
    for (int c = 0; c < 16; ++c) { br[c] = bb[2 * c]; bi[c] = bb[2 * c + 1]; }
    const int cc = lane & 15, part = lane >> 4;
    float cr[16], ci[16];
#pragma unroll
    for (int j = 0; j < 16; ++j) { cr[j] = inp(F, I_CRE)[(g * 16 + cc) * 64 + part * 16 + j]; ci[j] = inp(F, I_CIM)[(g * 16 + cc) * 64 + part * 16 + j]; }
    const float dv = inp(F, I_D)[g * 16 + cc];
    const bf16* us = (const bf16*)(F.ws + WS_US); bf16* gbuf = (bf16*)((unsigned char*)F.out + DO_G);
    float bur[16], bui[16], ucc[16];
#pragma unroll
    for (int t = 0; t < 16; ++t) { const int tok = sq0 * 4 + t;
        const v4u u0 = *(const v4u*)(us + (size_t)tok * DS5 + g * 16), u1 = *(const v4u*)(us + (size_t)tok * DS5 + g * 16 + 8);
        float uf[16]; uf[0] = bflo(u0.x); uf[1] = bfhi(u0.x); uf[2] = bflo(u0.y); uf[3] = bfhi(u0.y); uf[4] = bflo(u0.z); uf[5] = bfhi(u0.z); uf[6] = bflo(u0.w); uf[7] = bfhi(u0.w);
        uf[8] = bflo(u1.x); uf[9] = bfhi(u1.x); uf[10] = bflo(u1.y); uf[11] = bfhi(u1.y); uf[12] = bflo(u1.z); uf[13] = bfhi(u1.z); uf[14] = bflo(u1.w); uf[15] = bfhi(u1.w);
        float a = 0.f, b = 0.f;
#pragma unroll
        for (int c = 0; c < 16; ++c) { a += br[c] * uf[c]; b += bi[c] * uf[c]; }
        bur[t] = a; bui[t] = b; ucc[t] = bf2f(us[(size_t)tok * DS5 + g * 16 + cc]); }
    float hr[4], hi[4];
#pragma unroll
    for (int q = 0; q < 4; ++q) { hr[q] = inp(F, I_SRE)[((sq0 + q) * 64 + g) * 64 + p]; hi[q] = inp(F, I_SIM)[((sq0 + q) * 64 + g) * 64 + p]; }
#pragma unroll
    for (int s = 0; s < 4; ++s) {
#pragma unroll
        for (int q = 0; q < 4; ++q) { const int t = q * 4 + s; const float nr = ar * hr[q] - ai * hi[q] + bur[t], ni = ar * hi[q] + ai * hr[q] + bui[t]; hr[q] = nr; hi[q] = ni;
            hs[q * 128 + p] = nr; hs[q * 128 + 64 + p] = ni; }
        LDS_WAIT();
#pragma unroll
        for (int q = 0; q < 4; ++q) { float y = 0.f;
#pragma unroll
            for (int j = 0; j < 16; ++j) y += cr[j] * hs[q * 128 + part * 16 + j] - ci[j] * hs[q * 128 + 64 + part * 16 + j];
            y += __shfl_xor(y, 16); y += __shfl_xor(y, 32);
            y += dv * ucc[q * 4 + s];
            if (lane < 16) gbuf[(size_t)(MP + sq0 * 4 + q * 4 + s) * DS5 + g * 16 + cc] = (bf16)f2bf(gelu_tanh(y)); }
        LDS_WAIT();
    }
#pragma unroll
    for (int q = 0; q < 4; ++q) { F.out[O_RES + (size_t)((sq0 + q) * 64 + g) * 64 + p] = hr[q]; F.out[O_IMS + (size_t)((sq0 + q) * 64 + g) * 64 + p] = hi[q]; }
}

constexpr int LW_XS = 0, LW_XC = 4864, LW_XF = 7168, LW_AB = 11264, LW_BYTES = 16384;
struct LruPre { f32x4 xs[5]; float hin; };
__device__ __forceinline__ void lruw_load(Frame& F, int hd, int idx, int pass, LruPre& R) {
    const int lane = F.lane; const bool sample = idx >= 512;
    const int gc = idx, b = gc >> 7, c = gc & 127, tok0 = sample ? MP + 16 * (idx - 512) : 16 * gc, cgl = hd * 64 + lane;
    const float* xlru = (const float*)((unsigned char*)F.out + DO_XLRU);
#pragma unroll
    for (int k = 0; k < 5; ++k) { const int i = lane + 64 * k, r = i >> 4, q = i & 15, t = c * 16 - 3 + r; f32x4 v = {0.f, 0.f, 0.f, 0.f};
        if (!sample && i < 19 * 16 && t >= 0) v = *(const f32x4*)(xlru + (size_t)(b * SEQ + t) * DLRU + hd * 64 + 4 * q);
        R.xs[k] = v; }
    R.hin = 0.f;
    if (pass == 2) {
        if (!sample) R.hin = ((const float*)(F.ws + WS_HIN))[(size_t)gc * DLRU + cgl];
    }
}
#ifndef LRU_MODE
#define LRU_MODE 0
#endif
__device__ __forceinline__ void lruw_tile(Frame& F, int hd, int idx, int pass, float* ssqa_p, const LruPre& R, int mode = 0) {
    const int lane = F.lane;
    const bool sample = idx >= 512;
    const int gc = idx, b = gc >> 7, c = gc & 127, sb = idx - 512;
    const int tok0 = sample ? MP + 16 * sb : 16 * gc, cgl = hd * 64 + lane;
    const float* xlru = (const float*)((unsigned char*)F.out + DO_XLRU);
    bf16* mix = (bf16*)(F.ws + WS_MIX);
    LAS unsigned char* wl = F.lds + F.wave * LW_BYTES;
    LAS float* XS = (LAS float*)(wl + LW_XS); LAS bf16* XC = (LAS bf16*)(wl + LW_XC); LAS float* XF = (LAS float*)(wl + LW_XF); LAS float* AB = (LAS float*)(wl + LW_AB);
    const float* cw = inp(F, I_CONVW); const float* cb = inp(F, I_CONVB);
    const int fr = lane & 15, fq = lane >> 4;
    const bf16* WGA = (const bf16*)(F.ws + SM_WGA) + hd * 4096; const bf16* WGX = (const bf16*)(F.ws + SM_WGX) + hd * 4096;
    float vbga[4], vbgx[4], vsp[4];
#pragma unroll
    for (int nt = 0; nt < 4; ++nt) { const int ch = nt * 16 + fr; vbga[nt] = inp(F, I_BGA)[hd * 64 + ch]; vbgx[nt] = inp(F, I_BGX)[hd * 64 + ch]; vsp[nt] = ((const float*)(F.ws + SM_SP))[hd * 64 + ch]; }
    const int qc = lane & 15;
    f32x4 cwv[4], cbv = *(const f32x4*)(cb + hd * 64 + 4 * qc);
#pragma unroll
    for (int kk = 0; kk < 4; ++kk) cwv[kk] = *(const f32x4*)(cw + kk * DLRU + hd * 64 + 4 * qc);
    float h = R.hin, h0v[4], gvv[16];
#pragma unroll
    for (int q = 0; q < 4; ++q) h0v[q] = (pass == 2 && sample) ? inp(F, I_SLRU)[(size_t)(sb * 4 + q) * DLRU + cgl] : 0.f;
    if (pass == 2) { const bf16* glru = (const bf16*)((unsigned char*)F.out + DO_GLRU);
#pragma unroll
        for (int s = 0; s < 16; ++s) gvv[s] = bf2f(glru[(size_t)(tok0 + s) * DLRU + cgl]); }
    if (!sample) {
#pragma unroll
        for (int k = 0; k < 5; ++k) { const int i = lane + 64 * k; if (i < 19 * 16) { const int r = i >> 4, q = i & 15; *(LAS f32x4*)(XS + r * 64 + 4 * q) = R.xs[k]; } }
        LDS_WAIT();
#pragma unroll
        for (int k = 0; k < 4; ++k) { const int i = lane + 64 * k, t = i >> 4, q = i & 15;
            f32x4 a = cbv;
#pragma unroll
            for (int kk = 0; kk < 4; ++kk) a += cwv[kk] * *(LAS f32x4*)(XS + (t + kk) * 64 + 4 * q);
            *(LAS f32x4*)(XF + t * 64 + 4 * q) = a; v2u pk; pk.x = pk2(a.x, a.y); pk.y = pk2(a.z, a.w); *(LAS v2u*)(XC + t * 72 + 4 * q) = pk; }
    } else {
        const float* sconv = inp(F, I_SCONV);
#pragma unroll
        for (int k = 0; k < 4; ++k) { const int i = lane + 64 * k, t = i >> 4, q = i & 15, ch = hd * 64 + 4 * q, sq = sb * 4 + (t >> 2), s = t & 3;
            f32x4 a = cbv;
#pragma unroll
            for (int kk = 0; kk < 4; ++kk) { const int j = s + kk; const f32x4 xv = (j < 3) ? *(const f32x4*)(sconv + (size_t)(sq * 3 + j) * DLRU + ch) : *(const f32x4*)(xlru + (size_t)(MP + sq * 4 + j - 3) * DLRU + ch);
                a += cwv[kk] * xv; }
            *(LAS f32x4*)(XF + t * 64 + 4 * q) = a; v2u pk; pk.x = pk2(a.x, a.y); pk.y = pk2(a.z, a.w); *(LAS v2u*)(XC + t * 72 + 4 * q) = pk; }
    }
    bf16x8 wba0[4], wba1[4], wbx0[4], wbx1[4];
#pragma unroll
    for (int nt = 0; nt < 4; ++nt) { const int ch = nt * 16 + fr;
        wba0[nt] = *(const bf16x8*)(WGA + ch * 64 + fq * 8); wba1[nt] = *(const bf16x8*)(WGA + ch * 64 + 32 + fq * 8);
        wbx0[nt] = *(const bf16x8*)(WGX + ch * 64 + fq * 8); wbx1[nt] = *(const bf16x8*)(WGX + ch * 64 + 32 + fq * 8); }
    LDS_WAIT();
    {
        const bf16x8 a0 = *(LAS bf16x8*)(XC + fr * 72 + fq * 8), a1 = *(LAS bf16x8*)(XC + fr * 72 + 32 + fq * 8);
#pragma unroll
        for (int nt = 0; nt < 4; ++nt) {
            const int ch = nt * 16 + fr;
            f32x4 ga = {0.f, 0.f, 0.f, 0.f}, gx = {0.f, 0.f, 0.f, 0.f};
            ga = __builtin_amdgcn_mfma_f32_16x16x32_bf16(a0, wba0[nt], ga, 0, 0, 0); ga = __builtin_amdgcn_mfma_f32_16x16x32_bf16(a1, wba1[nt], ga, 0, 0, 0);
            gx = __builtin_amdgcn_mfma_f32_16x16x32_bf16(a0, wbx0[nt], gx, 0, 0, 0); gx = __builtin_amdgcn_mfma_f32_16x16x32_bf16(a1, wbx1[nt], gx, 0, 0, 0);
            const float bga = vbga[nt], bgx = vbgx[nt], sp = vsp[nt];
#pragma unroll
            for (int r = 0; r < 4; ++r) { const int t = fq * 4 + r; const float xc = XF[t * 64 + ch];
                const float rg = sigmoidf_(ga[r] + bga), ig = sigmoidf_(gx[r] + bgx), la = -8.f * rg * sp, av = __expf(la), x2 = 2.f * la;
                const float m1 = -x2 * (1.f + x2 * (0.5f + x2 * (0.16666667f + x2 * (0.041666668f + x2 * (0.0083333338f + x2 * 0.0013888889f)))));
                const float mult = __builtin_amdgcn_sqrtf((x2 > -0.25f) ? m1 : 1.f - __expf(x2));
                (void)av; XS[t * 64 + ch] = la; XF[t * 64 + ch] = mult * ig * xc; }
        }
    }
    LDS_WAIT();
    {
        bf16* LA = (bf16*)(F.ws + WS_XB); bf16* LB = LA + (size_t)MT * DLRU;
        float Ap = 1.f; unsigned lw[8], bw[8];
#pragma unroll
        for (int s = 0; s < 16; ++s) { const unsigned lab = f2bf(XS[s * 64 + lane]), bb = f2bf(XF[s * 64 + lane]);
            if (s & 1) { lw[s >> 1] |= lab << 16; bw[s >> 1] |= bb << 16; } else { lw[s >> 1] = lab; bw[s >> 1] = bb; }
            const float av = __expf(bf2f(lab)); h = av * h + bf2f(bb); Ap *= av; }
        { const size_t o = ((size_t)(idx * 16 + hd) * 64 + lane) * 16;
          *(v4u*)(LA + o) = (v4u){lw[0], lw[1], lw[2], lw[3]}; *(v4u*)(LA + o + 8) = (v4u){lw[4], lw[5], lw[6], lw[7]};
          *(v4u*)(LB + o) = (v4u){bw[0], bw[1], bw[2], bw[3]}; *(v4u*)(LB + o + 8) = (v4u){bw[4], bw[5], bw[6], bw[7]}; }
        if (!sample) { float* o = (float*)(F.ws + WS_AGG) + ((size_t)gc * DLRU + cgl) * 2; *(v2u*)o = (v2u){__builtin_bit_cast(unsigned, Ap), __builtin_bit_cast(unsigned, h)}; }
        LDS_WAIT();
    }
}
struct Lru2Pre { v4u la0, la1, lb0, lb1; float g[16]; float hin; };
__device__ __forceinline__ void lruw2_load(Frame& F, int hd, int idx, Lru2Pre& R) {
    const int lane = F.lane; const bool sample = idx >= 512;
    const int tok0 = sample ? MP + 16 * (idx - 512) : 16 * idx, cgl = hd * 64 + lane;
    const bf16* glru = (const bf16*)((unsigned char*)F.out + DO_GLRU);
    const bf16* LA = (const bf16*)(F.ws + WS_XB); const bf16* LB = LA + (size_t)MT * DLRU;
    const size_t o = ((size_t)(idx * 16 + hd) * 64 + lane) * 16;
    R.la0 = *(const v4u*)(LA + o); R.la1 = *(const v4u*)(LA + o + 8); R.lb0 = *(const v4u*)(LB + o); R.lb1 = *(const v4u*)(LB + o + 8);
#pragma unroll
    for (int s = 0; s < 16; ++s) R.g[s] = bf2f(glru[(size_t)(tok0 + s) * DLRU + cgl]);
    R.hin = sample ? 0.f : ((const float*)(F.ws + WS_HIN))[(size_t)idx * DLRU + cgl];
}
__device__ __forceinline__ void lruw2_tile(Frame& F, int hd, int idx, float* ssqa_p, const Lru2Pre& R) {
    const int lane = F.lane;
    const bool sample = idx >= 512;
    const int gc = idx, b = gc >> 7, c = gc & 127, sb = idx - 512;
    const int tok0 = sample ? MP + 16 * sb : 16 * gc, cgl = hd * 64 + lane;
    const float* xlru = (const float*)((unsigned char*)F.out + DO_XLRU);
    bf16* mix = (bf16*)(F.ws + WS_MIX);
    float lav[16], bvv[16], h0v[4];
    { const unsigned lw[8] = {R.la0.x, R.la0.y, R.la0.z, R.la0.w, R.la1.x, R.la1.y, R.la1.z, R.la1.w}, bw[8] = {R.lb0.x, R.lb0.y, R.lb0.z, R.lb0.w, R.lb1.x, R.lb1.y, R.lb1.z, R.lb1.w};
#pragma unroll
      for (int k = 0; k < 8; ++k) { lav[2 * k] = bflo(lw[k]); lav[2 * k + 1] = bfhi(lw[k]); bvv[2 * k] = bflo(bw[k]); bvv[2 * k + 1] = bfhi(bw[k]); } }
    float h = R.hin;
#pragma unroll
    for (int q = 0; q < 4; ++q) h0v[q] = sample ? inp(F, I_SLRU)[(size_t)(sb * 4 + q) * DLRU + cgl] : 0.f;
    float sq[16];
#pragma unroll
    for (int s = 0; s < 16; ++s) {
        if (sample && (s & 3) == 0) h = h0v[s >> 2];
        h = __expf(lav[s]) * h + bvv[s];
        const float o = h * gelu_tanh(R.g[s]);
        mix[(size_t)(tok0 + s) * DM + cgl] = (bf16)f2bf(o); sq[s] = o * o;
        if (sample && (s & 3) == 3) F.out[O_LRUS + (size_t)(sb * 4 + (s >> 2)) * DLRU + cgl] = h;
    }
    if (!sample && c == 127) { F.out[O_LRUP + (size_t)b * DLRU + cgl] = h;
#pragma unroll
        for (int j = 0; j < 3; ++j) F.out[O_CONVP + (size_t)(b * 3 + j) * DLRU + cgl] = xlru[(size_t)(b * SEQ + 2045 + j) * DLRU + cgl]; }
    if (sample) {
#pragma unroll
        for (int e = 0; e < 12; ++e) { const int sqn = sb * 4 + e / 3, j = e % 3; F.out[O_CONVS + (size_t)(sqn * 3 + j) * DLRU + cgl] = xlru[(size_t)(MP + sqn * 4 + 1 + j) * DLRU + cgl]; }
    }
    const bool b5 = lane & 32, b4 = lane & 16, b3 = lane & 8, b2 = lane & 4;
    float r8[8], r4[4], r2[2], r1;
#pragma unroll
    for (int k = 0; k < 8; ++k) { const float mine = b5 ? sq[8 + k] : sq[k], send = b5 ? sq[k] : sq[8 + k]; r8[k] = mine + __shfl_xor(send, 32); }
#pragma unroll
    for (int k = 0; k < 4; ++k) { const float mine = b4 ? r8[4 + k] : r8[k], send = b4 ? r8[k] : r8[4 + k]; r4[k] = mine + __shfl_xor(send, 16); }
#pragma unroll
    for (int k = 0; k < 2; ++k) { const float mine = b3 ? r4[2 + k] : r4[k], send = b3 ? r4[k] : r4[2 + k]; r2[k] = mine + __shfl_xor(send, 8); }
    { const float mine = b2 ? r2[1] : r2[0], send = b2 ? r2[0] : r2[1]; r1 = mine + __shfl_xor(send, 4); }
    r1 += __shfl_xor(r1, 1); r1 += __shfl_xor(r1, 2);
    if ((lane & 3) == 0) atomicAdd(ssqa_p + tok0 + ((lane >> 5) & 1) * 8 + ((lane >> 4) & 1) * 4 + ((lane >> 3) & 1) * 2 + ((lane >> 2) & 1), r1);
}
__device__ __forceinline__ void lruw_tiles(Frame& F, int pass, int nper, unsigned* counters, float* ssqa_p, int mode = 0) {
    const int hd = F.bid & 15; unsigned* cp = counters + 16 * hd;
    unsigned v0 = 0u, v1 = 0u; if (F.lane == 0) { v0 = atomicAdd(cp, 1u); v1 = atomicAdd(cp, 1u); }
    int t = (int)__builtin_amdgcn_readfirstlane(v0), nx = (int)__builtin_amdgcn_readfirstlane(v1);
    if (pass == 2) {
        Lru2Pre Q; if (t < nper) lruw2_load(F, hd, t, Q);
        while (t < nper) {
            unsigned v2 = 0u; if (F.lane == 0) v2 = atomicAdd(cp, 1u);
            Lru2Pre Qn; if (nx < nper) lruw2_load(F, hd, nx, Qn);
            lruw2_tile(F, hd, t, ssqa_p, Q);
            t = nx; Q = Qn; nx = (int)__builtin_amdgcn_readfirstlane(v2);
        }
        return;
    }
    LruPre R; if (t < nper) lruw_load(F, hd, t, pass, R);
    while (t < nper) {
        unsigned v2 = 0u; if (F.lane == 0) v2 = atomicAdd(cp, 1u);
        LruPre Rn; if (nx < nper) lruw_load(F, hd, nx, pass, Rn);
        lruw_tile(F, hd, t, pass, ssqa_p, R, mode);
        t = nx; R = Rn; nx = (int)__builtin_amdgcn_readfirstlane(v2);
    }
}

constexpr int NPHASE = 10;
#ifndef LRU_N4
#define LRU_N4 256
#endif
#ifndef DUP_PHASE
#define DUP_PHASE (-1)
#endif

__global__ void __launch_bounds__(NTHR, 2) fwd_megakernel(Args args) {
    extern __shared__ __attribute__((aligned(16))) unsigned char lds_raw[];
    cg::grid_group grid = cg::this_grid();
    Frame F; F.lds = (LAS unsigned char*)lds_raw; F.tid = threadIdx.x; F.lane = F.tid & 63; F.wave = __builtin_amdgcn_readfirstlane(F.tid >> 6); F.G = gridDim.x; F.bid = blockIdx.x;
    F.out = args.out; F.ws = args.ws;
    if (F.tid == 0) {
#pragma unroll
        for (int i = 0; i < 32; ++i) { const unsigned long long pv = (unsigned long long)args.in[i]; ((LAS unsigned*)(F.lds + PTR_OFF))[2 * i] = (unsigned)pv; ((LAS unsigned*)(F.lds + PTR_OFF))[2 * i + 1] = (unsigned)(pv >> 32); }
    }
    const int lo = args.ph_lo, hi = args.ph_hi;
    volatile LAS unsigned* MISC = (volatile LAS unsigned*)(F.lds + MISC_OFF);
    if (F.tid < 32) MISC[F.tid] = 0u;
    __syncthreads();
    if (lo > hi) grid.sync();
    XcdBarrier xbar = xcd_barrier_post((unsigned*)(args.ws + WS_CTL + CTL_BAR), MISC + 8);
#define IN(k) (lo <= (k) && (k) < hi)
#define SEAM(k) do { if (IN(k) && IN((k) + 1)) { xcd_barrier(xbar); } } while (0)
    unsigned char* ws = args.ws;
    bf16* WinT = (bf16*)(ws + WS_WIN); bf16* WgluT = (bf16*)(ws + WS_WGLU); bf16* WoutT = (bf16*)(ws + WS_WOUT); bf16* WupT = (bf16*)(ws + WS_WUP); bf16* WdownT = (bf16*)(ws + WS_WDOWN);
    bf16* XB = (bf16*)(ws + WS_XB); bf16* HB = (bf16*)(ws + WS_H); bf16* A2 = (bf16*)(ws + WS_A2); bf16* US = (bf16*)(ws + WS_US); bf16* MIX = (bf16*)(ws + WS_MIX);
    bf16* M1 = (bf16*)(ws + WS_M1); bf16* KG = (bf16*)(ws + WS_KG); float* SB = (float*)(ws + WS_S);
    float* ssqa = (float*)(ws + WS_CTL + CTL_SSQA); float* ssqb = (float*)(ws + WS_CTL + CTL_SSQB); float* ssq1 = (float*)(ws + WS_CTL + CTL_SSQ1); float* ssq2 = (float*)(ws + WS_CTL + CTL_SSQ2);
    unsigned* cnt = (unsigned*)(ws + WS_CTL + CTL_CNT); float* ssqd = (float*)(ws + WS_CTL + 320 * 1024);
    float* xlru = (float*)((unsigned char*)args.out + DO_XLRU); bf16* glru = (bf16*)((unsigned char*)args.out + DO_GLRU); bf16* gbuf = (bf16*)((unsigned char*)args.out + DO_G);

    if (IN(0)) {
        if (DUP_PHASE == 0) { constexpr bool dup = true; (void)dup; { p0_prologue(F, P0_MASK); } xcd_barrier(xbar); }
        { constexpr bool dup = false; (void)dup; { p0_prologue(F, 7); } }
    }
    SEAM(0);
    if (IN(1)) {
        if (DUP_PHASE == 1) { constexpr bool dup = true; (void)dup; { {
        pg8::Gemm g{XB, WinT, DM, DM, DM, 0, 0}; pg8::Order S; S.init(MT, NZ, 1, F.G, F.bid);
        pg8::EpiZ E{(const float*)(ws + SM_RS0), xlru, glru, A2, US};
        pg8::gemm_phase<pg8::EpiZ, pg8::Order, true, true>(F.lds, g, S, E);
        __syncthreads();
        if constexpr (!dup) { tr_items_dyn(F, inp(F, I_WGLU), nullptr, DS5, DS5, WgluT, cnt + 10);
          tr_items_dyn(F, inp(F, I_WUP), inp(F, I_NMLP), DM, DFF, WupT, cnt + 8); }
    } } xcd_barrier(xbar); }
        { constexpr bool dup = false; (void)dup; { {
        pg8::Gemm g{XB, WinT, DM, DM, DM, 0, 0}; pg8::Order S; S.init(MT, NZ, 1, F.G, F.bid);
        pg8::EpiZ E{(const float*)(ws + SM_RS0), xlru, glru, A2, US};
        pg8::gemm_phase<pg8::EpiZ, pg8::Order, true, true>(F.lds, g, S, E);
        __syncthreads();
        if constexpr (!dup) { tr_items_dyn(F, inp(F, I_WGLU), nullptr, DS5, DS5, WgluT, cnt + 10);
          tr_items_dyn(F, inp(F, I_WUP), inp(F, I_NMLP), DM, DFF, WupT, cnt + 8); }
    } } }
    }
    SEAM(1);
    if (IN(2)) {
        if (DUP_PHASE == 2) { constexpr bool dup = true; (void)dup; { {
        { pg8::Gemm g{A2, M1, A2_LD, 512, 512, (size_t)A2_ROWS * A2_LD, (size_t)256 * 512}; pg8::Order S; S.init(A2_ROWS, 256, NPAIR, F.G, F.bid);
          pg8::EpiS E{SB};
          pg8::gemm_phase<pg8::EpiS, pg8::Order, true, true>(F.lds, g, S, E); }
#ifdef SMP_REP
        if constexpr (!dup) { xcd_barrier(xbar); for (int it = F.bid * NWAVES + F.wave; it < 2048; it += F.G * NWAVES) s5_sample_item(F, it); xcd_barrier(xbar); }
#endif
        __syncthreads();
        lruw_tiles(F, 1, 544, cnt + (dup ? 1024 : 512), ssqa); __syncthreads();
    } } xcd_barrier(xbar); }
        { constexpr bool dup = false; (void)dup; { {
        { pg8::Gemm g{A2, M1, A2_LD, 512, 512, (size_t)A2_ROWS * A2_LD, (size_t)256 * 512}; pg8::Order S; S.init(A2_ROWS, 256, NPAIR, F.G, F.bid);
          pg8::EpiS E{SB};
          pg8::gemm_phase<pg8::EpiS, pg8::Order, true, true>(F.lds, g, S, E); }
#ifdef SMP_REP
        if constexpr (!dup) { xcd_barrier(xbar); for (int it = F.bid * NWAVES + F.wave; it < 2048; it += F.G * NWAVES) s5_sample_item(F, it); xcd_barrier(xbar); }
#endif
        __syncthreads();
        lruw_tiles(F, 1, 544, cnt + (dup ? 1024 : 512), ssqa); __syncthreads();
    } } }
    }
    SEAM(2);
    if (IN(3)) {
        if (DUP_PHASE == 3) { constexpr bool dup = true; (void)dup; { {
        for (int e = F.bid * 64 + F.tid; F.tid < 64 && e < NPAIR * NB * 128; e += F.G * 64) {
            const int z = e >> 9, b = (e >> 7) & 3, q = e & 127, gl = q >> 6, p = q & 63, g = z * 2 + gl;
            const float* e16 = (const float*)(ws + SM_E16) + (g * 64 + p) * 2; const float ar = e16[0], ai = e16[1];
            float hr = 0.f, hi = 0.f;
            const float* __restrict__ Sp = SB + ((size_t)z * A2_ROWS + b * NCH) * 256 + gl * 128 + p;
            bf16* __restrict__ Hp = A2 + ((size_t)z * A2_ROWS + b * NCH) * A2_LD + 512 + gl * 128 + p;
            for (int c0 = 0; c0 < NCH; c0 += 32) {
                float sr[32], si[32];
#pragma unroll
                for (int j = 0; j < 32; ++j) { sr[j] = Sp[(size_t)(c0 + j) * 256]; si[j] = Sp[(size_t)(c0 + j) * 256 + 64]; }
#pragma unroll
                for (int j = 0; j < 32; ++j) { Hp[(size_t)(c0 + j) * A2_LD] = (bf16)f2bf(hr); Hp[(size_t)(c0 + j) * A2_LD + 64] = (bf16)f2bf(hi);
                    const float nr = ar * hr - ai * hi + sr[j], ni = ar * hi + ai * hr + si[j]; hr = nr; hi = ni; }
            }
            args.out[O_REP + (size_t)(b * 64 + g) * 64 + p] = hr; args.out[O_IMP + (size_t)(b * 64 + g) * 64 + p] = hi;
        }
        for (int e = F.bid * 64 + (F.tid - 64); F.tid >= 64 && F.tid < 128 && e < NB * DLRU; e += F.G * 64) {
            const int b = e >> 10, chn = e & 1023;
            const float* __restrict__ ag = (const float*)(ws + WS_AGG) + ((size_t)(b * 128) * DLRU + chn) * 2; float* __restrict__ hn = (float*)(ws + WS_HIN) + (size_t)(b * 128) * DLRU + chn;
            float h = 0.f;
            for (int c0 = 0; c0 < 128; c0 += 32) {
                float aa[32], hh[32];
#pragma unroll
                for (int j = 0; j < 32; ++j) { aa[j] = ag[(size_t)(c0 + j) * DLRU * 2]; hh[j] = ag[(size_t)(c0 + j) * DLRU * 2 + 1]; }
#pragma unroll
                for (int j = 0; j < 32; ++j) { hn[(size_t)(c0 + j) * DLRU] = h; h = aa[j] * h + hh[j]; }
            }
        }
    } } xcd_barrier(xbar); }
        { constexpr bool dup = false; (void)dup; { {
        for (int e = F.bid * 64 + F.tid; F.tid < 64 && e < NPAIR * NB * 128; e += F.G * 64) {
            const int z = e >> 9, b = (e >> 7) & 3, q = e & 127, gl = q >> 6, p = q & 63, g = z * 2 + gl;
            const float* e16 = (const float*)(ws + SM_E16) + (g * 64 + p) * 2; const float ar = e16[0], ai = e16[1];
            float hr = 0.f, hi = 0.f;
            const float* __restrict__ Sp = SB + ((size_t)z * A2_ROWS + b * NCH) * 256 + gl * 128 + p;
            bf16* __restrict__ Hp = A2 + ((size_t)z * A2_ROWS + b * NCH) * A2_LD + 512 + gl * 128 + p;
            for (int c0 = 0; c0 < NCH; c0 += 32) {
                float sr[32], si[32];
#pragma unroll
                for (int j = 0; j < 32; ++j) { sr[j] = Sp[(size_t)(c0 + j) * 256]; si[j] = Sp[(size_t)(c0 + j) * 256 + 64]; }
#pragma unroll
                for (int j = 0; j < 32; ++j) { Hp[(size_t)(c0 + j) * A2_LD] = (bf16)f2bf(hr); Hp[(size_t)(c0 + j) * A2_LD + 64] = (bf16)f2bf(hi);
                    const float nr = ar * hr - ai * hi + sr[j], ni = ar * hi + ai * hr + si[j]; hr = nr; hi = ni; }
            }
            args.out[O_REP + (size_t)(b * 64 + g) * 64 + p] = hr; args.out[O_IMP + (size_t)(b * 64 + g) * 64 + p] = hi;
        }
        for (int e = F.bid * 64 + (F.tid - 64); F.tid >= 64 && F.tid < 128 && e < NB * DLRU; e += F.G * 64) {
            const int b = e >> 10, chn = e & 1023;
            const float* __restrict__ ag = (const float*)(ws + WS_AGG) + ((size_t)(b * 128) * DLRU + chn) * 2; float* __restrict__ hn = (float*)(ws + WS_HIN) + (size_t)(b * 128) * DLRU + chn;
            float h = 0.f;
            for (int c0 = 0; c0 < 128; c0 += 32) {
                float aa[32], hh[32];
#pragma unroll
                for (int j = 0; j < 32; ++j) { aa[j] = ag[(size_t)(c0 + j) * DLRU * 2]; hh[j] = ag[(size_t)(c0 + j) * DLRU * 2 + 1]; }
#pragma unroll
                for (int j = 0; j < 32; ++j) { hn[(size_t)(c0 + j) * DLRU] = h; h = aa[j] * h + hh[j]; }
            }
        }
    } } }
    }
    SEAM(3);
    if (IN(4)) {
        if (DUP_PHASE == 4) { constexpr bool dup = true; (void)dup; { {
        if constexpr (!dup) { pg8::Gemm g{A2, KG, A2_LD, 768, 768, (size_t)A2_ROWS * A2_LD, (size_t)512 * 768}; pg8::Order S; S.init(A2_ROWS, 512, NPAIR, F.G, F.bid);
          pg8::EpiY E{gbuf};
          pg8::gemm_phase<pg8::EpiY, pg8::Order, true, true>(F.lds, g, S, E); }
        __syncthreads();
        if constexpr (!dup) { const int nyu = NPAIR * 4, nidle = F.G > nyu ? F.G - nyu : F.G, rank = F.G > nyu ? F.bid - nyu : F.bid;
          if (rank >= 0) for (int it = rank * NWAVES + F.wave; it < 2048; it += nidle * NWAVES) s5_sample_item(F, it);
          __syncthreads(); }
#ifdef YG_REP
        if constexpr (!dup) { xcd_barrier(xbar); pg8::Gemm g{A2, KG, A2_LD, 768, 768, (size_t)A2_ROWS * A2_LD, (size_t)512 * 768}; pg8::Order S; S.init(A2_ROWS, 512, NPAIR, F.G, F.bid);
          pg8::EpiY E{gbuf};
          pg8::gemm_phase<pg8::EpiY, pg8::Order, true, true>(F.lds, g, S, E); xcd_barrier(xbar); }
#endif
        __syncthreads();
#ifdef LRU2_REP
#pragma nounroll
        for (int rep = 0; rep < LRU2_REP; ++rep) { lruw_tiles(F, 2, 544, cnt + 2048 + 256 * rep, ssqd, LRU_MODE); xcd_barrier(xbar); }
#endif
        lruw_tiles(F, 2, 544, cnt + (dup ? 1536 : 1280), dup ? ssqd : ssqa); __syncthreads();
    } } xcd_barrier(xbar); }
        { constexpr bool dup = false; (void)dup; { {
        if constexpr (!dup) { pg8::Gemm g{A2, KG, A2_LD, 768, 768, (size_t)A2_ROWS * A2_LD, (size_t)512 * 768}; pg8::Order S; S.init(A2_ROWS, 512, NPAIR, F.G, F.bid);
          pg8::EpiY E{gbuf};
          pg8::gemm_phase<pg8::EpiY, pg8::Order, true, true>(F.lds, g, S, E); }
        __syncthreads();
        if constexpr (!dup) { const int nyu = NPAIR * 4, nidle = F.G > nyu ? F.G - nyu : F.G, rank = F.G > nyu ? F.bid - nyu : F.bid;
          if (rank >= 0) for (int it = rank * NWAVES + F.wave; it < 2048; it += nidle * NWAVES) s5_sample_item(F, it);
          __syncthreads(); }
#ifdef YG_REP
        if constexpr (!dup) { xcd_barrier(xbar); pg8::Gemm g{A2, KG, A2_LD, 768, 768, (size_t)A2_ROWS * A2_LD, (size_t)512 * 768}; pg8::Order S; S.init(A2_ROWS, 512, NPAIR, F.G, F.bid);
          pg8::EpiY E{gbuf};
          pg8::gemm_phase<pg8::EpiY, pg8::Order, true, true>(F.lds, g, S, E); xcd_barrier(xbar); }
#endif
        __syncthreads();
#ifdef LRU2_REP
#pragma nounroll
        for (int rep = 0; rep < LRU2_REP; ++rep) { lruw_tiles(F, 2, 544, cnt + 2048 + 256 * rep, ssqd, LRU_MODE); xcd_barrier(xbar); }
#endif
        lruw_tiles(F, 2, 544, cnt + (dup ? 1536 : 1280), dup ? ssqd : ssqa); __syncthreads();
    } } }
    }
    SEAM(4);
    if (IN(5)) {
        if (DUP_PHASE == 5) { constexpr bool dup = true; (void)dup; { {
        pg8::Gemm g{gbuf, WgluT, DS5, DS5, DS5, 0, 0}; pg8::Order S; S.init(MT, DS5, 1, F.G, F.bid);
        pg8::EpiGlu E{gbuf, inp(F, I_BGLU), MIX, dup ? ssqd : ssqb};
        pg8::gemm_phase<pg8::EpiGlu, pg8::Order, true, true>(F.lds, g, S, E);
        __syncthreads();
        if constexpr (!dup) tr_items_dyn(F, inp(F, I_WOUT), inp(F, I_NOUTA), DM, DM, WoutT, cnt + 11, inp(F, I_NOUTB));
    } } xcd_barrier(xbar); }
        { constexpr bool dup = false; (void)dup; { {
        pg8::Gemm g{gbuf, WgluT, DS5, DS5, DS5, 0, 0}; pg8::Order S; S.init(MT, DS5, 1, F.G, F.bid);
        pg8::EpiGlu E{gbuf, inp(F, I_BGLU), MIX, dup ? ssqd : ssqb};
        pg8::gemm_phase<pg8::EpiGlu, pg8::Order, true, true>(F.lds, g, S, E);
        __syncthreads();
        if constexpr (!dup) tr_items_dyn(F, inp(F, I_WOUT), inp(F, I_NOUTA), DM, DM, WoutT, cnt + 11, inp(F, I_NOUTB));
    } } }
    }
    SEAM(5);
    if (IN(6)) {
        if (DUP_PHASE == 6) { constexpr bool dup = true; (void)dup; { {
        { pg8::Gemm g{MIX, WoutT, DM, DM, 1024, 1024, 1024}; pg8::Order S; S.init(MP, DM, -1, F.G, F.bid);
          pg8::EpiOut E{ssqa, ssqb, inp(F, I_XP), inp(F, I_XS), args.out, XB, dup ? ssqd : ssq1};
          pg8::gemm_phase<pg8::EpiOut, pg8::Order, true, true>(F.lds, g, S, E); }
        { pg8::Gemm g{MIX, WoutT, DM, DM, 256, 256, 256}; pg8::SliceOrder S{F.bid, 8, F.G};
          pg8::EpiPart E{(float*)(ws + WS_KG), (float*)(ws + WS_A2), 8};
          pg8::gemm_phase<pg8::EpiPart, pg8::SliceOrder, true, true>(F.lds, g, S, E); }
        if constexpr (!dup) { if (hi - lo > 1) xcd_barrier(xbar);
          for (int r2 = F.bid; r2 < MS / 2; r2 += F.G) {
            const int row = MP + 2 * r2 + (F.wave >> 2), qd = F.wave & 3, pm = row >> 8, rl = row & 255;
            const float* Pb = (const float*)(ws + (pm == 32 ? WS_KG : WS_A2));
            const float ra = 1.f / sqrtf(ssqa[row] * (1.f / DLRU) + EPS), rb = 1.f / sqrtf(ssqb[row] * (1.f / DS5) + EPS);
            float sq = 0.f;
#pragma unroll
            for (int jj = 0; jj < 2; ++jj) { const int col = 512 * qd + 256 * jj + 4 * F.lane, pn = col >> 8, cl = col & 255;
                const float* pp = Pb + (size_t)(pn * 8) * 65536 + rl * 256 + cl;
                f32x4 sa = {0.f, 0.f, 0.f, 0.f}, sb2 = {0.f, 0.f, 0.f, 0.f};
#pragma unroll
                for (int sl = 0; sl < 4; ++sl) { sa += *(const f32x4*)(pp + (size_t)sl * 65536); sb2 += *(const f32x4*)(pp + (size_t)(sl + 4) * 65536); }
                const f32x4 v = *(const f32x4*)(inp(F, I_XS) + (size_t)(row - MP) * DM + col) + sa * ra + sb2 * rb;
                *(f32x4*)(args.out + (size_t)row * DM + col) = v;
                v2u pk; pk.x = pk2(v.x, v.y); pk.y = pk2(v.z, v.w); *(v2u*)(XB + (size_t)row * DM + col) = pk;
                sq += (v.x * v.x + v.y * v.y) + (v.z * v.z + v.w * v.w); }
            sq = wave_sum(sq);
            if (F.lane == 0) atomicAdd(ssq1 + row, sq);
          } }
    } } xcd_barrier(xbar); }
        { constexpr bool dup = false; (void)dup; { {
        { pg8::Gemm g{MIX, WoutT, DM, DM, 1024, 1024, 1024}; pg8::Order S; S.init(MP, DM, -1, F.G, F.bid);
          pg8::EpiOut E{ssqa, ssqb, inp(F, I_XP), inp(F, I_XS), args.out, XB, dup ? ssqd : ssq1};
          pg8::gemm_phase<pg8::EpiOut, pg8::Order, true, true>(F.lds, g, S, E); }
        { pg8::Gemm g{MIX, WoutT, DM, DM, 256, 256, 256}; pg8::SliceOrder S{F.bid, 8, F.G};
          pg8::EpiPart E{(float*)(ws + WS_KG), (float*)(ws + WS_A2), 8};
          pg8::gemm_phase<pg8::EpiPart, pg8::SliceOrder, true, true>(F.lds, g, S, E); }
        if constexpr (!dup) { if (hi - lo > 1) xcd_barrier(xbar);
          for (int r2 = F.bid; r2 < MS / 2; r2 += F.G) {
            const int row = MP + 2 * r2 + (F.wave >> 2), qd = F.wave & 3, pm = row >> 8, rl = row & 255;
            const float* Pb = (const float*)(ws + (pm == 32 ? WS_KG : WS_A2));
            const float ra = 1.f / sqrtf(ssqa[row] * (1.f / DLRU) + EPS), rb = 1.f / sqrtf(ssqb[row] * (1.f / DS5) + EPS);
            float sq = 0.f;
#pragma unroll
            for (int jj = 0; jj < 2; ++jj) { const int col = 512 * qd + 256 * jj + 4 * F.lane, pn = col >> 8, cl = col & 255;
                const float* pp = Pb + (size_t)(pn * 8) * 65536 + rl * 256 + cl;
                f32x4 sa = {0.f, 0.f, 0.f, 0.f}, sb2 = {0.f, 0.f, 0.f, 0.f};
#pragma unroll
                for (int sl = 0; sl < 4; ++sl) { sa += *(const f32x4*)(pp + (size_t)sl * 65536); sb2 += *(const f32x4*)(pp + (size_t)(sl + 4) * 65536); }
                const f32x4 v = *(const f32x4*)(inp(F, I_XS) + (size_t)(row - MP) * DM + col) + sa * ra + sb2 * rb;
                *(f32x4*)(args.out + (size_t)row * DM + col) = v;
                v2u pk; pk.x = pk2(v.x, v.y); pk.y = pk2(v.z, v.w); *(v2u*)(XB + (size_t)row * DM + col) = pk;
                sq += (v.x * v.x + v.y * v.y) + (v.z * v.z + v.w * v.w); }
            sq = wave_sum(sq);
            if (F.lane == 0) atomicAdd(ssq1 + row, sq);
          } }
    } } }
    }
    SEAM(6);
    if (IN(7)) {
        if (DUP_PHASE == 7) { constexpr bool dup = true; (void)dup; { {
        pg8::Gemm g{XB, WupT, DM, DM, DM, 0, 0}; pg8::Order S; S.init(MT, DFF, 1, F.G, F.bid);
        pg8::EpiUp E{ssq1, HB};
        pg8::gemm_phase<pg8::EpiUp, pg8::Order, true, true>(F.lds, g, S, E);
        __syncthreads();
        if constexpr (!dup) tr_items_dyn(F, inp(F, I_WDOWN), nullptr, DFF, DM, WdownT, cnt + 9);
    } } xcd_barrier(xbar); }
        { constexpr bool dup = false; (void)dup; { {
        pg8::Gemm g{XB, WupT, DM, DM, DM, 0, 0}; pg8::Order S; S.init(MT, DFF, 1, F.G, F.bid);
        pg8::EpiUp E{ssq1, HB};
        pg8::gemm_phase<pg8::EpiUp, pg8::Order, true, true>(F.lds, g, S, E);
        __syncthreads();
        if constexpr (!dup) tr_items_dyn(F, inp(F, I_WDOWN), nullptr, DFF, DM, WdownT, cnt + 9);
    } } }
    }
    SEAM(7);
    if (IN(8)) {
        if (DUP_PHASE == 8) { constexpr bool dup = true; (void)dup; { {
        { pg8::Gemm g{HB, WdownT, DFF, DFF, DFF, 0, 0}; pg8::Order S; S.init(MP, DM, 1, F.G, F.bid);
          pg8::EpiDown E{args.out, XB, dup ? 0.f : 1.f};
          pg8::gemm_phase<pg8::EpiDown, pg8::Order, true, true>(F.lds, g, S, E); }
        { pg8::Gemm g{HB, WdownT, DFF, DFF, 1024, 1024, 1024}; pg8::SliceOrder S{F.bid, 8, F.G};
          pg8::EpiPart E{(float*)(ws + WS_WUP), (float*)(ws + WS_WUP) + (size_t)64 * 65536, 8};
          pg8::gemm_phase<pg8::EpiPart, pg8::SliceOrder, true, true>(F.lds, g, S, E); }
    } } xcd_barrier(xbar); }
        { constexpr bool dup = false; (void)dup; { {
        { pg8::Gemm g{HB, WdownT, DFF, DFF, DFF, 0, 0}; pg8::Order S; S.init(MP, DM, 1, F.G, F.bid);
          pg8::EpiDown E{args.out, XB, dup ? 0.f : 1.f};
          pg8::gemm_phase<pg8::EpiDown, pg8::Order, true, true>(F.lds, g, S, E); }
        { pg8::Gemm g{HB, WdownT, DFF, DFF, 1024, 1024, 1024}; pg8::SliceOrder S{F.bid, 8, F.G};
          pg8::EpiPart E{(float*)(ws + WS_WUP), (float*)(ws + WS_WUP) + (size_t)64 * 65536, 8};
          pg8::gemm_phase<pg8::EpiPart, pg8::SliceOrder, true, true>(F.lds, g, S, E); }
    } } }
    }
    SEAM(8);
    if (IN(9)) {
        if (DUP_PHASE == 9) { constexpr bool dup = true; (void)dup; { {
        const float* gf = inp(F, I_NFINAL);
        for (int r2 = F.bid; r2 < MS / 2; r2 += F.G) {
            const int row = MP + 2 * r2 + (F.wave >> 2), qd = F.wave & 3, pm = row >> 8, rl = row & 255;
            const float* Pb = (const float*)(ws + WS_WUP) + (pm == 32 ? (size_t)0 : (size_t)64 * 65536);
            f32x4 v[2]; float sq = 0.f;
#pragma unroll
            for (int jj = 0; jj < 2; ++jj) { const int col = 512 * qd + 256 * jj + 4 * F.lane, pn = col >> 8, cl = col & 255;
                f32x4 a = *(const f32x4*)(args.out + (size_t)row * DM + col);
                const float* pp = Pb + (size_t)(pn * 8) * 65536 + rl * 256 + cl;
#pragma unroll
                for (int sl = 0; sl < 8; ++sl) a += *(const f32x4*)(pp + (size_t)sl * 65536);
                v[jj] = a; sq += (a.x * a.x + a.y * a.y) + (a.z * a.z + a.w * a.w); }
            sq = wave_sum(sq);
            LAS float* red = (LAS float*)(F.lds + MISC_OFF + 128);
            if (F.lane == 0) red[F.wave] = sq;
            __syncthreads();
            const int w0 = F.wave & 4; const float tot = (red[w0] + red[w0 + 1]) + (red[w0 + 2] + red[w0 + 3]);
            __syncthreads();
            const float rs = dup ? 1.f : 1.f / sqrtf(tot * (1.f / DM) + EPS);
#pragma unroll
            for (int jj = 0; jj < 2; ++jj) { const int col = 512 * qd + 256 * jj + 4 * F.lane; const f32x4 gr = dup ? (f32x4){1.f, 1.f, 1.f, 1.f} : *(const f32x4*)(gf + col);
                f32x4 o = v[jj] * rs * gr; if (dup) o = *(const f32x4*)(args.out + (size_t)row * DM + col);
                *(f32x4*)(args.out + (size_t)row * DM + col) = o; }
        }
        for (int m = F.bid * NWAVES + F.wave; m < MP; m += F.G * NWAVES) {
            const v4u* xb = (const v4u*)(args.out + (size_t)m * DM) + F.lane; float* xo = args.out + (size_t)m * DM;
            v4u w[4]; float sq = 0.f; f32x4 v[8];
#pragma unroll
            for (int j = 0; j < 4; ++j) w[j] = xb[64 * j];
#pragma unroll
            for (int j = 0; j < 4; ++j) { v[2 * j] = (f32x4){bflo(w[j].x), bfhi(w[j].x), bflo(w[j].y), bfhi(w[j].y)}; v[2 * j + 1] = (f32x4){bflo(w[j].z), bfhi(w[j].z), bflo(w[j].w), bfhi(w[j].w)};
                sq += (v[2 * j].x * v[2 * j].x + v[2 * j].y * v[2 * j].y) + (v[2 * j].z * v[2 * j].z + v[2 * j].w * v[2 * j].w) + (v[2 * j + 1].x * v[2 * j + 1].x + v[2 * j + 1].y * v[2 * j + 1].y) + (v[2 * j + 1].z * v[2 * j + 1].z + v[2 * j + 1].w * v[2 * j + 1].w); }
            sq = wave_sum(sq);
            const float rs = 1.f / sqrtf(sq * (1.f / DM) + EPS);
            asm volatile("s_waitcnt vmcnt(0)" ::: "memory");
#pragma unroll
            for (int j = 0; j < 4; ++j) { const int c0 = 8 * (F.lane + 64 * j); const f32x4 g0 = *(const f32x4*)(gf + c0), g1 = *(const f32x4*)(gf + c0 + 4);
                *(f32x4*)(xo + c0) = v[2 * j] * rs * g0; *(f32x4*)(xo + c0 + 4) = v[2 * j + 1] * rs * g1; }
        }
    } } xcd_barrier(xbar); }
        { constexpr bool dup = false; (void)dup; { {
        const float* gf = inp(F, I_NFINAL);
        for (int r2 = F.bid; r2 < MS / 2; r2 += F.G) {
            const int row = MP + 2 * r2 + (F.wave >> 2), qd = F.wave & 3, pm = row >> 8, rl = row & 255;
            const float* Pb = (const float*)(ws + WS_WUP) + (pm == 32 ? (size_t)0 : (size_t)64 * 65536);
            f32x4 v[2]; float sq = 0.f;
#pragma unroll
            for (int jj = 0; jj < 2; ++jj) { const int col = 512 * qd + 256 * jj + 4 * F.lane, pn = col >> 8, cl = col & 255;
                f32x4 a = *(const f32x4*)(args.out + (size_t)row * DM + col);
                const float* pp = Pb + (size_t)(pn * 8) * 65536 + rl * 256 + cl;
#pragma unroll
                for (int sl = 0; sl < 8; ++sl) a += *(const f32x4*)(pp + (size_t)sl * 65536);
                v[jj] = a; sq += (a.x * a.x + a.y * a.y) + (a.z * a.z + a.w * a.w); }
            sq = wave_sum(sq);
            LAS float* red = (LAS float*)(F.lds + MISC_OFF + 128);
            if (F.lane == 0) red[F.wave] = sq;
            __syncthreads();
            const int w0 = F.wave & 4; const float tot = (red[w0] + red[w0 + 1]) + (red[w0 + 2] + red[w0 + 3]);
            __syncthreads();
            const float rs = dup ? 1.f : 1.f / sqrtf(tot * (1.f / DM) + EPS);
#pragma unroll
            for (int jj = 0; jj < 2; ++jj) { const int col = 512 * qd + 256 * jj + 4 * F.lane; const f32x4 gr = dup ? (f32x4){1.f, 1.f, 1.f, 1.f} : *(const f32x4*)(gf + col);
                f32x4 o = v[jj] * rs * gr; if (dup) o = *(const f32x4*)(args.out + (size_t)row * DM + col);
                *(f32x4*)(args.out + (size_t)row * DM + col) = o; }
        }
        for (int m = F.bid * NWAVES + F.wave; m < MP; m += F.G * NWAVES) {
            const v4u* xb = (const v4u*)(args.out + (size_t)m * DM) + F.lane; float* xo = args.out + (size_t)m * DM;
            v4u w[4]; float sq = 0.f; f32x4 v[8];
#pragma unroll
            for (int j = 0; j < 4; ++j) w[j] = xb[64 * j];
#pragma unroll
            for (int j = 0; j < 4; ++j) { v[2 * j] = (f32x4){bflo(w[j].x), bfhi(w[j].x), bflo(w[j].y), bfhi(w[j].y)}; v[2 * j + 1] = (f32x4){bflo(w[j].z), bfhi(w[j].z), bflo(w[j].w), bfhi(w[j].w)};
                sq += (v[2 * j].x * v[2 * j].x + v[2 * j].y * v[2 * j].y) + (v[2 * j].z * v[2 * j].z + v[2 * j].w * v[2 * j].w) + (v[2 * j + 1].x * v[2 * j + 1].x + v[2 * j + 1].y * v[2 * j + 1].y) + (v[2 * j + 1].z * v[2 * j + 1].z + v[2 * j + 1].w * v[2 * j + 1].w); }
            sq = wave_sum(sq);
            const float rs = 1.f / sqrtf(sq * (1.f / DM) + EPS);
            asm volatile("s_waitcnt vmcnt(0)" ::: "memory");
#pragma unroll
            for (int j = 0; j < 4; ++j) { const int c0 = 8 * (F.lane + 64 * j); const f32x4 g0 = *(const f32x4*)(gf + c0), g1 = *(const f32x4*)(gf + c0 + 4);
                *(f32x4*)(xo + c0) = v[2 * j] * rs * g0; *(f32x4*)(xo + c0 + 4) = v[2 * j + 1] * rs * g1; }
        }
    } } }
    }
#undef IN
#undef SEAM
}

#ifndef MK_MULTI_LAUNCH
#define MK_MULTI_LAUNCH 0
#endif
extern "C" void kernel_launch(void* const* d_in, const int* in_sizes, int n_in, void* d_out, int out_size, void* d_ws, size_t ws_size, hipStream_t stream) {
    static int grid = 0;
    if (grid == 0) {
        if (n_in != 32 || (size_t)out_size != O_END || ws_size < WS_END) { fprintf(stderr, "kernel_launch: unexpected sizes n_in %d out %d ws %zu\n", n_in, out_size, ws_size); grid = -1; return; }
        int dev = 0, cus = 0, per_cu = 0;
        hipGetDevice(&dev); hipDeviceGetAttribute(&cus, hipDeviceAttributeMultiprocessorCount, dev);
        if (hipFuncSetAttribute((const void*)fwd_megakernel, hipFuncAttributeMaxDynamicSharedMemorySize, LDS_BYTES) != hipSuccess) { fprintf(stderr, "kernel_launch: hipFuncSetAttribute failed\n"); grid = -1; return; }
        if (hipOccupancyMaxActiveBlocksPerMultiprocessor(&per_cu, (const void*)fwd_megakernel, NTHR, LDS_BYTES) != hipSuccess || per_cu < 1) { fprintf(stderr, "kernel_launch: occupancy query says %d\n", per_cu); per_cu = 1; }
        (void)hipGetLastError();
        grid = cus * 1;
        fprintf(stderr, "kernel_launch: grid %d (cus %d, per_cu %d)\n", grid, cus, per_cu);
    }
    if (grid < 0) return;
    hipMemsetAsync((char*)d_ws + WS_CTL, 0, CTL_BYTES, stream);
    Args a{};
    for (int i = 0; i < 32; ++i) a.in[i] = (const float*)d_in[i];
    a.out = (float*)d_out; a.ws = (unsigned char*)d_ws;
#if MK_MULTI_LAUNCH
    for (int p = 0; p < NPHASE; ++p) { a.ph_lo = p; a.ph_hi = p + 1; hipLaunchKernelGGL(fwd_megakernel, dim3(grid), dim3(NTHR), LDS_BYTES, stream, a); }
#else
    a.ph_lo = 0; a.ph_hi = NPHASE;
    void* kargs[] = {&a};
    hipError_t e = hipLaunchCooperativeKernel((const void*)fwd_megakernel, dim3(grid), dim3(NTHR), kargs, LDS_BYTES, stream);
    if (e != hipSuccess) fprintf(stderr, "kernel_launch: cooperative launch failed: %s (grid %d)\n", hipGetErrorString(e), grid);
#endif
}
```
